# Optimizing an MI355X kernel written in HIP

```python
import jax, jax.numpy as jnp
from jax import lax
import numpy as np

D_MODEL = 4096
BATCH = 4
SEQ = 2048
DEPTH = 4

N_MIXERS = 2
MLA_HEADS = 32
Q_LORA = 1024
KV_LORA = 512
NOPE_DIM = 128
ROPE_DIM = 64
V_DIM = 128
QK_DIM = NOPE_DIM + ROPE_DIM
MLA_WIDTH = MLA_HEADS * V_DIM
MLA_IN = Q_LORA + KV_LORA + ROPE_DIM + MLA_WIDTH
ROPE_THETA = 10000.0
SB_HEADS = 32
SB_DIM = 128
SB_WIDTH = SB_HEADS * SB_DIM
SB_IN = 4 * SB_WIDTH
Q_BLOCK = 128
EPS = 1e-6
N_MLA = (DEPTH + 1) // 2
N_SB = DEPTH // 2

kernel_name = "hybrid_mla_stickbreaking_gated"


def rms_norm(x, g):
    xf = x.astype(jnp.float32)
    y = xf * lax.rsqrt(jnp.mean(xf * xf, axis=-1, keepdims=True) + EPS)
    return (y * g.astype(jnp.float32)).astype(x.dtype)


def rope_tables(seq):
    inv = 1.0 / (ROPE_THETA ** (jnp.arange(0, ROPE_DIM, 2, dtype=jnp.float32) / ROPE_DIM))
    ang = jnp.arange(seq, dtype=jnp.float32)[:, None] * inv[None, :]
    return jnp.cos(ang), jnp.sin(ang)


def apply_rope(x, cos, sin):
    x1, x2 = jnp.split(x, 2, axis=-1)
    c = cos.astype(x.dtype)
    s = sin.astype(x.dtype)
    return jnp.concatenate([x1 * c - x2 * s, x1 * s + x2 * c], axis=-1)


def to_blocks(t):
    b, s, h, d = t.shape
    return jnp.moveaxis(t.reshape(b, s // Q_BLOCK, Q_BLOCK, h, d), 1, 0)


def from_blocks(t):
    nb, b, qb, h, d = t.shape
    return jnp.moveaxis(t, 0, 1).reshape(b, nb * qb, h * d)


def softmax_attend(q, k, v):
    seq = q.shape[1]
    nb = seq // Q_BLOCK
    scale = QK_DIM ** -0.5
    kpos = jnp.arange(seq)

    def block(args):
        qblk, i = args
        qpos = i * Q_BLOCK + jnp.arange(Q_BLOCK)
        s = jnp.einsum('bqhd,bkhd->bhqk', qblk, k).astype(jnp.float32) * scale
        s = jnp.where(kpos[None, :] <= qpos[:, None], s, -jnp.inf)
        p = jax.nn.softmax(s, axis=-1).astype(v.dtype)
        return jnp.einsum('bhqk,bkhd->bqhd', p, v)

    out = lax.map(block, (to_blocks(q), jnp.arange(nb)))
    return from_blocks(out)


def stick_breaking_attend(q, k, v):
    seq = q.shape[1]
    nb = seq // Q_BLOCK
    scale = SB_DIM ** -0.5
    kpos = jnp.arange(seq)

    def block(args):
        qblk, i = args
        qpos = i * Q_BLOCK + jnp.arange(Q_BLOCK)
        z = jnp.einsum('bqhd,bkhd->bhqk', qblk, k).astype(jnp.float32) * scale
        mask = kpos[None, :] < qpos[:, None]
        log_beta = jax.nn.log_sigmoid(z)
        log_1m = jnp.where(mask, jax.nn.log_sigmoid(-z), 0.0)
        suffix = lax.cumsum(log_1m, axis=3, reverse=True) - log_1m
        w = jnp.where(mask, jnp.exp(log_beta + suffix), 0.0).astype(v.dtype)
        return jnp.einsum('bhqk,bkhd->bqhd', w, v)

    out = lax.map(block, (to_blocks(q), jnp.arange(nb)))
    return from_blocks(out)


def mla_layer(x, norm_g, w_in, q_a_g, w_qb, kv_a_g, w_kvb, q_norm_g, k_norm_g, w_out, cos, sin):
    b, s, _ = x.shape
    h = rms_norm(x, norm_g)
    proj = h @ w_in
    q_lat, kv_lat, k_pe, gate = jnp.split(
        proj, [Q_LORA, Q_LORA + KV_LORA, Q_LORA + KV_LORA + ROPE_DIM], axis=-1)
    q = (rms_norm(q_lat, q_a_g) @ w_qb).reshape(b, s, MLA_HEADS, QK_DIM)
    kv = (rms_norm(kv_lat, kv_a_g) @ w_kvb).reshape(b, s, MLA_HEADS, NOPE_DIM + V_DIM)
    k_nope, v = jnp.split(kv, [NOPE_DIM], axis=-1)
    k_pe_h = jnp.broadcast_to(k_pe[:, :, None, :], (b, s, MLA_HEADS, ROPE_DIM))
    k = jnp.concatenate([k_nope, k_pe_h], axis=-1)
    q = rms_norm(q, q_norm_g)
    k = rms_norm(k, k_norm_g)
    c, sn = cos[:, None, :], sin[:, None, :]
    q = jnp.concatenate([q[..., :NOPE_DIM], apply_rope(q[..., NOPE_DIM:], c, sn)], axis=-1)
    k = jnp.concatenate([k[..., :NOPE_DIM], apply_rope(k[..., NOPE_DIM:], c, sn)], axis=-1)
    o = softmax_attend(q, k, v)
    return x + (o * jax.nn.silu(gate)) @ w_out


def sb_layer(x, norm_g, w_in, w_out):
    b, s, _ = x.shape
    h = rms_norm(x, norm_g)
    q, k, v, gate = jnp.split(h @ w_in, 4, axis=-1)
    q = q.reshape(b, s, SB_HEADS, SB_DIM)
    k = k.reshape(b, s, SB_HEADS, SB_DIM)
    v = v.reshape(b, s, SB_HEADS, SB_DIM)
    o = stick_breaking_attend(q, k, v)
    return x + (o * jax.nn.silu(gate)) @ w_out


def setup_inputs(seed: int = 0) -> dict:
    key = jax.random.key(seed)
    ks = jax.random.split(key, 16)

    def w(k, shape, fan_in):
        return jax.random.normal(k, shape, jnp.float32) * (fan_in ** -0.5)

    def gain(k, shape):
        return 1.0 + 0.02 * jax.random.normal(k, shape, jnp.float32)

    return {
        "x": jax.random.normal(ks[0], (BATCH, SEQ, D_MODEL), jnp.float32),
        "mla_norm_g": gain(ks[1], (N_MLA, D_MODEL)),
        "mla_w_in": w(ks[2], (N_MLA, D_MODEL, MLA_IN), D_MODEL),
        "mla_q_a_g": gain(ks[3], (N_MLA, Q_LORA)),
        "mla_w_qb": w(ks[4], (N_MLA, Q_LORA, MLA_HEADS * QK_DIM), Q_LORA),
        "mla_kv_a_g": gain(ks[5], (N_MLA, KV_LORA)),
        "mla_w_kvb": w(ks[6], (N_MLA, KV_LORA, MLA_HEADS * (NOPE_DIM + V_DIM)), KV_LORA),
        "mla_q_norm_g": gain(ks[7], (N_MLA, QK_DIM)),
        "mla_k_norm_g": gain(ks[8], (N_MLA, QK_DIM)),
        "mla_w_out": w(ks[9], (N_MLA, MLA_WIDTH, D_MODEL), MLA_WIDTH),
        "sb_norm_g": gain(ks[10], (N_SB, D_MODEL)),
        "sb_w_in": w(ks[11], (N_SB, D_MODEL, SB_IN), D_MODEL),
        "sb_w_out": w(ks[12], (N_SB, SB_WIDTH, D_MODEL), SB_WIDTH),
    }


def reference(x, mla_norm_g, mla_w_in, mla_q_a_g, mla_w_qb, mla_kv_a_g, mla_w_kvb,
              mla_q_norm_g, mla_k_norm_g, mla_w_out, sb_norm_g, sb_w_in, sb_w_out):
    cos, sin = rope_tables(x.shape[1])
    h = x
    for i in range(DEPTH):
        j = i // N_MIXERS
        if i % N_MIXERS == 0:
            h = mla_layer(h, mla_norm_g[j], mla_w_in[j], mla_q_a_g[j], mla_w_qb[j],
                          mla_kv_a_g[j], mla_w_kvb[j], mla_q_norm_g[j], mla_k_norm_g[j],
                          mla_w_out[j], cos, sin)
        else:
            h = sb_layer(h, sb_norm_g[j], sb_w_in[j], sb_w_out[j])
    return h
```

```cpp
#include <hip/hip_runtime.h>
#include <cstdio>
#include <cstdint>
namespace pg8 {
#define PG8_LAS __attribute__((address_space(3)))
typedef unsigned short bf16_t;
typedef short bf16x8 __attribute__((ext_vector_type(8)));
typedef float f32x4 __attribute__((ext_vector_type(4)));
typedef unsigned u32x4 __attribute__((ext_vector_type(4)));
constexpr int BM = 256, BK = 64, HALF = 128, HTB = HALF * BK * 2  , STAGE_BYTES = 8 * HTB, NXCD = 8, WGM = 8;

__host__ __device__ __forceinline__ int lds_byte(int r, int c) { const int st = (r >> 4) * 2 + (c >> 5), rr = r & 15, cc = c & 31, ob = rr * 64 + cc * 2; return st * 1024 + (ob ^ (((ob >> 9) & 1) << 5)); }
__host__ __device__ __forceinline__ void stage_rc(int b, int& R, int& C) { const int st = b / 1024, sb = b % 1024, swz = sb ^ (((sb >> 9) & 1) << 5); R = (st >> 1) * 16 + swz / 64; C = (st & 1) * 32 + (swz % 64) / 2; }
__host__ __device__ __forceinline__ int perm32(int rho) { const int n = rho >> 4, i = rho & 15; return 8 * (i >> 2) + 4 * n + (i & 3); }

struct Unit { int pm, pn; };
struct Gemm { const bf16_t* A; const bf16_t* Bt; int M, N, K, lda; };

struct StaticOrder {
    int nM, nN, nwg, G, c;
    __host__ __device__ void init(int M, int N, int G_, int c_) { nM = M / BM; nN = N / BM; nwg = nM * nN; G = G_; c = c_; }
    __host__ __device__ bool next(int i, Unit& u) const {
        const long L = (long)i * G + c; if (L >= nwg) return false;
        int wgid = (int)L; { const int q = nwg / NXCD, r = nwg % NXCD, xcd = wgid % NXCD, off = wgid / NXCD; wgid = (xcd < r ? xcd * (q + 1) : r * (q + 1) + (xcd - r) * q) + off; }
        const int nig = WGM * nN, gid = wgid / nig, fm = gid * WGM, gsz = (nM - fm) < WGM ? (nM - fm) : WGM;
        u.pm = fm + ((wgid % nig) % gsz); u.pn = (wgid % nig) / gsz; return true;
    }
    __device__ __forceinline__ void a_ready(const Unit&) const {}
    __device__ __forceinline__ void done(const Unit&) const {}
};

__device__ __forceinline__ unsigned cvt_pk_bf16(float lo, float hi) { unsigned r; asm volatile("v_cvt_pk_bf16_f32 %0, %1, %2" : "=v"(r) : "v"(lo), "v"(hi)); return r; }
struct EpiBf16 {
    static constexpr bool PERM = true, AFTER_DRAIN = false;
    bf16_t* O; int ldc;
    __device__ __forceinline__ void operator()(const f32x4 (&acc)[2][2][4][2], const Unit& u, int wr, int wc, int fr, int fq) const {
        const int row0 = u.pm * BM + wr * 64 + fr; const int col0 = u.pn * BM + wc * 32 + 8 * fq;
#pragma unroll
        for (int ai = 0; ai < 2; ++ai)
#pragma unroll
            for (int m = 0; m < 4; ++m) { bf16_t* rowp = O + (size_t)(row0 + ai * HALF + m * 16) * ldc + col0;
#pragma unroll
                for (int bj = 0; bj < 2; ++bj) { const f32x4 v0 = acc[ai][bj][m][0], v1 = acc[ai][bj][m][1];
                    u32x4 w; w.x = cvt_pk_bf16(v0[0], v0[1]); w.y = cvt_pk_bf16(v0[2], v0[3]); w.z = cvt_pk_bf16(v1[0], v1[1]); w.w = cvt_pk_bf16(v1[2], v1[3]);
                    *(u32x4*)(rowp + bj * HALF) = w; } }
    }
};
struct EpiResF32 {
    static constexpr bool PERM = true, AFTER_DRAIN = false;
    const float* base; float* out; int ldc;
    __device__ __forceinline__ void operator()(const f32x4 (&acc)[2][2][4][2], const Unit& u, int wr, int wc, int fr, int fq) const {
        const int row0 = u.pm * BM + wr * 64 + fr; const int col0 = u.pn * BM + wc * 32 + 8 * fq;
#pragma unroll
        for (int ai = 0; ai < 2; ++ai)
#pragma unroll
            for (int m = 0; m < 4; ++m) { const size_t off = (size_t)(row0 + ai * HALF + m * 16) * ldc + col0;
#pragma unroll
                for (int bj = 0; bj < 2; ++bj) {
                    const f32x4 b0 = *(const f32x4*)(base + off + bj * HALF), b1 = *(const f32x4*)(base + off + bj * HALF + 4);
                    *(f32x4*)(out + off + bj * HALF) = b0 + acc[ai][bj][m][0]; *(f32x4*)(out + off + bj * HALF + 4) = b1 + acc[ai][bj][m][1]; } }
    }
};

constexpr float SS_FIX = 1048576.f, SS_UNFIX = 1.f / 1048576.f;
__device__ __forceinline__ float rstd_of(const unsigned long long* ss, int row, float inv_n) { return 1.f / sqrtf((float)ss[row] * (SS_UNFIX * inv_n) + 1e-6f); }
__device__ __forceinline__ void ss_add(unsigned long long* ss, int row, float part, int fq) {
    part += __shfl_xor(part, 16); part += __shfl_xor(part, 32);
    if (fq == 0) atomicAdd(ss + row, (unsigned long long)(part * SS_FIX));
}
template <int SSMODE> struct EpiBf16S {
    static constexpr bool PERM = true, AFTER_DRAIN = false;
    bf16_t* O; int ldc; const unsigned long long* ss_in; float inv_n; unsigned long long* ss1; unsigned long long* ss2;
    __device__ __forceinline__ void operator()(const f32x4 (&acc)[2][2][4][2], const Unit& u, int wr, int wc, int fr, int fq) const {
        const int row0 = u.pm * BM + wr * 64 + fr; const int col0 = u.pn * BM + wc * 32 + 8 * fq;
#pragma unroll
        for (int ai = 0; ai < 2; ++ai)
#pragma unroll
            for (int m = 0; m < 4; ++m) { const int row = row0 + ai * HALF + m * 16; const float rs = rstd_of(ss_in, row, inv_n); bf16_t* rowp = O + (size_t)row * ldc + col0; float part = 0.f;
#pragma unroll
                for (int bj = 0; bj < 2; ++bj) { const f32x4 v0 = acc[ai][bj][m][0] * rs, v1 = acc[ai][bj][m][1] * rs;
                    if (SSMODE == 1) part += (v0[0] * v0[0] + v0[1] * v0[1]) + (v0[2] * v0[2] + v0[3] * v0[3]) + (v1[0] * v1[0] + v1[1] * v1[1]) + (v1[2] * v1[2] + v1[3] * v1[3]);
                    u32x4 w; w.x = cvt_pk_bf16(v0[0], v0[1]); w.y = cvt_pk_bf16(v0[2], v0[3]); w.z = cvt_pk_bf16(v1[0], v1[1]); w.w = cvt_pk_bf16(v1[2], v1[3]);
                    *(u32x4*)(rowp + bj * HALF) = w; }
                if (SSMODE == 1) { if (u.pn < 6) ss_add(u.pn < 4 ? ss1 : ss2, row, part, fq); } }
    }
};
struct EpiResF32X {
    static constexpr bool PERM = true, AFTER_DRAIN = false;
    const float* base; float* out; int ldc; bf16_t* xb; unsigned long long* ss;
    __device__ __forceinline__ void operator()(const f32x4 (&acc)[2][2][4][2], const Unit& u, int wr, int wc, int fr, int fq) const {
        const int row0 = u.pm * BM + wr * 64 + fr; const int col0 = u.pn * BM + wc * 32 + 8 * fq;
#pragma unroll
        for (int ai = 0; ai < 2; ++ai)
#pragma unroll
            for (int m = 0; m < 4; ++m) { const int row = row0 + ai * HALF + m * 16; const size_t off = (size_t)row * ldc + col0; float part = 0.f;
#pragma unroll
                for (int bj = 0; bj < 2; ++bj) {
                    const f32x4 b0 = *(const f32x4*)(base + off + bj * HALF), b1 = *(const f32x4*)(base + off + bj * HALF + 4);
                    const f32x4 o0 = b0 + acc[ai][bj][m][0], o1 = b1 + acc[ai][bj][m][1];
                    *(f32x4*)(out + off + bj * HALF) = o0; *(f32x4*)(out + off + bj * HALF + 4) = o1;
                    if (xb) { part += (o0[0] * o0[0] + o0[1] * o0[1]) + (o0[2] * o0[2] + o0[3] * o0[3]) + (o1[0] * o1[0] + o1[1] * o1[1]) + (o1[2] * o1[2] + o1[3] * o1[3]);
                        u32x4 w; w.x = cvt_pk_bf16(o0[0], o0[1]); w.y = cvt_pk_bf16(o0[2], o0[3]); w.z = cvt_pk_bf16(o1[0], o1[1]); w.w = cvt_pk_bf16(o1[2], o1[3]);
                        *(u32x4*)(xb + off + bj * HALF) = w; } }
                if (xb) ss_add(ss, row, part, fq); }
    }
};

template <class Epi, class Sched, bool ALIGN_EPI = false, bool SP2 = false>
__device__ __forceinline__ void gemm_phase(PG8_LAS unsigned char* lds, const Gemm g, const Sched& S, const Epi& E) {
    int tid_l = threadIdx.x; asm volatile("" : "+v"(tid_l));
    const int tid = tid_l, wid = __builtin_amdgcn_readfirstlane(tid >> 6), lane = tid & 63, wr = wid >> 2, wc = wid & 3, fr = lane & 15, fq = lane >> 4;
    const int K = g.K, nt = K / BK;
    unsigned voffA[2], voffB[2];
#pragma unroll
    for (int i = 0; i < 2; ++i) { int R, C; stage_rc(tid * 16 + i * 8192, R, C); const int Rb = Epi::PERM ? ((R & ~31) + perm32(R & 31)) : R;
        voffA[i] = (unsigned)(R * g.lda + C) * 2u; voffB[i] = (unsigned)(Rb * K + C) * 2u; }
    const size_t kstep = (size_t)(BK * 2);
    const size_t hstep = (size_t)HALF * K * 2;
    const size_t tstep = 2 * hstep;
    const size_t hstepA = (size_t)HALF * g.lda * 2, tstepA = 2 * hstepA;
    const unsigned ldsw = (unsigned)wid * 1024u;
    const int aoff = lds_byte(wr * 64 + fr, fq * 8), boff = lds_byte(wc * 32 + fr, fq * 8);
#define PG8_SA(b, h) (((b) * 2 + (h)) * HTB)
#define PG8_SB(b, h) ((4 + (b) * 2 + (h)) * HTB)
#define PG8_STAGE(bufoff, gbase, voff) do { _Pragma("unroll") for (int _i = 0; _i < 2; ++_i) \
        __builtin_amdgcn_global_load_lds((const unsigned*)((const char*)(gbase) + (voff)[_i]), (PG8_LAS unsigned*)(lds + (bufoff) + ldsw + _i * 8192), 16, 0, 0); } while (0)
#define PG8_LDA(dst, b, h) do { _Pragma("unroll") for (int m = 0; m < 4; ++m) _Pragma("unroll") for (int k = 0; k < 2; ++k) dst[m][k] = *(const PG8_LAS bf16x8*)(lds + PG8_SA(b, h) + aoff + m * 2048 + k * 1024); } while (0)
#define PG8_LDB(dst, b, h) do { _Pragma("unroll") for (int n = 0; n < 2; ++n) _Pragma("unroll") for (int k = 0; k < 2; ++k) dst[n][k] = *(const PG8_LAS bf16x8*)(lds + PG8_SB(b, h) + boff + n * 2048 + k * 1024); } while (0)
#define PG8_MMA(ai, bj, At, Bt) do { __builtin_amdgcn_s_setprio(1); _Pragma("unroll") for (int m = 0; m < 4; ++m) _Pragma("unroll") for (int n = 0; n < 2; ++n) _Pragma("unroll") for (int k = 0; k < 2; ++k) \
        acc[ai][bj][m][n] = __builtin_amdgcn_mfma_f32_16x16x32_bf16(Bt[n][k], At[m][k], acc[ai][bj][m][n], 0, 0, 0); __builtin_amdgcn_s_setprio(0); } while (0)
#define PG8_WAIT_V(n) asm volatile("s_waitcnt vmcnt(" #n ")" ::: "memory")
#define PG8_WAIT_L(n) asm volatile("s_waitcnt lgkmcnt(" #n ")" ::: "memory")
#define PG8_BAR __builtin_amdgcn_s_barrier()
#define PG8_SCHED __builtin_amdgcn_sched_barrier(0)
    Unit cur, nxt; int ui = 0;
    if (!S.next(0, cur)) return;
    f32x4 acc[2][2][4][2];
#pragma unroll
    for (int a = 0; a < 2; ++a)
#pragma unroll
        for (int b = 0; b < 2; ++b)
#pragma unroll
            for (int m = 0; m < 4; ++m)
#pragma unroll
                for (int n = 0; n < 2; ++n) acc[a][b][m][n] = (f32x4){0.f, 0.f, 0.f, 0.f};
    bf16x8 At[4][2], B0[2][2], B1[2][2];
    const char* cA = (const char*)g.A + (size_t)cur.pm * tstepA; const char* cB = (const char*)g.Bt + (size_t)cur.pn * tstep;
    S.a_ready(cur);
    if constexpr (SP2) {
        PG8_STAGE(PG8_SB(0, 0), cB, voffB); PG8_STAGE(PG8_SB(0, 1), cB + hstep, voffB); PG8_STAGE(PG8_SA(0, 0), cA, voffA); PG8_STAGE(PG8_SA(0, 1), cA + hstepA, voffA);
        if (wr == 1) PG8_BAR;
        PG8_WAIT_V(2); PG8_BAR;
        PG8_STAGE(PG8_SB(1, 0), cB + kstep, voffB); PG8_STAGE(PG8_SA(1, 0), cA + kstep, voffA); PG8_STAGE(PG8_SB(1, 1), cB + hstep + kstep, voffB);
        PG8_WAIT_V(6); PG8_BAR;
    } else {
        PG8_STAGE(PG8_SB(0, 0), cB, voffB); PG8_STAGE(PG8_SA(0, 0), cA, voffA); PG8_STAGE(PG8_SB(0, 1), cB + hstep, voffB); PG8_STAGE(PG8_SA(0, 1), cA + hstepA, voffA);
        if (wr == 1) PG8_BAR;
        PG8_WAIT_V(4); PG8_BAR;
        PG8_STAGE(PG8_SB(1, 0), cB + kstep, voffB); PG8_STAGE(PG8_SA(1, 0), cA + kstep, voffA); PG8_STAGE(PG8_SB(1, 1), cB + hstep + kstep, voffB);
        PG8_WAIT_V(6); PG8_BAR;
    }
    for (;;) {
        const bool has_next = S.next(ui + 1, nxt);
        const char* nA = has_next ? (const char*)g.A + (size_t)nxt.pm * tstepA : cA; const char* nB = has_next ? (const char*)g.Bt + (size_t)nxt.pn * tstep : cB;
        for (int t = 0; t < nt; t += 2) {
            const bool last = (t == nt - 2);
            const char* a1 = cA + (size_t)(t + 1) * kstep;
            const char* a2 = last ? nA : cA + (size_t)(t + 2) * kstep; const char* b2 = last ? nB : cB + (size_t)(t + 2) * kstep;
            const char* a3 = a2 + kstep; const char* b3 = b2 + kstep;
            if (last && has_next) S.a_ready(nxt);
            if constexpr (SP2) {
            PG8_LDB(B0, 0, 0); PG8_LDB(B1, 0, 1); PG8_SCHED; PG8_LDA(At, 0, 0); PG8_STAGE(PG8_SA(1, 1), a1 + hstepA, voffA);
            PG8_WAIT_V(8); PG8_WAIT_L(0); PG8_BAR; PG8_MMA(0, 0, At, B0); PG8_MMA(0, 1, At, B1); PG8_BAR; PG8_SCHED;
            PG8_LDA(At, 0, 1); PG8_STAGE(PG8_SB(0, 0), b2, voffB); PG8_STAGE(PG8_SB(0, 1), b2 + hstep, voffB); PG8_STAGE(PG8_SA(0, 0), a2, voffA);
            PG8_WAIT_V(8); PG8_WAIT_L(0); PG8_BAR; PG8_MMA(1, 0, At, B0); PG8_MMA(1, 1, At, B1); PG8_BAR; PG8_SCHED;
            PG8_LDB(B0, 1, 0); PG8_LDB(B1, 1, 1); PG8_SCHED; PG8_LDA(At, 1, 0); PG8_STAGE(PG8_SA(0, 1), a2 + hstepA, voffA);
            PG8_WAIT_V(8); PG8_WAIT_L(0); PG8_BAR; PG8_MMA(0, 0, At, B0); PG8_MMA(0, 1, At, B1); PG8_BAR; PG8_SCHED;
            PG8_LDA(At, 1, 1); PG8_STAGE(PG8_SB(1, 0), b3, voffB); PG8_STAGE(PG8_SB(1, 1), b3 + hstep, voffB); PG8_STAGE(PG8_SA(1, 0), a3, voffA);
            PG8_WAIT_V(8); PG8_WAIT_L(0); PG8_BAR; PG8_MMA(1, 0, At, B0); PG8_MMA(1, 1, At, B1); PG8_BAR; PG8_SCHED;
            } else {
            PG8_LDB(B0, 0, 0); PG8_SCHED; PG8_LDA(At, 0, 0); PG8_STAGE(PG8_SA(1, 1), a1 + hstepA, voffA);
            PG8_WAIT_L(8); PG8_BAR; PG8_WAIT_L(0); PG8_MMA(0, 0, At, B0); PG8_BAR; PG8_SCHED;
            PG8_LDB(B1, 0, 1); PG8_STAGE(PG8_SB(0, 0), b2, voffB);
            PG8_BAR; PG8_WAIT_L(0); PG8_MMA(0, 1, At, B1); PG8_BAR;
            PG8_LDA(At, 0, 1); PG8_STAGE(PG8_SA(0, 0), a2, voffA);
            PG8_BAR; PG8_WAIT_L(0); PG8_MMA(1, 0, At, B0); PG8_BAR; PG8_SCHED;
            PG8_STAGE(PG8_SB(0, 1), b2 + hstep, voffB);
            PG8_WAIT_V(6); PG8_BAR; PG8_MMA(1, 1, At, B1); PG8_BAR;
            PG8_LDB(B0, 1, 0); PG8_SCHED; PG8_LDA(At, 1, 0); PG8_STAGE(PG8_SA(0, 1), a2 + hstepA, voffA);
            PG8_WAIT_L(8); PG8_BAR; PG8_WAIT_L(0); PG8_MMA(0, 0, At, B0); PG8_BAR; PG8_SCHED;
            PG8_LDB(B1, 1, 1); PG8_STAGE(PG8_SB(1, 0), b3, voffB);
            PG8_BAR; PG8_WAIT_L(0); PG8_MMA(0, 1, At, B1); PG8_BAR;
            PG8_LDA(At, 1, 1); PG8_STAGE(PG8_SA(1, 0), a3, voffA);
            PG8_BAR; PG8_WAIT_L(0); PG8_MMA(1, 0, At, B0); PG8_BAR; PG8_SCHED;
            PG8_STAGE(PG8_SB(1, 1), b3 + hstep, voffB);
            PG8_WAIT_V(6); PG8_BAR; PG8_MMA(1, 1, At, B1); PG8_BAR;
            }
        }
        if constexpr (ALIGN_EPI) { if (wr == 0) PG8_BAR; }
        if constexpr (!Epi::AFTER_DRAIN) { E(acc, cur, wr, wc, fr, fq); S.done(cur); }
        if (!has_next) break;
#pragma unroll
        for (int a = 0; a < 2; ++a)
#pragma unroll
            for (int b = 0; b < 2; ++b)
#pragma unroll
                for (int m = 0; m < 4; ++m)
#pragma unroll
                    for (int n = 0; n < 2; ++n) acc[a][b][m][n] = (f32x4){0.f, 0.f, 0.f, 0.f};
        cur = nxt; cA = nA; cB = nB; ++ui;
        if constexpr (ALIGN_EPI) { if (wr == 1) PG8_BAR; }
    }
    PG8_WAIT_V(0);
    if constexpr (!ALIGN_EPI) { if (wr == 0) PG8_BAR; }
    PG8_BAR;
    if constexpr (Epi::AFTER_DRAIN) { E.fused(acc, cur, wr, wc, fr, fq, lds, wid, lane); S.done(cur); }
#undef PG8_SA
#undef PG8_SB
#undef PG8_STAGE
#undef PG8_LDA
#undef PG8_LDB
#undef PG8_MMA
#undef PG8_WAIT_V
#undef PG8_WAIT_L
#undef PG8_BAR
#undef PG8_SCHED
}
}
#ifndef PG8_SP2
#define PG8_SP2 true
#endif
#ifndef PG8_ALIGN
#define PG8_ALIGN true
#endif

constexpr int NWAVES = 8;
#ifndef MK_ONE_LAUNCH
#define MK_ONE_LAUNCH 1
#endif
#ifndef FAST_ATTN_MLA
#define FAST_ATTN_MLA 1
#endif
#ifndef FAST_ATTN_SB
#define FAST_ATTN_SB 1
#endif

#define PROBE_NREP 1
#define REP_P0 1
#define REP_THIN 1
#define REP_ATT0 1
#define REP_ATT1 1
#define REP_G1 1
#define REP_G3 1
#define REP_G8 1
constexpr int M = 8192, DM = 4096, SEQ = 2048, NH = 32;
constexpr int MLA_IN = 5696, MLA_INP = 5888, QL = 1024, KVL = 512, QKD = 192, NQ = NH * QKD, NKV = NH * 256;
constexpr int C_KVLAT = 1024, C_KPE = 1536, C_GATE = 1600;
constexpr int SB_IN = 16384, C_SBK = 4096, C_SBV = 8192, C_SBG = 12288;
constexpr float EPS = 1e-6f;
constexpr float Q_SCALE_MLA = 0.07216878364870323f * 1.4426950408889634f;
constexpr float Q_SCALE_SB = 0.08838834764831845f * 1.4426950408889634f;
constexpr int N_PHASES = 17;

constexpr size_t MiB = 1u << 20;
constexpr size_t WS_CTL = 0, CTL_ZERO_BYTES = 1 * MiB;
constexpr size_t WS_ROPE = 1 * MiB;
constexpr size_t WS_W = 2 * MiB, W_LAYER = 258 * MiB;
constexpr size_t W_IN_MLA = 0, W_QB = 46 * MiB, W_KVB = 58 * MiB, W_OUT_MLA = 66 * MiB, W_IN_SB = 98 * MiB, W_OUT_SB = 226 * MiB;
constexpr size_t WS_ACT = WS_W + 2 * W_LAYER;
constexpr size_t A_XN = WS_ACT, A_PROJ = WS_ACT + 64 * MiB, A_QN = WS_ACT + 320 * MiB, A_KVN = WS_ACT + 336 * MiB, A_QRAW = WS_ACT + 344 * MiB,
                 A_KVRAW = WS_ACT + 440 * MiB, A_Q = WS_ACT + 568 * MiB, A_K = WS_ACT + 664 * MiB, A_OG = WS_ACT + 760 * MiB, WS_END = WS_ACT + 824 * MiB;
constexpr int CW_TMO = 0, CW_BAR = 4096;
constexpr size_t WS_SS = 64 * 1024, SS_BYTES = 64 * 1024;

constexpr int RING_OFF = 0, RING_BYTES = 131072;
constexpr int LDSCTL_OFF = RING_BYTES, MISC_OFF = LDSCTL_OFF + 320;
constexpr int LDS_BYTES = 147456;

#define GAS __attribute__((address_space(1)))
#define LAS __attribute__((address_space(3)))
typedef unsigned short bf16;
typedef unsigned v4u __attribute__((ext_vector_type(4)));
typedef unsigned v2u __attribute__((ext_vector_type(2)));
typedef float f32x4 __attribute__((ext_vector_type(4)));
typedef GAS unsigned gu32;
#define RLX_AGENT __ATOMIC_RELAXED, __HIP_MEMORY_SCOPE_AGENT
#define LDS_WAIT() asm volatile("s_waitcnt lgkmcnt(0)" ::: "memory")
__device__ __forceinline__ float bf_lo(unsigned w) { return __uint_as_float(w << 16); }
__device__ __forceinline__ float bf_hi(unsigned w) { return __uint_as_float(w & 0xffff0000u); }
__device__ __forceinline__ unsigned pk2(float lo, float hi) { return pg8::cvt_pk_bf16(lo, hi); }
__device__ __forceinline__ void unpack8(v4u w, float (&f)[8]) { f[0] = bf_lo(w.x); f[1] = bf_hi(w.x); f[2] = bf_lo(w.y); f[3] = bf_hi(w.y); f[4] = bf_lo(w.z); f[5] = bf_hi(w.z); f[6] = bf_lo(w.w); f[7] = bf_hi(w.w); }
__device__ __forceinline__ v4u pack8(const float (&f)[8]) { v4u w; w.x = pk2(f[0], f[1]); w.y = pk2(f[2], f[3]); w.z = pk2(f[4], f[5]); w.w = pk2(f[6], f[7]); return w; }

#define XB_TMO      128
#define XB_XCNT(j)  (256  + 64 * (j))
#define XB_XSUB(j)  (1280 + 64 * (j))
#define XB_XGEN(j)  (2304 + 64 * (j))
#define XB_TOP      3328
#define XB_TOPGEN   3392
#define XCD_BAR_WORDS 3456
#define XB_SPIN_CAP (1u << 18)

__device__ __forceinline__ unsigned xb_ld(unsigned* p)              { return __hip_atomic_load(p, __ATOMIC_RELAXED, __HIP_MEMORY_SCOPE_AGENT); }
__device__ __forceinline__ unsigned xb_add(unsigned* p, unsigned v) { return __hip_atomic_fetch_add(p, v, __ATOMIC_RELAXED, __HIP_MEMORY_SCOPE_AGENT); }
__device__ __forceinline__ unsigned xb_xcc_id() { return (unsigned)__builtin_amdgcn_s_getreg((3 << 11) | 20) & 0xFu; }
#define XB_SPIN(cond, bar) do { unsigned _sp = 0; while (cond) { __builtin_amdgcn_s_sleep(1); \
    if ((++_sp & 255u) == 0u) { if (xb_ld(&(bar)[XB_TMO])) break; if (_sp > XB_SPIN_CAP) { atomicAdd(&(bar)[XB_TMO], 1u); break; } } } } while (0)

struct XcdBarrier {
    unsigned* bar; unsigned x;
    volatile LAS unsigned* st;
};

__device__ __forceinline__ XcdBarrier xcd_barrier_post(unsigned* bar, volatile LAS unsigned* st) {
    XcdBarrier b; b.bar = bar; b.x = xb_xcc_id(); b.st = st;
    if (threadIdx.x == 0) (void)xb_add(&bar[XB_XCNT(b.x)], 1u);
    return b;
}
__device__ __forceinline__ void xcd_barrier_complete(unsigned* bar, unsigned x, unsigned& nloc, unsigned& nx) {
    const unsigned G = gridDim.x * gridDim.y * gridDim.z;
    unsigned sum, cnt, mine, sp = 0u;
    for (;;) {
        sum = 0u; cnt = 0u; mine = 0u;
#pragma unroll
        for (unsigned j = 0; j < 16; ++j) { const unsigned c = xb_ld(&bar[XB_XCNT(j)]); sum += c; cnt += (c > 0u) ? 1u : 0u; mine = (j == x) ? c : mine; }
        if (sum == G) break;
        __builtin_amdgcn_s_sleep(1);
        if ((++sp & 255u) == 0u) { if (xb_ld(&bar[XB_TMO])) break; if (sp > XB_SPIN_CAP) { atomicAdd(&bar[XB_TMO], 1u); break; } }
    }
    nloc = mine > 0u ? mine : 1u; nx = cnt > 0u ? cnt : 1u;
}

__device__ __forceinline__ void xcd_barrier(const XcdBarrier& b) {
    asm volatile("s_waitcnt vmcnt(0)" ::: "memory");
    __syncthreads();
    if (threadIdx.x == 0) {
        unsigned* bar = b.bar;
        __builtin_amdgcn_s_waitcnt(0);
        unsigned nloc = b.st[0], nx = b.st[1];
        if (nloc == 0u) { xcd_barrier_complete(bar, b.x, nloc, nx); b.st[0] = nloc; b.st[1] = nx; }
        const unsigned old = xb_add(&bar[XB_XSUB(b.x)], 1u);
        const unsigned gen = old / nloc;
        if (old + 1u == (gen + 1u) * nloc) {
            __builtin_amdgcn_fence(__ATOMIC_RELEASE, "agent");
            asm volatile("s_waitcnt vmcnt(0)" ::: "memory");
            const unsigned og = xb_add(&bar[XB_TOP], 1u);
            const unsigned tg = og / nx;
            if (og + 1u == (tg + 1u) * nx) xb_add(&bar[XB_TOPGEN], 1u);
            else XB_SPIN(xb_ld(&bar[XB_TOPGEN]) == tg, bar);
            __builtin_amdgcn_fence(__ATOMIC_ACQUIRE, "agent");
            xb_add(&bar[XB_XGEN(b.x)], 1u);
            asm volatile("s_waitcnt vmcnt(0)" ::: "memory");
        } else {
            XB_SPIN(xb_ld(&bar[XB_XGEN(b.x)]) == gen, bar);
            __builtin_amdgcn_fence(__ATOMIC_ACQUIRE, "agent");
            asm volatile("s_waitcnt vmcnt(0)" ::: "memory");
        }
    }
    __syncthreads();
}

#define LAUNDER_V(x) asm volatile("" : "+v"(x))
__device__ __forceinline__ float wave_sum(float v) {
#pragma unroll
    for (int o = 1; o < 64; o <<= 1) v += __shfl_xor(v, o);
    return v;
}
__device__ __forceinline__ void p0_transpose_item(const float* W, int K, int N, bf16* WT, LAS float* scr, int item, int lane, int nscale, float scale, const float* kg) {
    const int nblk = N / 64, kb = item / nblk, nb = item % nblk, k0 = 64 * kb, n0 = 64 * nb;
    const int rr = lane >> 4, c4 = (lane & 15) * 4;
    f32x4 v[16];
#pragma unroll
    for (int i = 0; i < 16; ++i) v[i] = *(const GAS f32x4*)(W + (size_t)(k0 + 4 * i + rr) * N + n0 + c4);
#pragma unroll
    for (int i = 0; i < 16; ++i) { const int k = 4 * i + rr; *(LAS f32x4*)(scr + k * 64 + (c4 ^ ((k >> 3) * 4))) = v[i]; }
    LDS_WAIT(); asm volatile("" ::: "memory");
    const int c = lane & 7, nl = lane >> 3;
    f32x4 ga = (f32x4){1.f, 1.f, 1.f, 1.f}, gb = ga;
    if (kg) { ga = *(const GAS f32x4*)(kg + k0 + 8 * c); gb = *(const GAS f32x4*)(kg + k0 + 8 * c + 4); }
#pragma unroll
    for (int j = 0; j < 8; ++j) { const int n = nl + 8 * j; const LAS float* s = scr + (8 * c) * 64 + (n ^ (4 * c));
        const float sc = (n0 + n) < nscale ? scale : 1.f;
        v4u o; o.x = pk2(s[0 * 64] * (sc * ga.x), s[1 * 64] * (sc * ga.y)); o.y = pk2(s[2 * 64] * (sc * ga.z), s[3 * 64] * (sc * ga.w)); o.z = pk2(s[4 * 64] * (sc * gb.x), s[5 * 64] * (sc * gb.y)); o.w = pk2(s[6 * 64] * (sc * gb.z), s[7 * 64] * (sc * gb.w));
        *(GAS v4u*)(WT + (size_t)(n0 + n) * K + k0 + 8 * c) = o; }
    LDS_WAIT(); asm volatile("" ::: "memory");
}
__device__ __forceinline__ void p0_transpose(const float* W, int K, int N, bf16* WT, LAS float* scr, int gw, int NGW, int lane, const float* kg = nullptr, int nscale = 0, float scale = 1.f) {
    LAUNDER_V(lane);
    const int items = (K / 64) * (N / 64);
    for (int it = gw; it < items; it += NGW) p0_transpose_item(W, K, N, WT, scr, it, lane, nscale, scale, kg);
}
__device__ __forceinline__ void x_to_bf16_rows(const float* x, bf16* xb, unsigned long long* ss, int gw, int NGW, int lane) {
    LAUNDER_V(lane);
    for (int m = 2 * gw; m < M; m += 2 * NGW) {
        const GAS f32x4* xr = (const GAS f32x4*)(x + (size_t)m * DM) + lane;
        f32x4 v[16], w[16]; float s = 0.f, t = 0.f;
#pragma unroll
        for (int j = 0; j < 16; ++j) { v[j] = xr[64 * j]; w[j] = xr[DM / 4 + 64 * j]; }
#pragma unroll
        for (int j = 0; j < 16; ++j) { s += (v[j].x * v[j].x + v[j].y * v[j].y) + (v[j].z * v[j].z + v[j].w * v[j].w); t += (w[j].x * w[j].x + w[j].y * w[j].y) + (w[j].z * w[j].z + w[j].w * w[j].w); }
#pragma unroll
        for (int o = 1; o < 64; o <<= 1) { s += __shfl_xor(s, o); t += __shfl_xor(t, o); }
        if (lane == 0) { ss[m] = (unsigned long long)(s * pg8::SS_FIX); ss[m + 1] = (unsigned long long)(t * pg8::SS_FIX); }
        GAS v2u* o8 = (GAS v2u*)(xb + (size_t)m * DM) + lane;
#pragma unroll
        for (int j = 0; j < 16; ++j) { v2u o, q; o.x = pk2(v[j].x, v[j].y); o.y = pk2(v[j].z, v[j].w); o8[64 * j] = o; q.x = pk2(w[j].x, w[j].y); q.y = pk2(w[j].z, w[j].w); o8[DM / 4 + 64 * j] = q; }
    }
}
__device__ __forceinline__ void prep_half_head(const v4u (&w)[12], const LAS float* gl, int half, const float* cs, const float* sn, bf16* dst) {
    float ss = 0.f;
#pragma unroll
    for (int c = 0; c < 12; ++c) { float f[8]; unpack8(w[c], f);
#pragma unroll
        for (int e = 0; e < 8; ++e) ss += f[e] * f[e]; }
    ss += __shfl_xor(ss, 1);
    const float r = 1.f / sqrtf(ss * (1.f / QKD) + EPS);
    const LAS float* g = gl + half * 96;
#pragma unroll
    for (int c = 0; c < 4; ++c) { float f[8]; unpack8(w[c], f); const f32x4 ga = *(const LAS f32x4*)(g + c * 8), gb = *(const LAS f32x4*)(g + c * 8 + 4);
        f[0] *= r * ga.x; f[1] *= r * ga.y; f[2] *= r * ga.z; f[3] *= r * ga.w; f[4] *= r * gb.x; f[5] *= r * gb.y; f[6] *= r * gb.z; f[7] *= r * gb.w;
        *(GAS v4u*)(dst + c * 8) = pack8(f); }
#pragma unroll
    for (int c = 0; c < 4; ++c) { float a[8], b[8], o1[8], o2[8]; unpack8(w[4 + c], a); unpack8(w[8 + c], b);
        const f32x4 ga0 = *(const LAS f32x4*)(g + 32 + c * 8), ga1 = *(const LAS f32x4*)(g + 32 + c * 8 + 4), gb0 = *(const LAS f32x4*)(g + 64 + c * 8), gb1 = *(const LAS f32x4*)(g + 64 + c * 8 + 4);
        const float gA[8] = {ga0.x, ga0.y, ga0.z, ga0.w, ga1.x, ga1.y, ga1.z, ga1.w}, gB[8] = {gb0.x, gb0.y, gb0.z, gb0.w, gb1.x, gb1.y, gb1.z, gb1.w};
#pragma unroll
        for (int e = 0; e < 8; ++e) { const float x1 = a[e] * r * gA[e], x2 = b[e] * r * gB[e]; const float cc = half ? cs[c * 8 + e] : 1.f, s_ = half ? sn[c * 8 + e] : 0.f;
            o1[e] = x1 * cc - x2 * s_; o2[e] = x1 * s_ + x2 * cc; }
        *(GAS v4u*)(dst + (4 + c) * 8) = pack8(o1); *(GAS v4u*)(dst + (8 + c) * 8) = pack8(o2); }
}
__device__ __forceinline__ void prep_qk(const bf16* qraw, const bf16* kvraw, const bf16* proj, const float* gq, const float* gk, const float* ropec, const float* ropes, bf16* Qo, bf16* Ko,
                                        LAS float* gl, int gw, int NGW, int tid) {
    LAUNDER_V(tid);
    if (tid < QKD) { gl[tid] = gq[tid] * Q_SCALE_MLA; gl[QKD + tid] = gk[tid]; }
    __syncthreads();
    const int lane = tid & 63, h = lane >> 1, half = lane & 1;
    for (int m = gw; m < M; m += NGW) {
        const int pos = m & (SEQ - 1);
        const float* cs = ropec + pos * 32; const float* sn = ropes + pos * 32;
        v4u qw[12], kw[12];
        const bf16* qsrc = qraw + (size_t)m * NQ + h * QKD + half * 96;
        const bf16* ksrc = kvraw + (size_t)m * NKV + h * 256 + half * 96;
        const bf16* psrc = proj + (size_t)m * MLA_INP + C_KPE;
#pragma unroll
        for (int c = 0; c < 12; ++c) qw[c] = *(const GAS v4u*)(qsrc + c * 8);
#pragma unroll
        for (int c = 0; c < 12; ++c) kw[c] = (half == 0 || c < 4) ? *(const GAS v4u*)(ksrc + c * 8) : *(const GAS v4u*)(psrc + (c - 4) * 8);
        prep_half_head(qw, gl, half, cs, sn, Qo + (size_t)m * NQ + h * QKD + half * 96);
        prep_half_head(kw, gl + QKD, half, cs, sn, Ko + (size_t)m * NQ + h * QKD + half * 96);
    }
    __syncthreads();
}

template <int MODE>
__device__ __forceinline__ void naive_attn(LAS unsigned char* lds, const bf16* Qp, int qpitch, int qhs, const bf16* Kp, int kpitch, int khs, const bf16* Vp, int vpitch, int vhs,
                                           const bf16* Gp, int gpitch, bf16* Op, int G, int bid, int tid) {
    LAUNDER_V(tid);
    constexpr int DQK = MODE == 0 ? 192 : 128, DP = DQK / 8, KCH = DQK / 8;
    LAS float* Ks = (LAS float*)lds; LAS float* Vs = Ks + 64 * DQK;
    const int r = tid >> 3, c = tid & 7;
    for (int item = bid; item < 128 * 16; item += G) {
        const int bh = item >> 4, pp = item & 15, b = bh >> 5, h = bh & 31;
        for (int pass = 0; pass < 2; ++pass) {
            const int qb = pass ? 31 - pp : pp, t = qb * 64 + r; const size_t mrow = (size_t)b * SEQ + t;
            float q[DP];
#pragma unroll
            for (int j = 0; j < DP / 8; ++j) { float f[8]; unpack8(*(const GAS v4u*)(Qp + mrow * qpitch + h * qhs + c * DP + j * 8), f);
#pragma unroll
                for (int e = 0; e < 8; ++e) q[j * 8 + e] = f[e]; }
            float acc[16];
#pragma unroll
            for (int j = 0; j < 16; ++j) acc[j] = 0.f;
            float m_run = -__builtin_inff(), l = 0.f, suffix = 0.f;
            for (int ti = 0; ti <= qb; ++ti) {
                const int kt = MODE == 0 ? ti : qb - ti;
                __syncthreads();
#pragma unroll
                for (int i2 = 0; i2 < KCH * 64 / 512; ++i2) { const int ch = tid + 512 * i2, key = ch / KCH, cc = ch % KCH; float f[8];
                    unpack8(*(const GAS v4u*)(Kp + ((size_t)b * SEQ + kt * 64 + key) * kpitch + h * khs + cc * 8), f);
                    *(LAS f32x4*)(Ks + key * DQK + cc * 8) = (f32x4){f[0], f[1], f[2], f[3]}; *(LAS f32x4*)(Ks + key * DQK + cc * 8 + 4) = (f32x4){f[4], f[5], f[6], f[7]}; }
#pragma unroll
                for (int i2 = 0; i2 < 2; ++i2) { const int ch = tid + 512 * i2, key = ch >> 4, cc = ch & 15; float f[8];
                    unpack8(*(const GAS v4u*)(Vp + ((size_t)b * SEQ + kt * 64 + key) * vpitch + h * vhs + cc * 8), f);
                    *(LAS f32x4*)(Vs + key * 128 + cc * 8) = (f32x4){f[0], f[1], f[2], f[3]}; *(LAS f32x4*)(Vs + key * 128 + cc * 8 + 4) = (f32x4){f[4], f[5], f[6], f[7]}; }
                __syncthreads();
                for (int kki = 0; kki < 64; ++kki) {
                    const int kk = MODE == 0 ? kki : 63 - kki, s = kt * 64 + kk;
                    float dot = 0.f;
#pragma unroll
                    for (int j = 0; j < DP / 4; ++j) { const f32x4 kv = *(const LAS f32x4*)(Ks + kk * DQK + c * DP + j * 4); dot += q[j * 4] * kv.x + q[j * 4 + 1] * kv.y + q[j * 4 + 2] * kv.z + q[j * 4 + 3] * kv.w; }
                    dot += __shfl_xor(dot, 1); dot += __shfl_xor(dot, 2); dot += __shfl_xor(dot, 4);
                    float vv[16];
#pragma unroll
                    for (int j = 0; j < 4; ++j) { const f32x4 x = *(const LAS f32x4*)(Vs + kk * 128 + c * 16 + j * 4); vv[j * 4] = x.x; vv[j * 4 + 1] = x.y; vv[j * 4 + 2] = x.z; vv[j * 4 + 3] = x.w; }
                    if (MODE == 0) {
                        if (s <= t) { const float mn = fmaxf(m_run, dot), a = exp2f(m_run - mn), p = exp2f(dot - mn); l = l * a + p; m_run = mn;
#pragma unroll
                            for (int j = 0; j < 16; ++j) acc[j] = acc[j] * a + p * vv[j]; }
                    } else {
                        if (s < t) { const float z = dot * 0.6931471805599453f, lb = fminf(z, 0.f) - log1pf(expf(-fabsf(z))), w = expf(lb + suffix); suffix += lb - z;
#pragma unroll
                            for (int j = 0; j < 16; ++j) acc[j] += w * vv[j]; }
                    }
                }
            }
            const float inv = MODE == 0 ? 1.f / l : 1.f;
#pragma unroll
            for (int j = 0; j < 2; ++j) { float g[8], o[8]; unpack8(*(const GAS v4u*)(Gp + mrow * gpitch + h * 128 + c * 16 + j * 8), g);
#pragma unroll
                for (int e = 0; e < 8; ++e) o[e] = acc[j * 8 + e] * inv * g[e] / (1.f + expf(-g[e]));
                *(GAS v4u*)(Op + mrow * DM + h * 128 + c * 16 + j * 8) = pack8(o); }
        }
    }
    __syncthreads();
}


namespace fa {
typedef short bf16x8 __attribute__((ext_vector_type(8)));
typedef short s16x4 __attribute__((ext_vector_type(4)));
typedef float f32x16 __attribute__((ext_vector_type(16)));
#define FA_SBAR() __builtin_amdgcn_sched_barrier(0)
constexpr int SHM_V = 16384;
__device__ __forceinline__ int v_st(int k, int c) { const int kk = (k & ~0xC) | ((k & 4) << 1) | ((k & 8) >> 1); return ((kk >> 3) * 4 + (c >> 5)) * 512 + ((kk & 7) * 32 + (c & 31)) * 2; }
__device__ __forceinline__ int v_rd_base(int lane) { return ((lane & 3) << 3) | (((lane >> 2) & 3) << 6) | (((lane >> 4) & 1) << 5) | (((lane >> 5) & 1) << 8); }
__device__ __forceinline__ unsigned cvtpk(float lo, float hi) { unsigned r; asm volatile("v_cvt_pk_bf16_f32 %0, %1, %2" : "=v"(r) : "v"(lo), "v"(hi)); return r; }
__device__ __forceinline__ bf16x8 pack8p(const f32x16& p, int b) { v4u w = {cvtpk(p[b + 0], p[b + 1]), cvtpk(p[b + 2], p[b + 3]), cvtpk(p[b + 4], p[b + 5]), cvtpk(p[b + 6], p[b + 7])}; return __builtin_bit_cast(bf16x8, w); }
__device__ __forceinline__ float ex2(float x) { return __builtin_amdgcn_exp2f(x); }
__device__ __forceinline__ float lg2(float x) { return __builtin_amdgcn_logf(x); }

template <int MODE>
__device__ __forceinline__ void attn_phase(LAS unsigned char* lds, const bf16* Qp, int qpitch, int qhs, const bf16* Kp, int kpitch, int khs, const bf16* Vp, int vpitch, int vhs,
                                           const bf16* Gp, int gpitch, bf16* Op, int G, int vcu, LAS unsigned* ecnt) {
    constexpr int DQK = MODE == 0 ? 192 : 128, ND = DQK / 16, NDR = ND, KPITCH = DQK * 2, SHM_K = 64 * KPITCH, KP = SHM_K / 8192, VOFF = 3 * SHM_K, VR = MODE == 0 ? 3 : 4, QROFF = VOFF + VR * SHM_V;
    constexpr bool STAG = MODE == 1;
    int tid_l = threadIdx.x; asm volatile("" : "+v"(tid_l));
    const int tid = tid_l, wid = __builtin_amdgcn_readfirstlane(tid >> 6), lane = tid & 63, r32 = lane & 31, hi = lane >> 5;
    const bool late = STAG && wid >= 4;
    unsigned koff[KP], voff[2];
#pragma unroll
    for (int i = 0; i < KP; ++i) { const int L = (wid * KP + i) * 1024 + lane * 16, v = L / KPITCH, sb = L % KPITCH;
        const int swz = MODE == 0 ? (((v >> 1) & 7) << 4) : ((v & 15) << 4), cb = sb ^ swz, vi = v & 31;
        const int key = (v & 32) + (vi & 3) + 4 * (vi >> 3) + 16 * ((vi >> 2) & 1);
        koff[i] = (unsigned)(key * kpitch + (cb >> 1)); }
#pragma unroll
    for (int i = 0; i < 2; ++i) { const int L = (wid * 2 + i) * 1024 + lane * 16, sub = L >> 9, within = L & 511, kk = (sub >> 2) * 8 + (within >> 6);
        const int u = (kk & ~0xC) | ((kk & 4) << 1) | ((kk & 8) >> 1);
        const int key = (u & ~0x18) | ((u & 8) << 1) | ((u & 16) >> 1);
        const int c = (sub & 3) * 32 + ((within & 63) >> 4) * 8;
        voff[i] = (unsigned)(key * vpitch + c); }
    const int kswz = MODE == 0 ? (((r32 >> 1) & 7) << 4) : ((r32 & 15) << 4);
    const int krow = r32 * KPITCH;
    const int vb0 = (int)(uintptr_t)lds + VOFF + v_rd_base(lane);
    LAS unsigned char* qrl = lds + QROFF + wid * 4096 + lane * 16;
    const float NEG_INF = -__builtin_inff();
    constexpr float SB_CUT = -160.f;
    int un = 0;
    if (MODE == 1) { if (tid < 64) ecnt[tid] = 0u; asm volatile("s_waitcnt lgkmcnt(0)\n\ts_barrier" ::: "memory"); }

    for (int item = vcu; item < 512; item += G) {
        const int bh = item >> 2, pp = item & 3, b = bh >> 5, h = bh & 31;
        const bf16* Kh = Kp + (size_t)b * SEQ * kpitch + h * khs; const bf16* Vh = Vp + (size_t)b * SEQ * vpitch + h * vhs;
        for (int pass = 0; pass < 2; ++pass) {
            const int qb = pass ? pp : 7 - pp, qlo = qb * 256 + wid * 32, NT = 4 * (qb + 1), jmax = (qlo + 31) >> 6;
            const size_t mrow = (size_t)b * SEQ + qlo + r32;
            bf16x8 qr[NDR];
#pragma unroll
            for (int d0 = 0; d0 < NDR; ++d0) qr[d0] = *(const bf16x8*)(Qp + mrow * qpitch + h * qhs + d0 * 16 + hi * 8);
            if (MODE == 0) {
#pragma unroll
                for (int d0 = NDR; d0 < ND; ++d0) *(LAS bf16x8*)(qrl + (d0 - NDR) * 1024) = *(const bf16x8*)(Qp + mrow * qpitch + h * qhs + d0 * 16 + hi * 8);
            }
            f32x16 o[4];
#pragma unroll
            for (int d0 = 0; d0 < 4; ++d0) o[d0] = f32x16{};
            float m_reg = -1e30f, l_reg = 0.f, carry = 0.f; bool wdone = false, pend = false;
            bf16x8 pa0, pa1, pa2, pa3;
            LAS unsigned* ebank = ecnt + (un & 1) * 32;
#define FA_DMA(j, kbuf, vbuf) do { const bf16* kb_ = Kh + (size_t)(j) * 64 * kpitch; const bf16* vb_ = Vh + (size_t)(j) * 64 * vpitch; \
            _Pragma("unroll") for (int i_ = 0; i_ < KP; ++i_) __builtin_amdgcn_global_load_lds((const unsigned*)(kb_ + koff[i_]), (LAS unsigned*)(lds + (kbuf) * SHM_K + (wid * KP + i_) * 1024), 16, 0, 0); \
            _Pragma("unroll") for (int i_ = 0; i_ < 2; ++i_) __builtin_amdgcn_global_load_lds((const unsigned*)(vb_ + voff[i_]), (LAS unsigned*)(lds + VOFF + (vbuf) * SHM_V + (wid * 2 + i_) * 1024), 16, 0, 0); } while (0)
#define FA_WAITBAR() asm volatile("s_waitcnt vmcnt(0) lgkmcnt(0)\n\ts_barrier" ::: "memory")
#define FA_WAITBAR1() asm volatile("s_waitcnt vmcnt(%0) lgkmcnt(0)\n\ts_barrier" :: "i"(KP + 2) : "memory")
#define FA_TRRD(dst, off) asm volatile("ds_read_b64_tr_b16 %0, %1 offset:%2" : "=&v"(dst) : "v"(vbase), "i"(off) : "memory")
#define FA_PV_D0(d0) do { s16x4 l0, l1, l2, l3, h0, h1, h2, h3; constexpr int b_ = (d0) * 512; \
            FA_TRRD(l0, b_); FA_TRRD(h0, b_ + 2048); FA_TRRD(l1, b_ + 4096); FA_TRRD(h1, b_ + 6144); FA_TRRD(l2, b_ + 8192); FA_TRRD(h2, b_ + 10240); FA_TRRD(l3, b_ + 12288); FA_TRRD(h3, b_ + 14336); \
            asm volatile("s_waitcnt lgkmcnt(0)" ::: "memory"); FA_SBAR(); \
            o[d0] = __builtin_amdgcn_mfma_f32_32x32x16_bf16((bf16x8){l0[0], l0[1], l0[2], l0[3], h0[0], h0[1], h0[2], h0[3]}, pa0, o[d0], 0, 0, 0); \
            o[d0] = __builtin_amdgcn_mfma_f32_32x32x16_bf16((bf16x8){l1[0], l1[1], l1[2], l1[3], h1[0], h1[1], h1[2], h1[3]}, pa1, o[d0], 0, 0, 0); \
            o[d0] = __builtin_amdgcn_mfma_f32_32x32x16_bf16((bf16x8){l2[0], l2[1], l2[2], l2[3], h2[0], h2[1], h2[2], h2[3]}, pa2, o[d0], 0, 0, 0); \
            o[d0] = __builtin_amdgcn_mfma_f32_32x32x16_bf16((bf16x8){l3[0], l3[1], l3[2], l3[3], h3[0], h3[1], h3[2], h3[3]}, pa3, o[d0], 0, 0, 0); } while (0)
#define FA_PV(vbuf) do { const int vbase = vb0 + (vbuf) * SHM_V; FA_PV_D0(0); FA_PV_D0(1); FA_PV_D0(2); FA_PV_D0(3); } while (0)

            FA_DMA(MODE == 0 ? 0 : NT - 1, 0, 0);
            FA_DMA(MODE == 0 ? 1 : NT - 2, 1, 1);
            FA_WAITBAR1();
            if (MODE == 1) { if (tid < 32) ecnt[((un + 1) & 1) * 32 + tid] = 0u; ++un; }
            int vbuf = 0, kbuf = 0;
            for (int t = 0; t < NT; ++t) {
                const int j = MODE == 0 ? t : NT - 1 - t, vnext = vbuf == VR - 1 ? 0 : vbuf + 1, vprev = vbuf == 0 ? VR - 1 : vbuf - 1, knext = kbuf == 2 ? 0 : kbuf + 1;
                if (t + 2 < NT) { const int jn = MODE == 0 ? t + 2 : NT - 3 - t; const int k2 = knext == 2 ? 0 : knext + 1, v2 = vnext == VR - 1 ? 0 : vnext + 1; FA_DMA(jn, k2, v2); }
                if (late && pend) { FA_PV(vprev); pend = false; }
                if (j <= jmax && !(MODE == 1 && wdone)) {
                    f32x16 p0 = f32x16{}, p1 = f32x16{};
                    const LAS unsigned char* kt_ = lds + kbuf * SHM_K + krow;
#pragma unroll
                    for (int d0 = 0; d0 < ND; ++d0) { const int cb = d0 * 32 + hi * 16; const LAS unsigned char* a = kt_ + (cb ^ kswz);
                        const bf16x8 k0 = *(const LAS bf16x8*)a, k1 = *(const LAS bf16x8*)(a + 32 * KPITCH);
                        const bf16x8 qf = d0 < NDR ? qr[d0 < NDR ? d0 : 0] : *(const LAS bf16x8*)(qrl + (d0 - NDR) * 1024);
                        p0 = __builtin_amdgcn_mfma_f32_32x32x16_bf16(k0, qf, p0, 0, 0, 0); p1 = __builtin_amdgcn_mfma_f32_32x32x16_bf16(k1, qf, p1, 0, 0, 0); }
                    const int kb = j * 64, dq = qlo + r32 - kb - 16 * hi;
                    if (MODE == 0) {
                        if (kb + 63 > qlo) {
#pragma unroll
                            for (int r = 0; r < 16; ++r) { if (r > dq) p0[r] = NEG_INF; if (r + 32 > dq) p1[r] = NEG_INF; } }
                        float pmax = p0[0];
#pragma unroll
                        for (int r = 1; r < 16; ++r) pmax = fmaxf(pmax, p0[r]);
#pragma unroll
                        for (int r = 0; r < 16; ++r) pmax = fmaxf(pmax, p1[r]);
                        { auto rr = __builtin_amdgcn_permlane32_swap(__float_as_uint(pmax), __float_as_uint(pmax), false, false); pmax = fmaxf(__uint_as_float(rr[0]), __uint_as_float(rr[1])); }
                        if (!__all(pmax - m_reg <= 11.5f)) { const float mn = fmaxf(m_reg, pmax), alpha = ex2(m_reg - mn); m_reg = mn; l_reg *= alpha;
#pragma unroll
                            for (int d0 = 0; d0 < 4; ++d0)
#pragma unroll
                                for (int r = 0; r < 16; ++r) o[d0][r] *= alpha; }
                        float ps = 0.f;
#pragma unroll
                        for (int r = 0; r < 16; ++r) { p0[r] = ex2(p0[r] - m_reg); p1[r] = ex2(p1[r] - m_reg); ps += p0[r] + p1[r]; }
                        l_reg += ps;
                    } else {
                        f32x16 e0, e1;
#pragma unroll
                        for (int r = 0; r < 16; ++r) { const float t0 = p0[r], t1 = p1[r];
                            const float b0 = fminf(t0, 0.f) - lg2(1.f + ex2(-fabsf(t0))), b1 = fminf(t1, 0.f) - lg2(1.f + ex2(-fabsf(t1)));
                            p0[r] = b0; e0[r] = b0 - t0; p1[r] = b1; e1[r] = b1 - t1; }
                        if (kb + 63 >= qlo) {
#pragma unroll
                            for (int r = 0; r < 16; ++r) { if (r >= dq) { p0[r] = NEG_INF; e0[r] = 0.f; } if (r + 32 >= dq) { p1[r] = NEG_INF; e1[r] = 0.f; } } }
                        float s0 = 0.f, s1 = 0.f;
#pragma unroll
                        for (int r = 15; r >= 0; --r) { const float x0 = e0[r], x1 = e1[r]; e0[r] = s0; e1[r] = s1; s0 += x0; s1 += x1; }
                        const auto r1 = __builtin_amdgcn_permlane32_swap(__float_as_uint(s0), __float_as_uint(s1), false, false);
                        const auto r2 = __builtin_amdgcn_permlane32_swap(__float_as_uint(s1), __float_as_uint(s0), false, false);
                        const float ps0 = __uint_as_float(hi ? r2[0] : r1[1]), ps1 = __uint_as_float(hi ? r1[0] : r2[1]);
                        const float off1 = carry + (hi ? 0.f : ps1), off0 = carry + s1 + ps1 + (hi ? 0.f : ps0);
                        carry += (s0 + s1) + (ps0 + ps1);
#pragma unroll
                        for (int r = 0; r < 16; ++r) { p0[r] = ex2(p0[r] + (e0[r] + off0)); p1[r] = ex2(p1[r] + (e1[r] + off1)); }
                        if (__all(carry < SB_CUT)) wdone = true;
                    }
                    pa0 = pack8p(p0, 0); pa1 = pack8p(p0, 8); pa2 = pack8p(p1, 0); pa3 = pack8p(p1, 8);
                    if (late) pend = true; else FA_PV(vbuf);
                }
                if (MODE == 1 && wdone && lane == 0) __hip_atomic_fetch_add(ebank + t, 1u, __ATOMIC_RELAXED, __HIP_MEMORY_SCOPE_WORKGROUP);
                if (t + 2 < NT) FA_WAITBAR1(); else FA_WAITBAR();
                if (MODE == 1) { if (*(volatile LAS unsigned*)(ebank + t) == 8u) { vbuf = vnext; break; } }
                vbuf = vnext; kbuf = knext;
            }
            if (late && pend) { const int vprev = vbuf == 0 ? VR - 1 : vbuf - 1; FA_PV(vprev); pend = false; }
            float inv = 1.f;
            if (MODE == 0) { auto rr = __builtin_amdgcn_permlane32_swap(__float_as_uint(l_reg), __float_as_uint(l_reg), false, false); inv = 1.f / (__uint_as_float(rr[0]) + __uint_as_float(rr[1])); }
            int lane_e = lane; asm volatile("" : "+v"(lane_e));
            const size_t mrow_e = (size_t)b * SEQ + qlo + (lane_e & 31);
            const bf16* grow = Gp + mrow_e * gpitch + h * 128 + 4 * (lane_e >> 5); bf16* orow = Op + mrow_e * DM + h * 128 + 4 * (lane_e >> 5);
#pragma unroll
            for (int d0 = 0; d0 < 4; ++d0)
#pragma unroll
                for (int g4 = 0; g4 < 4; ++g4) { const v2u gw2 = *(const GAS v2u*)(grow + d0 * 32 + g4 * 8);
                    const float g0 = bf_lo(gw2.x), g1 = bf_hi(gw2.x), g2 = bf_lo(gw2.y), g3 = bf_hi(gw2.y);
                    const float y0 = o[d0][g4 * 4 + 0] * inv * g0 * __builtin_amdgcn_rcpf(1.f + ex2(-1.4426950408889634f * g0)), y1 = o[d0][g4 * 4 + 1] * inv * g1 * __builtin_amdgcn_rcpf(1.f + ex2(-1.4426950408889634f * g1));
                    const float y2 = o[d0][g4 * 4 + 2] * inv * g2 * __builtin_amdgcn_rcpf(1.f + ex2(-1.4426950408889634f * g2)), y3 = o[d0][g4 * 4 + 3] * inv * g3 * __builtin_amdgcn_rcpf(1.f + ex2(-1.4426950408889634f * g3));
                    v2u w; w.x = cvtpk(y0, y1); w.y = cvtpk(y2, y3); *(GAS v2u*)(orow + d0 * 32 + g4 * 8) = w; }
            asm volatile("s_waitcnt lgkmcnt(0)\n\ts_barrier" ::: "memory");
        }
    }
#undef FA_DMA
#undef FA_WAITBAR
#undef FA_WAITBAR1
#undef FA_TRRD
#undef FA_PV_D0
#undef FA_PV
}
}
struct Args { const float* in[13]; float* out; unsigned char* ws; int ph_lo, ph_hi; };
__global__ void __launch_bounds__(NWAVES * 64, 2) hybrid_fwd(Args args) {
    extern __shared__ __attribute__((aligned(16))) unsigned char lds_raw[];
    LAS unsigned char* lds = (LAS unsigned char*)lds_raw;
    volatile LAS unsigned* MISC = (volatile LAS unsigned*)(lds + MISC_OFF);
    const int tid = threadIdx.x, lane = tid & 63, wave = __builtin_amdgcn_readfirstlane(tid >> 6);
    const int G = gridDim.x, bx = blockIdx.x;
    const int vcu = (G % 8 == 0) ? (bx % 8) * (G / 8) + bx / 8 : bx;
    const int gw = vcu * NWAVES + wave, NGW = G * NWAVES;
    unsigned char* ws = args.ws;
    gu32* ctl = (gu32*)(ws + WS_CTL);
    for (int u = tid; u < (LDS_BYTES - LDSCTL_OFF) / 4; u += NWAVES * 64) ((LAS unsigned*)(lds + LDSCTL_OFF))[u] = 0u;
    __syncthreads();
#if MK_ONE_LAUNCH
    XcdBarrier bar = xcd_barrier_post((unsigned*)(ctl + CW_BAR), MISC + 8);
#define GRID_BAR() xcd_barrier(bar)
#else
    (void)MISC; (void)ctl;
#define GRID_BAR() do { } while (0)
#endif
    const int lo = args.ph_lo, hi = args.ph_hi;
#define IN(k) (lo <= (k) && (k) < hi)
#define SEAM(k) do { if (IN(k) && IN((k) + 1)) GRID_BAR(); } while (0)
    const float* x_in = args.in[0]; float* out = args.out;
    float* ropec = (float*)(ws + WS_ROPE); float* ropes = ropec + SEQ * 32;
    bf16* XB = (bf16*)(ws + A_XN); bf16* PROJ = (bf16*)(ws + A_PROJ);
    bf16* QRAW = (bf16*)(ws + A_QRAW); bf16* KVRAW = (bf16*)(ws + A_KVRAW); bf16* Qb = (bf16*)(ws + A_Q); bf16* Kb = (bf16*)(ws + A_K); bf16* OG = (bf16*)(ws + A_OG);
    unsigned long long* SSX = (unsigned long long*)(ws + WS_SS);
    unsigned long long* SSQ = SSX + 4 * M; unsigned long long* SSKV = SSX + 6 * M;

    if (IN(0)) {
        LAS float* scr = (LAS float*)(lds + RING_OFF + wave * 16384);
        x_to_bf16_rows(x_in, XB, SSX, gw, NGW, lane);
        for (int j = 0; j < 2; ++j) {
            unsigned char* wl = ws + WS_W + (size_t)j * W_LAYER;
            p0_transpose(args.in[2] + (size_t)j * DM * MLA_IN, DM, MLA_IN, (bf16*)(wl + W_IN_MLA), scr, gw, NGW, lane, args.in[1] + (size_t)j * DM);
            p0_transpose(args.in[4] + (size_t)j * QL * NQ, QL, NQ, (bf16*)(wl + W_QB), scr, gw, NGW, lane, args.in[3] + (size_t)j * QL);
            p0_transpose(args.in[6] + (size_t)j * KVL * NKV, KVL, NKV, (bf16*)(wl + W_KVB), scr, gw, NGW, lane, args.in[5] + (size_t)j * KVL);
            p0_transpose(args.in[9] + (size_t)j * DM * DM, DM, DM, (bf16*)(wl + W_OUT_MLA), scr, gw, NGW, lane);
            p0_transpose(args.in[11] + (size_t)j * DM * SB_IN, DM, SB_IN, (bf16*)(wl + W_IN_SB), scr, gw, NGW, lane, args.in[10] + (size_t)j * DM, DM, Q_SCALE_SB);
            p0_transpose(args.in[12] + (size_t)j * DM * DM, DM, DM, (bf16*)(wl + W_OUT_SB), scr, gw, NGW, lane);
            GAS v4u* pad = (GAS v4u*)(wl + W_IN_MLA + (size_t)MLA_IN * DM * 2);
            for (int i = vcu * 512 + tid; i < (MLA_INP - MLA_IN) * DM * 2 / 16; i += G * 512) pad[i] = (v4u){0u, 0u, 0u, 0u};
        }
        for (int i = vcu * 512 + tid; i < SEQ * 32; i += G * 512) { const int pos = i >> 5, p = i & 31;
            const float inv = 1.0f / powf(10000.0f, (float)(2 * p) / 64.0f), ang = (float)pos * inv; ropec[i] = cosf(ang); ropes[i] = sinf(ang); }
    }
    SEAM(0);

    for (int L = 0; L < 2; ++L) {
        const int pb = 1 + 8 * L;
        unsigned char* wl = ws + WS_W + (size_t)L * W_LAYER;
        const float* xa = (L == 0) ? x_in : (const float*)out;
        if (IN(pb + 0)) { pg8::Gemm g{XB, (const bf16*)(wl + W_IN_MLA), M, MLA_INP, DM, DM}; pg8::StaticOrder S; S.init(M, MLA_INP, G, bx);
            pg8::EpiBf16S<1> E{PROJ, MLA_INP, SSX + (size_t)(2 * L) * M, 1.f / DM, SSQ + (size_t)L * M, SSKV + (size_t)L * M};
            pg8::gemm_phase<pg8::EpiBf16S<1>, pg8::StaticOrder, PG8_ALIGN, PG8_SP2>(lds + RING_OFF, g, S, E); }
        SEAM(pb + 0);
        if (IN(pb + 1)) {
            { pg8::Gemm g{PROJ, (const bf16*)(wl + W_QB), M, NQ, QL, MLA_INP}; pg8::StaticOrder S; S.init(M, NQ, G, bx);
              pg8::EpiBf16S<0> E{QRAW, NQ, SSQ + (size_t)L * M, 1.f / QL, nullptr, nullptr}; pg8::gemm_phase<pg8::EpiBf16S<0>, pg8::StaticOrder, PG8_ALIGN, PG8_SP2>(lds + RING_OFF, g, S, E); }
            { pg8::Gemm g{PROJ + C_KVLAT, (const bf16*)(wl + W_KVB), M, NKV, KVL, MLA_INP}; pg8::StaticOrder S; S.init(M, NKV, G, bx);
              pg8::EpiBf16S<0> E{KVRAW, NKV, SSKV + (size_t)L * M, 1.f / KVL, nullptr, nullptr}; pg8::gemm_phase<pg8::EpiBf16S<0>, pg8::StaticOrder, PG8_ALIGN, PG8_SP2>(lds + RING_OFF, g, S, E); }
        }
        SEAM(pb + 1);
        if (IN(pb + 2)) prep_qk(QRAW, KVRAW, PROJ, args.in[7] + (size_t)L * QKD, args.in[8] + (size_t)L * QKD, ropec, ropes, Qb, Kb, (LAS float*)(lds + RING_OFF), gw, NGW, tid);
        SEAM(pb + 2);
#if FAST_ATTN_MLA
        if (IN(pb + 3)) fa::attn_phase<0>(lds, Qb, NQ, QKD, Kb, NQ, QKD, KVRAW + 128, NKV, 256, PROJ + C_GATE, MLA_INP, OG, G, vcu, (LAS unsigned*)(lds + LDSCTL_OFF));
#else
        if (IN(pb + 3)) naive_attn<0>(lds, Qb, NQ, QKD, Kb, NQ, QKD, KVRAW + 128, NKV, 256, PROJ + C_GATE, MLA_INP, OG, G, bx, tid);
#endif
        SEAM(pb + 3);
        if (IN(pb + 4)) { pg8::Gemm g{OG, (const bf16*)(wl + W_OUT_MLA), M, DM, DM, DM}; pg8::StaticOrder S; S.init(M, DM, G, bx);
            pg8::EpiResF32X E{xa, out, DM, XB, SSX + (size_t)(2 * L + 1) * M}; pg8::gemm_phase<pg8::EpiResF32X, pg8::StaticOrder, PG8_ALIGN, PG8_SP2>(lds + RING_OFF, g, S, E); }
        SEAM(pb + 4);
        if (IN(pb + 5)) { pg8::Gemm g{XB, (const bf16*)(wl + W_IN_SB), M, SB_IN, DM, DM}; pg8::StaticOrder S; S.init(M, SB_IN, G, bx);
            pg8::EpiBf16S<0> E{PROJ, SB_IN, SSX + (size_t)(2 * L + 1) * M, 1.f / DM, nullptr, nullptr}; pg8::gemm_phase<pg8::EpiBf16S<0>, pg8::StaticOrder, PG8_ALIGN, PG8_SP2>(lds + RING_OFF, g, S, E); }
        SEAM(pb + 5);
#if FAST_ATTN_SB
        if (IN(pb + 6)) fa::attn_phase<1>(lds, PROJ, SB_IN, 128, PROJ + C_SBK, SB_IN, 128, PROJ + C_SBV, SB_IN, 128, PROJ + C_SBG, SB_IN, OG, G, vcu, (LAS unsigned*)(lds + LDSCTL_OFF));
#else
        if (IN(pb + 6)) naive_attn<1>(lds, PROJ, SB_IN, 128, PROJ + C_SBK, SB_IN, 128, PROJ + C_SBV, SB_IN, 128, PROJ + C_SBG, SB_IN, OG, G, bx, tid);
#endif
        SEAM(pb + 6);
        if (IN(pb + 7)) { pg8::Gemm g{OG, (const bf16*)(wl + W_OUT_SB), M, DM, DM, DM}; pg8::StaticOrder S; S.init(M, DM, G, bx);
            pg8::EpiResF32X E{out, out, DM, (L == 0) ? XB : (bf16*)nullptr, SSX + (size_t)2 * M}; pg8::gemm_phase<pg8::EpiResF32X, pg8::StaticOrder, PG8_ALIGN, PG8_SP2>(lds + RING_OFF, g, S, E); }
        SEAM(pb + 7);
    }
#undef IN
#undef SEAM
}

extern "C" void kernel_launch(void* const* d_in, const int* in_sizes, int n_in, void* d_out, int out_size, void* d_ws, size_t ws_size, hipStream_t stream) {
    static int grid = 0;
    if (grid == 0) {
        if (n_in != 13 || in_sizes[0] != M * DM || out_size != M * DM || ws_size < WS_END) { fprintf(stderr, "kernel_launch: unexpected shapes (n_in %d, in0 %d, out %d, ws %zu; need ws >= %zu); nothing launched\n", n_in, n_in > 0 ? in_sizes[0] : -1, out_size, ws_size, (size_t)WS_END); grid = -1; return; }
        int dev = 0, cus = 0, per_cu = 0;
        if (hipGetDevice(&dev) != hipSuccess || hipDeviceGetAttribute(&cus, hipDeviceAttributeMultiprocessorCount, dev) != hipSuccess) { fprintf(stderr, "kernel_launch: device query failed\n"); grid = -1; return; }
        if (hipFuncSetAttribute((const void*)hybrid_fwd, hipFuncAttributeMaxDynamicSharedMemorySize, LDS_BYTES) != hipSuccess) { fprintf(stderr, "kernel_launch: hipFuncSetAttribute failed\n"); grid = -1; return; }
        if (hipOccupancyMaxActiveBlocksPerMultiprocessor(&per_cu, (const void*)hybrid_fwd, NWAVES * 64, LDS_BYTES) != hipSuccess || per_cu < 1)
            fprintf(stderr, "kernel_launch: note: occupancy query reports %d workgroups per CU\n", per_cu);
        (void)hipGetLastError();
        grid = cus;
    }
    if (grid < 0) return;
    if (hipMemsetAsync((char*)d_ws + WS_CTL, 0, CTL_ZERO_BYTES, stream) != hipSuccess) { fprintf(stderr, "kernel_launch: memset failed\n"); return; }
    Args a{};
    for (int i = 0; i < 13; ++i) a.in[i] = (const float*)d_in[i];
    a.out = (float*)d_out; a.ws = (unsigned char*)d_ws;
#if MK_ONE_LAUNCH
    a.ph_lo = 0; a.ph_hi = N_PHASES;
    hipLaunchKernelGGL(hybrid_fwd, dim3(grid), dim3(NWAVES * 64), LDS_BYTES, stream, a);
#ifdef PROBE_PHASES
    { static const int probe_ph[] = {PROBE_PHASES};
      for (int r = 0; r < PROBE_NREP; ++r) for (int ph : probe_ph) { a.ph_lo = ph; a.ph_hi = ph + 1; hipLaunchKernelGGL(hybrid_fwd, dim3(grid), dim3(NWAVES * 64), LDS_BYTES, stream, a); } }
#endif
#else
    for (int ph = 0; ph < N_PHASES; ++ph) { a.ph_lo = ph; a.ph_hi = ph + 1; hipLaunchKernelGGL(hybrid_fwd, dim3(grid), dim3(NWAVES * 64), LDS_BYTES, stream, a); }
#endif
    const hipError_t le = hipPeekAtLastError();
    if (le != hipSuccess) fprintf(stderr, "kernel_launch: launch failed: %s\n", hipGetErrorName(le));
}
```

```cpp
#include <hip/hip_runtime.h>
#include <cstdio>
#include <cstdint>
namespace pg8 {
#define PG8_LAS __attribute__((address_space(3)))
typedef unsigned short bf16_t;
typedef short bf16x8 __attribute__((ext_vector_type(8)));
typedef float f32x4 __attribute__((ext_vector_type(4)));
typedef unsigned u32x4 __attribute__((ext_vector_type(4)));
constexpr int BM = 256, BK = 64, HALF = 128, HTB = HALF * BK * 2  , STAGE_BYTES = 8 * HTB, NXCD = 8, WGM = 8;

__host__ __device__ __forceinline__ int lds_byte(int r, int c) { const int st = (r >> 4) * 2 + (c >> 5), rr = r & 15, cc = c & 31, ob = rr * 64 + cc * 2; return st * 1024 + (ob ^ (((ob >> 9) & 1) << 5)); }
__host__ __device__ __forceinline__ void stage_rc(int b, int& R, int& C) { const int st = b / 1024, sb = b % 1024, swz = sb ^ (((sb >> 9) & 1) << 5); R = (st >> 1) * 16 + swz / 64; C = (st & 1) * 32 + (swz % 64) / 2; }
__host__ __device__ __forceinline__ int perm32(int rho) { const int n = rho >> 4, i = rho & 15; return 8 * (i >> 2) + 4 * n + (i & 3); }

struct Unit { int pm, pn; };
struct Gemm { const bf16_t* A; const bf16_t* Bt; int M, N, K, lda; };

struct StaticOrder {
    int nM, nN, nwg, G, c;
    __host__ __device__ void init(int M, int N, int G_, int c_) { nM = M / BM; nN = N / BM; nwg = nM * nN; G = G_; c = c_; }
    __host__ __device__ bool next(int i, Unit& u) const {
        const long L = (long)i * G + c; if (L >= nwg) return false;
        int wgid = (int)L; { const int q = nwg / NXCD, r = nwg % NXCD, xcd = wgid % NXCD, off = wgid / NXCD; wgid = (xcd < r ? xcd * (q + 1) : r * (q + 1) + (xcd - r) * q) + off; }
        const int nig = WGM * nN, gid = wgid / nig, fm = gid * WGM, gsz = (nM - fm) < WGM ? (nM - fm) : WGM;
        u.pm = fm + ((wgid % nig) % gsz); u.pn = (wgid % nig) / gsz; return true;
    }
    __device__ __forceinline__ void a_ready(const Unit&) const {}
    __device__ __forceinline__ void done(const Unit&) const {}
};

__device__ __forceinline__ unsigned cvt_pk_bf16(float lo, float hi) { unsigned r; asm volatile("v_cvt_pk_bf16_f32 %0, %1, %2" : "=v"(r) : "v"(lo), "v"(hi)); return r; }
struct EpiBf16 {
    static constexpr bool PERM = true, AFTER_DRAIN = false;
    bf16_t* O; int ldc;
    __device__ __forceinline__ void operator()(const f32x4 (&acc)[2][2][4][2], const Unit& u, int wr, int wc, int fr, int fq) const {
        const int row0 = u.pm * BM + wr * 64 + fr; const int col0 = u.pn * BM + wc * 32 + 8 * fq;
#pragma unroll
        for (int ai = 0; ai < 2; ++ai)
#pragma unroll
            for (int m = 0; m < 4; ++m) { bf16_t* rowp = O + (size_t)(row0 + ai * HALF + m * 16) * ldc + col0;
#pragma unroll
                for (int bj = 0; bj < 2; ++bj) { const f32x4 v0 = acc[ai][bj][m][0], v1 = acc[ai][bj][m][1];
                    u32x4 w; w.x = cvt_pk_bf16(v0[0], v0[1]); w.y = cvt_pk_bf16(v0[2], v0[3]); w.z = cvt_pk_bf16(v1[0], v1[1]); w.w = cvt_pk_bf16(v1[2], v1[3]);
                    *(u32x4*)(rowp + bj * HALF) = w; } }
    }
};
struct EpiResF32 {
    static constexpr bool PERM = true, AFTER_DRAIN = false;
    const float* base; float* out; int ldc;
    __device__ __forceinline__ void operator()(const f32x4 (&acc)[2][2][4][2], const Unit& u, int wr, int wc, int fr, int fq) const {
        const int row0 = u.pm * BM + wr * 64 + fr; const int col0 = u.pn * BM + wc * 32 + 8 * fq;
#pragma unroll
        for (int ai = 0; ai < 2; ++ai)
#pragma unroll
            for (int m = 0; m < 4; ++m) { const size_t off = (size_t)(row0 + ai * HALF + m * 16) * ldc + col0;
#pragma unroll
                for (int bj = 0; bj < 2; ++bj) {
                    const f32x4 b0 = *(const f32x4*)(base + off + bj * HALF), b1 = *(const f32x4*)(base + off + bj * HALF + 4);
                    *(f32x4*)(out + off + bj * HALF) = b0 + acc[ai][bj][m][0]; *(f32x4*)(out + off + bj * HALF + 4) = b1 + acc[ai][bj][m][1]; } }
    }
};

constexpr float SS_FIX = 1048576.f, SS_UNFIX = 1.f / 1048576.f;
__device__ __forceinline__ float rstd_of(const unsigned long long* ss, int row, float inv_n) { return 1.f / sqrtf((float)ss[row] * (SS_UNFIX * inv_n) + 1e-6f); }
__device__ __forceinline__ void ss_add(unsigned long long* ss, int row, float part, int fq) {
    part += __shfl_xor(part, 16); part += __shfl_xor(part, 32);
    if (fq == 0) atomicAdd(ss + row, (unsigned long long)(part * SS_FIX));
}
template <int SSMODE> struct EpiBf16S {
    static constexpr bool PERM = true, AFTER_DRAIN = false;
    bf16_t* O; int ldc; const unsigned long long* ss_in; float inv_n; unsigned long long* ss1; unsigned long long* ss2;
    __device__ __forceinline__ void operator()(const f32x4 (&acc)[2][2][4][2], const Unit& u, int wr, int wc, int fr, int fq) const {
        const int row0 = u.pm * BM + wr * 64 + fr; const int col0 = u.pn * BM + wc * 32 + 8 * fq;
#pragma unroll
        for (int ai = 0; ai < 2; ++ai)
#pragma unroll
            for (int m = 0; m < 4; ++m) { const int row = row0 + ai * HALF + m * 16; const float rs = rstd_of(ss_in, row, inv_n); bf16_t* rowp = O + (size_t)row * ldc + col0; float part = 0.f;
#pragma unroll
                for (int bj = 0; bj < 2; ++bj) { const f32x4 v0 = acc[ai][bj][m][0] * rs, v1 = acc[ai][bj][m][1] * rs;
                    if (SSMODE == 1) part += (v0[0] * v0[0] + v0[1] * v0[1]) + (v0[2] * v0[2] + v0[3] * v0[3]) + (v1[0] * v1[0] + v1[1] * v1[1]) + (v1[2] * v1[2] + v1[3] * v1[3]);
                    u32x4 w; w.x = cvt_pk_bf16(v0[0], v0[1]); w.y = cvt_pk_bf16(v0[2], v0[3]); w.z = cvt_pk_bf16(v1[0], v1[1]); w.w = cvt_pk_bf16(v1[2], v1[3]);
                    *(u32x4*)(rowp + bj * HALF) = w; }
                if (SSMODE == 1) { if (u.pn < 6) ss_add(u.pn < 4 ? ss1 : ss2, row, part, fq); } }
    }
};
struct EpiResF32X {
    static constexpr bool PERM = true, AFTER_DRAIN = false;
    const float* base; float* out; int ldc; bf16_t* xb; unsigned long long* ss;
    __device__ __forceinline__ void operator()(const f32x4 (&acc)[2][2][4][2], const Unit& u, int wr, int wc, int fr, int fq) const {
        const int row0 = u.pm * BM + wr * 64 + fr; const int col0 = u.pn * BM + wc * 32 + 8 * fq;
#pragma unroll
        for (int ai = 0; ai < 2; ++ai)
#pragma unroll
            for (int m = 0; m < 4; ++m) { const int row = row0 + ai * HALF + m * 16; const size_t off = (size_t)row * ldc + col0; float part = 0.f;
#pragma unroll
                for (int bj = 0; bj < 2; ++bj) {
                    const f32x4 b0 = *(const f32x4*)(base + off + bj * HALF), b1 = *(const f32x4*)(base + off + bj * HALF + 4);
                    const f32x4 o0 = b0 + acc[ai][bj][m][0], o1 = b1 + acc[ai][bj][m][1];
                    *(f32x4*)(out + off + bj * HALF) = o0; *(f32x4*)(out + off + bj * HALF + 4) = o1;
                    if (xb) { part += (o0[0] * o0[0] + o0[1] * o0[1]) + (o0[2] * o0[2] + o0[3] * o0[3]) + (o1[0] * o1[0] + o1[1] * o1[1]) + (o1[2] * o1[2] + o1[3] * o1[3]);
                        u32x4 w; w.x = cvt_pk_bf16(o0[0], o0[1]); w.y = cvt_pk_bf16(o0[2], o0[3]); w.z = cvt_pk_bf16(o1[0], o1[1]); w.w = cvt_pk_bf16(o1[2], o1[3]);
                        *(u32x4*)(xb + off + bj * HALF) = w; } }
                if (xb) ss_add(ss, row, part, fq); }
    }
};

struct EpiKV {
    static constexpr bool PERM = true, AFTER_DRAIN = false;
    bf16_t* O; int ldc; const unsigned long long* ss_in; float inv_n; float* sskp;
    __device__ __forceinline__ void operator()(const f32x4 (&acc)[2][2][4][2], const Unit& u, int wr, int wc, int fr, int fq) const {
        const int row0 = u.pm * BM + wr * 64 + fr; const int col0 = u.pn * BM + wc * 32 + 8 * fq;
#pragma unroll
        for (int ai = 0; ai < 2; ++ai)
#pragma unroll
            for (int m = 0; m < 4; ++m) { const int row = row0 + ai * HALF + m * 16; const float rs = rstd_of(ss_in, row, inv_n); bf16_t* rowp = O + (size_t)row * ldc + col0; float part = 0.f;
#pragma unroll
                for (int bj = 0; bj < 2; ++bj) { const f32x4 v0 = acc[ai][bj][m][0] * rs, v1 = acc[ai][bj][m][1] * rs;
                    if (bj == 0) part = (v0[0] * v0[0] + v0[1] * v0[1]) + (v0[2] * v0[2] + v0[3] * v0[3]) + (v1[0] * v1[0] + v1[1] * v1[1]) + (v1[2] * v1[2] + v1[3] * v1[3]);
                    u32x4 w; w.x = cvt_pk_bf16(v0[0], v0[1]); w.y = cvt_pk_bf16(v0[2], v0[3]); w.z = cvt_pk_bf16(v1[0], v1[1]); w.w = cvt_pk_bf16(v1[2], v1[3]);
                    *(u32x4*)(rowp + bj * HALF) = w; }
                part += __shfl_xor(part, 16); part += __shfl_xor(part, 32);
                if (fq == 0) sskp[((size_t)row * 32 + u.pn) * 4 + wc] = part; }
    }
};

template <class Epi, class Sched, bool ALIGN_EPI = false, bool SP2 = false>
__device__ __forceinline__ void gemm_phase(PG8_LAS unsigned char* lds, const Gemm g, const Sched& S, const Epi& E) {
    int tid_l = threadIdx.x; asm volatile("" : "+v"(tid_l));
    const int tid = tid_l, wid = __builtin_amdgcn_readfirstlane(tid >> 6), lane = tid & 63, wr = wid >> 2, wc = wid & 3, fr = lane & 15, fq = lane >> 4;
    const int K = g.K, nt = K / BK;
    unsigned voffA[2], voffB[2];
#pragma unroll
    for (int i = 0; i < 2; ++i) { int R, C; stage_rc(tid * 16 + i * 8192, R, C); const int Rb = Epi::PERM ? ((R & ~31) + perm32(R & 31)) : R;
        voffA[i] = (unsigned)(R * g.lda + C) * 2u; voffB[i] = (unsigned)(Rb * K + C) * 2u; }
    const size_t kstep = (size_t)(BK * 2);
    const size_t hstep = (size_t)HALF * K * 2;
    const size_t tstep = 2 * hstep;
    const size_t hstepA = (size_t)HALF * g.lda * 2, tstepA = 2 * hstepA;
    const unsigned ldsw = (unsigned)wid * 1024u;
    const int aoff = lds_byte(wr * 64 + fr, fq * 8), boff = lds_byte(wc * 32 + fr, fq * 8);
#define PG8_SA(b, h) (((b) * 2 + (h)) * HTB)
#define PG8_SB(b, h) ((4 + (b) * 2 + (h)) * HTB)
#define PG8_STAGE(bufoff, gbase, voff) do { _Pragma("unroll") for (int _i = 0; _i < 2; ++_i) \
        __builtin_amdgcn_global_load_lds((const unsigned*)((const char*)(gbase) + (voff)[_i]), (PG8_LAS unsigned*)(lds + (bufoff) + ldsw + _i * 8192), 16, 0, 0); } while (0)
#define PG8_LDA(dst, b, h) do { _Pragma("unroll") for (int m = 0; m < 4; ++m) _Pragma("unroll") for (int k = 0; k < 2; ++k) dst[m][k] = *(const PG8_LAS bf16x8*)(lds + PG8_SA(b, h) + aoff + m * 2048 + k * 1024); } while (0)
#define PG8_LDB(dst, b, h) do { _Pragma("unroll") for (int n = 0; n < 2; ++n) _Pragma("unroll") for (int k = 0; k < 2; ++k) dst[n][k] = *(const PG8_LAS bf16x8*)(lds + PG8_SB(b, h) + boff + n * 2048 + k * 1024); } while (0)
#define PG8_MMA(ai, bj, At, Bt) do { __builtin_amdgcn_s_setprio(1); _Pragma("unroll") for (int m = 0; m < 4; ++m) _Pragma("unroll") for (int n = 0; n < 2; ++n) _Pragma("unroll") for (int k = 0; k < 2; ++k) \
        acc[ai][bj][m][n] = __builtin_amdgcn_mfma_f32_16x16x32_bf16(Bt[n][k], At[m][k], acc[ai][bj][m][n], 0, 0, 0); __builtin_amdgcn_s_setprio(0); } while (0)
#define PG8_WAIT_V(n) asm volatile("s_waitcnt vmcnt(" #n ")" ::: "memory")
#define PG8_WAIT_L(n) asm volatile("s_waitcnt lgkmcnt(" #n ")" ::: "memory")
#define PG8_BAR __builtin_amdgcn_s_barrier()
#define PG8_SCHED __builtin_amdgcn_sched_barrier(0)
    Unit cur, nxt; int ui = 0;
    if (!S.next(0, cur)) return;
    f32x4 acc[2][2][4][2];
#pragma unroll
    for (int a = 0; a < 2; ++a)
#pragma unroll
        for (int b = 0; b < 2; ++b)
#pragma unroll
            for (int m = 0; m < 4; ++m)
#pragma unroll
                for (int n = 0; n < 2; ++n) acc[a][b][m][n] = (f32x4){0.f, 0.f, 0.f, 0.f};
    bf16x8 At[4][2], B0[2][2], B1[2][2];
    const char* cA = (const char*)g.A + (size_t)cur.pm * tstepA; const char* cB = (const char*)g.Bt + (size_t)cur.pn * tstep;
    S.a_ready(cur);
    if constexpr (SP2) {
        PG8_STAGE(PG8_SB(0, 0), cB, voffB); PG8_STAGE(PG8_SB(0, 1), cB + hstep, voffB); PG8_STAGE(PG8_SA(0, 0), cA, voffA); PG8_STAGE(PG8_SA(0, 1), cA + hstepA, voffA);
        if (wr == 1) PG8_BAR;
        PG8_WAIT_V(2); PG8_BAR;
        PG8_STAGE(PG8_SB(1, 0), cB + kstep, voffB); PG8_STAGE(PG8_SA(1, 0), cA + kstep, voffA); PG8_STAGE(PG8_SB(1, 1), cB + hstep + kstep, voffB);
        PG8_WAIT_V(6); PG8_BAR;
    } else {
        PG8_STAGE(PG8_SB(0, 0), cB, voffB); PG8_STAGE(PG8_SA(0, 0), cA, voffA); PG8_STAGE(PG8_SB(0, 1), cB + hstep, voffB); PG8_STAGE(PG8_SA(0, 1), cA + hstepA, voffA);
        if (wr == 1) PG8_BAR;
        PG8_WAIT_V(4); PG8_BAR;
        PG8_STAGE(PG8_SB(1, 0), cB + kstep, voffB); PG8_STAGE(PG8_SA(1, 0), cA + kstep, voffA); PG8_STAGE(PG8_SB(1, 1), cB + hstep + kstep, voffB);
        PG8_WAIT_V(6); PG8_BAR;
    }
    for (;;) {
        const bool has_next = S.next(ui + 1, nxt);
        const char* nA = has_next ? (const char*)g.A + (size_t)nxt.pm * tstepA : cA; const char* nB = has_next ? (const char*)g.Bt + (size_t)nxt.pn * tstep : cB;
        for (int t = 0; t < nt; t += 2) {
            const bool last = (t == nt - 2);
            const char* a1 = cA + (size_t)(t + 1) * kstep;
            const char* a2 = last ? nA : cA + (size_t)(t + 2) * kstep; const char* b2 = last ? nB : cB + (size_t)(t + 2) * kstep;
            const char* a3 = a2 + kstep; const char* b3 = b2 + kstep;
            if (last && has_next) S.a_ready(nxt);
            if constexpr (SP2) {
            PG8_LDB(B0, 0, 0); PG8_LDB(B1, 0, 1); PG8_SCHED; PG8_LDA(At, 0, 0); PG8_STAGE(PG8_SA(1, 1), a1 + hstepA, voffA);
            PG8_WAIT_V(8); PG8_WAIT_L(0); PG8_BAR; PG8_MMA(0, 0, At, B0); PG8_MMA(0, 1, At, B1); PG8_BAR; PG8_SCHED;
            PG8_LDA(At, 0, 1); PG8_STAGE(PG8_SB(0, 0), b2, voffB); PG8_STAGE(PG8_SB(0, 1), b2 + hstep, voffB); PG8_STAGE(PG8_SA(0, 0), a2, voffA);
            PG8_WAIT_V(8); PG8_WAIT_L(0); PG8_BAR; PG8_MMA(1, 0, At, B0); PG8_MMA(1, 1, At, B1); PG8_BAR; PG8_SCHED;
            PG8_LDB(B0, 1, 0); PG8_LDB(B1, 1, 1); PG8_SCHED; PG8_LDA(At, 1, 0); PG8_STAGE(PG8_SA(0, 1), a2 + hstepA, voffA);
            PG8_WAIT_V(8); PG8_WAIT_L(0); PG8_BAR; PG8_MMA(0, 0, At, B0); PG8_MMA(0, 1, At, B1); PG8_BAR; PG8_SCHED;
            PG8_LDA(At, 1, 1); PG8_STAGE(PG8_SB(1, 0), b3, voffB); PG8_STAGE(PG8_SB(1, 1), b3 + hstep, voffB); PG8_STAGE(PG8_SA(1, 0), a3, voffA);
            PG8_WAIT_V(8); PG8_WAIT_L(0); PG8_BAR; PG8_MMA(1, 0, At, B0); PG8_MMA(1, 1, At, B1); PG8_BAR; PG8_SCHED;
            } else {
            PG8_LDB(B0, 0, 0); PG8_SCHED; PG8_LDA(At, 0, 0); PG8_STAGE(PG8_SA(1, 1), a1 + hstepA, voffA);
            PG8_WAIT_L(8); PG8_BAR; PG8_WAIT_L(0); PG8_MMA(0, 0, At, B0); PG8_BAR; PG8_SCHED;
            PG8_LDB(B1, 0, 1); PG8_STAGE(PG8_SB(0, 0), b2, voffB);
            PG8_BAR; PG8_WAIT_L(0); PG8_MMA(0, 1, At, B1); PG8_BAR;
            PG8_LDA(At, 0, 1); PG8_STAGE(PG8_SA(0, 0), a2, voffA);
            PG8_BAR; PG8_WAIT_L(0); PG8_MMA(1, 0, At, B0); PG8_BAR; PG8_SCHED;
            PG8_STAGE(PG8_SB(0, 1), b2 + hstep, voffB);
            PG8_WAIT_V(6); PG8_BAR; PG8_MMA(1, 1, At, B1); PG8_BAR;
            PG8_LDB(B0, 1, 0); PG8_SCHED; PG8_LDA(At, 1, 0); PG8_STAGE(PG8_SA(0, 1), a2 + hstepA, voffA);
            PG8_WAIT_L(8); PG8_BAR; PG8_WAIT_L(0); PG8_MMA(0, 0, At, B0); PG8_BAR; PG8_SCHED;
            PG8_LDB(B1, 1, 1); PG8_STAGE(PG8_SB(1, 0), b3, voffB);
            PG8_BAR; PG8_WAIT_L(0); PG8_MMA(0, 1, At, B1); PG8_BAR;
            PG8_LDA(At, 1, 1); PG8_STAGE(PG8_SA(1, 0), a3, voffA);
            PG8_BAR; PG8_WAIT_L(0); PG8_MMA(1, 0, At, B0); PG8_BAR; PG8_SCHED;
            PG8_STAGE(PG8_SB(1, 1), b3 + hstep, voffB);
            PG8_WAIT_V(6); PG8_BAR; PG8_MMA(1, 1, At, B1); PG8_BAR;
            }
        }
        if constexpr (ALIGN_EPI) { if (wr == 0) PG8_BAR; }
        if constexpr (!Epi::AFTER_DRAIN) { E(acc, cur, wr, wc, fr, fq); S.done(cur); }
        if (!has_next) break;
#pragma unroll
        for (int a = 0; a < 2; ++a)
#pragma unroll
            for (int b = 0; b < 2; ++b)
#pragma unroll
                for (int m = 0; m < 4; ++m)
#pragma unroll
                    for (int n = 0; n < 2; ++n) acc[a][b][m][n] = (f32x4){0.f, 0.f, 0.f, 0.f};
        cur = nxt; cA = nA; cB = nB; ++ui;
        if constexpr (ALIGN_EPI) { if (wr == 1) PG8_BAR; }
    }
    PG8_WAIT_V(0);
    if constexpr (!ALIGN_EPI) { if (wr == 0) PG8_BAR; }
    PG8_BAR;
    if constexpr (Epi::AFTER_DRAIN) { E.fused(acc, cur, wr, wc, fr, fq, lds, wid, lane); S.done(cur); }
#undef PG8_SA
#undef PG8_SB
#undef PG8_STAGE
#undef PG8_LDA
#undef PG8_LDB
#undef PG8_MMA
#undef PG8_WAIT_V
#undef PG8_WAIT_L
#undef PG8_BAR
#undef PG8_SCHED
}
}
#ifndef PG8_SP2
#define PG8_SP2 true
#endif
#ifndef PG8_ALIGN
#define PG8_ALIGN true
#endif

constexpr int NWAVES = 8;
#ifndef MK_ONE_LAUNCH
#define MK_ONE_LAUNCH 1
#endif

#define PROBE_NREP 1
#define REP_P0 1
#define REP_THIN 1
#define REP_ATT0 1
#define REP_ATT1 1
#define REP_G1 1
#define REP_G3 1
#define REP_G8 1
constexpr int M = 8192, DM = 4096, SEQ = 2048, NH = 32;
constexpr int MLA_IN = 5696, MLA_INP = 5888, QL = 1024, KVL = 512, QKD = 192, NQ = NH * QKD, NKV = NH * 256;
constexpr int C_KVLAT = 1024, C_KPE = 1536, C_GATE = 1600;
constexpr int SB_IN = 16384, C_SBK = 4096, C_SBV = 8192, C_SBG = 12288;
constexpr float EPS = 1e-6f;
constexpr float Q_SCALE_MLA = 0.07216878364870323f * 1.4426950408889634f;
constexpr float Q_SCALE_SB = 0.08838834764831845f * 1.4426950408889634f;
constexpr int N_PHASES = 15;

constexpr size_t MiB = 1u << 20;
constexpr size_t WS_CTL = 0, CTL_ZERO_BYTES = 1 * MiB;
constexpr size_t WS_ROPE = 1 * MiB;
constexpr size_t WS_W = 2 * MiB, W_LAYER = 258 * MiB;
constexpr size_t W_IN_MLA = 0, W_QB = 46 * MiB, W_KVB = 58 * MiB, W_OUT_MLA = 66 * MiB, W_IN_SB = 98 * MiB, W_OUT_SB = 226 * MiB;
constexpr size_t WS_ACT = WS_W + 2 * W_LAYER;
constexpr size_t A_XN = WS_ACT, A_PROJ = WS_ACT + 64 * MiB, A_QN = WS_ACT + 320 * MiB, A_KVN = WS_ACT + 336 * MiB, A_QRAW = WS_ACT + 344 * MiB,
                 A_KVRAW = WS_ACT + 440 * MiB, A_KPER = WS_ACT + 568 * MiB  , A_SSPE = WS_ACT + 570 * MiB  , A_SSKP = WS_ACT + 572 * MiB  , A_OG = WS_ACT + 760 * MiB, WS_END = WS_ACT + 824 * MiB;
constexpr int CW_TMO = 0, CW_BAR = 4096;
constexpr size_t WS_SS = 64 * 1024, SS_BYTES = 64 * 1024;

constexpr int RING_OFF = 0, RING_BYTES = 131072;
constexpr int LDSCTL_OFF = RING_BYTES, MISC_OFF = LDSCTL_OFF + 320;
constexpr int LDS_BYTES = 147456;

#define GAS __attribute__((address_space(1)))
#define LAS __attribute__((address_space(3)))
typedef unsigned short bf16;
typedef unsigned v4u __attribute__((ext_vector_type(4)));
typedef unsigned v2u __attribute__((ext_vector_type(2)));
typedef float f32x4 __attribute__((ext_vector_type(4)));
typedef GAS unsigned gu32;
#define RLX_AGENT __ATOMIC_RELAXED, __HIP_MEMORY_SCOPE_AGENT
#define LDS_WAIT() asm volatile("s_waitcnt lgkmcnt(0)" ::: "memory")
__device__ __forceinline__ float bf_lo(unsigned w) { return __uint_as_float(w << 16); }
__device__ __forceinline__ float bf_hi(unsigned w) { return __uint_as_float(w & 0xffff0000u); }
__device__ __forceinline__ unsigned pk2(float lo, float hi) { return pg8::cvt_pk_bf16(lo, hi); }
__device__ __forceinline__ void unpack8(v4u w, float (&f)[8]) { f[0] = bf_lo(w.x); f[1] = bf_hi(w.x); f[2] = bf_lo(w.y); f[3] = bf_hi(w.y); f[4] = bf_lo(w.z); f[5] = bf_hi(w.z); f[6] = bf_lo(w.w); f[7] = bf_hi(w.w); }
__device__ __forceinline__ v4u pack8(const float (&f)[8]) { v4u w; w.x = pk2(f[0], f[1]); w.y = pk2(f[2], f[3]); w.z = pk2(f[4], f[5]); w.w = pk2(f[6], f[7]); return w; }

#define XB_TMO      128
#define XB_XCNT(j)  (256  + 64 * (j))
#define XB_XSUB(j)  (1280 + 64 * (j))
#define XB_XGEN(j)  (2304 + 64 * (j))
#define XB_TOP      3328
#define XB_TOPGEN   3392
#define XCD_BAR_WORDS 3456
#define XB_SPIN_CAP (1u << 18)

__device__ __forceinline__ unsigned xb_ld(unsigned* p)              { return __hip_atomic_load(p, __ATOMIC_RELAXED, __HIP_MEMORY_SCOPE_AGENT); }
__device__ __forceinline__ unsigned xb_add(unsigned* p, unsigned v) { return __hip_atomic_fetch_add(p, v, __ATOMIC_RELAXED, __HIP_MEMORY_SCOPE_AGENT); }
__device__ __forceinline__ unsigned xb_xcc_id() { return (unsigned)__builtin_amdgcn_s_getreg((3 << 11) | 20) & 0xFu; }
#define XB_SPIN(cond, bar) do { unsigned _sp = 0; while (cond) { __builtin_amdgcn_s_sleep(1); \
    if ((++_sp & 255u) == 0u) { if (xb_ld(&(bar)[XB_TMO])) break; if (_sp > XB_SPIN_CAP) { atomicAdd(&(bar)[XB_TMO], 1u); break; } } } } while (0)

struct XcdBarrier {
    unsigned* bar; unsigned x;
    volatile LAS unsigned* st;
};

__device__ __forceinline__ XcdBarrier xcd_barrier_post(unsigned* bar, volatile LAS unsigned* st) {
    XcdBarrier b; b.bar = bar; b.x = xb_xcc_id(); b.st = st;
    if (threadIdx.x == 0) (void)xb_add(&bar[XB_XCNT(b.x)], 1u);
    return b;
}
__device__ __forceinline__ void xcd_barrier_complete(unsigned* bar, unsigned x, unsigned& nloc, unsigned& nx) {
    const unsigned G = gridDim.x * gridDim.y * gridDim.z;
    unsigned sum, cnt, mine, sp = 0u;
    for (;;) {
        sum = 0u; cnt = 0u; mine = 0u;
#pragma unroll
        for (unsigned j = 0; j < 16; ++j) { const unsigned c = xb_ld(&bar[XB_XCNT(j)]); sum += c; cnt += (c > 0u) ? 1u : 0u; mine = (j == x) ? c : mine; }
        if (sum == G) break;
        __builtin_amdgcn_s_sleep(1);
        if ((++sp & 255u) == 0u) { if (xb_ld(&bar[XB_TMO])) break; if (sp > XB_SPIN_CAP) { atomicAdd(&bar[XB_TMO], 1u); break; } }
    }
    nloc = mine > 0u ? mine : 1u; nx = cnt > 0u ? cnt : 1u;
}

__device__ __forceinline__ void xcd_barrier(const XcdBarrier& b) {
    asm volatile("s_waitcnt vmcnt(0)" ::: "memory");
    __syncthreads();
    if (threadIdx.x == 0) {
        unsigned* bar = b.bar;
        __builtin_amdgcn_s_waitcnt(0);
        unsigned nloc = b.st[0], nx = b.st[1];
        if (nloc == 0u) { xcd_barrier_complete(bar, b.x, nloc, nx); b.st[0] = nloc; b.st[1] = nx; }
        const unsigned old = xb_add(&bar[XB_XSUB(b.x)], 1u);
        const unsigned gen = old / nloc;
        if (old + 1u == (gen + 1u) * nloc) {
            __builtin_amdgcn_fence(__ATOMIC_RELEASE, "agent");
            asm volatile("s_waitcnt vmcnt(0)" ::: "memory");
            const unsigned og = xb_add(&bar[XB_TOP], 1u);
            const unsigned tg = og / nx;
            if (og + 1u == (tg + 1u) * nx) xb_add(&bar[XB_TOPGEN], 1u);
            else XB_SPIN(xb_ld(&bar[XB_TOPGEN]) == tg, bar);
            __builtin_amdgcn_fence(__ATOMIC_ACQUIRE, "agent");
            xb_add(&bar[XB_XGEN(b.x)], 1u);
            asm volatile("s_waitcnt vmcnt(0)" ::: "memory");
        } else {
            XB_SPIN(xb_ld(&bar[XB_XGEN(b.x)]) == gen, bar);
            __builtin_amdgcn_fence(__ATOMIC_ACQUIRE, "agent");
            asm volatile("s_waitcnt vmcnt(0)" ::: "memory");
        }
    }
    __syncthreads();
}

#define LAUNDER_V(x) asm volatile("" : "+v"(x))
__device__ __forceinline__ float wave_sum(float v) {
#pragma unroll
    for (int o = 1; o < 64; o <<= 1) v += __shfl_xor(v, o);
    return v;
}
__device__ __forceinline__ void p0_transpose_item(const float* W, int K, int N, bf16* WT, LAS float* scr, int item, int lane, int nscale, float scale, const float* kg) {
    const int nblk = N / 64, kb = item / nblk, nb = item % nblk, k0 = 64 * kb, n0 = 64 * nb;
    const int rr = lane >> 4, c4 = (lane & 15) * 4;
    f32x4 v[16];
#pragma unroll
    for (int i = 0; i < 16; ++i) v[i] = *(const GAS f32x4*)(W + (size_t)(k0 + 4 * i + rr) * N + n0 + c4);
#pragma unroll
    for (int i = 0; i < 16; ++i) { const int k = 4 * i + rr; *(LAS f32x4*)(scr + k * 64 + (c4 ^ ((k >> 3) * 4))) = v[i]; }
    LDS_WAIT(); asm volatile("" ::: "memory");
    const int c = lane & 7, nl = lane >> 3;
    f32x4 ga = (f32x4){1.f, 1.f, 1.f, 1.f}, gb = ga;
    if (kg) { ga = *(const GAS f32x4*)(kg + k0 + 8 * c); gb = *(const GAS f32x4*)(kg + k0 + 8 * c + 4); }
#pragma unroll
    for (int j = 0; j < 8; ++j) { const int n = nl + 8 * j; const LAS float* s = scr + (8 * c) * 64 + (n ^ (4 * c));
        const float sc = (n0 + n) < nscale ? scale : 1.f;
        v4u o; o.x = pk2(s[0 * 64] * (sc * ga.x), s[1 * 64] * (sc * ga.y)); o.y = pk2(s[2 * 64] * (sc * ga.z), s[3 * 64] * (sc * ga.w)); o.z = pk2(s[4 * 64] * (sc * gb.x), s[5 * 64] * (sc * gb.y)); o.w = pk2(s[6 * 64] * (sc * gb.z), s[7 * 64] * (sc * gb.w));
        *(GAS v4u*)(WT + (size_t)(n0 + n) * K + k0 + 8 * c) = o; }
    LDS_WAIT(); asm volatile("" ::: "memory");
}
__device__ __forceinline__ void p0_transpose(const float* W, int K, int N, bf16* WT, LAS float* scr, int gw, int NGW, int lane, const float* kg = nullptr, int nscale = 0, float scale = 1.f) {
    LAUNDER_V(lane);
    const int items = (K / 64) * (N / 64);
    for (int it = gw; it < items; it += NGW) p0_transpose_item(W, K, N, WT, scr, it, lane, nscale, scale, kg);
}
__device__ __forceinline__ void x_to_bf16_rows(const float* x, bf16* xb, unsigned long long* ss, int gw, int NGW, int lane) {
    LAUNDER_V(lane);
    for (int m = 2 * gw; m < M; m += 2 * NGW) {
        const GAS f32x4* xr = (const GAS f32x4*)(x + (size_t)m * DM) + lane;
        f32x4 v[16], w[16]; float s = 0.f, t = 0.f;
#pragma unroll
        for (int j = 0; j < 16; ++j) { v[j] = xr[64 * j]; w[j] = xr[DM / 4 + 64 * j]; }
#pragma unroll
        for (int j = 0; j < 16; ++j) { s += (v[j].x * v[j].x + v[j].y * v[j].y) + (v[j].z * v[j].z + v[j].w * v[j].w); t += (w[j].x * w[j].x + w[j].y * w[j].y) + (w[j].z * w[j].z + w[j].w * w[j].w); }
#pragma unroll
        for (int o = 1; o < 64; o <<= 1) { s += __shfl_xor(s, o); t += __shfl_xor(t, o); }
        if (lane == 0) { ss[m] = (unsigned long long)(s * pg8::SS_FIX); ss[m + 1] = (unsigned long long)(t * pg8::SS_FIX); }
        GAS v2u* o8 = (GAS v2u*)(xb + (size_t)m * DM) + lane;
#pragma unroll
        for (int j = 0; j < 16; ++j) { v2u o, q; o.x = pk2(v[j].x, v[j].y); o.y = pk2(v[j].z, v[j].w); o8[64 * j] = o; q.x = pk2(w[j].x, w[j].y); q.y = pk2(w[j].z, w[j].w); o8[DM / 4 + 64 * j] = q; }
    }
}
__device__ __forceinline__ void kpe_rows(const bf16* proj, const float* gk, const float* ropec, const float* ropes, bf16* kper, float* sspe, int gw, int NGW, int lane) {
    LAUNDER_V(lane);
    const int tk = lane >> 3, c = lane & 7;
    float g[8];
#pragma unroll
    for (int e = 0; e < 8; ++e) g[e] = gk[128 + 8 * c + e];
    for (int m0 = 8 * gw; m0 < M; m0 += 8 * NGW) { const int m = m0 + tk, pos = m & (SEQ - 1);
        float f[8], x[8], pr[8], o[8]; unpack8(*(const GAS v4u*)(proj + (size_t)m * MLA_INP + C_KPE + 8 * c), f);
        float ss = 0.f;
#pragma unroll
        for (int e = 0; e < 8; ++e) { ss += f[e] * f[e]; x[e] = f[e] * g[e]; }
        ss += __shfl_xor(ss, 1); ss += __shfl_xor(ss, 2); ss += __shfl_xor(ss, 4);
        if (c == 0) sspe[m] = ss;
#pragma unroll
        for (int e = 0; e < 8; ++e) pr[e] = __shfl_xor(x[e], 4);
        const float* cs = ropec + pos * 32 + (c & 3) * 8; const float* sn = ropes + pos * 32 + (c & 3) * 8;
#pragma unroll
        for (int e = 0; e < 8; ++e) o[e] = (c < 4) ? (x[e] * cs[e] - pr[e] * sn[e]) : (pr[e] * sn[e] + x[e] * cs[e]);
        *(GAS v4u*)(kper + (size_t)m * 64 + 8 * c) = pack8(o); }
}


namespace fa {
typedef short bf16x8 __attribute__((ext_vector_type(8)));
typedef short s16x4 __attribute__((ext_vector_type(4)));
typedef float f32x16 __attribute__((ext_vector_type(16)));
#define FA_SBAR() __builtin_amdgcn_sched_barrier(0)
constexpr int SHM_V = 16384;
__device__ __forceinline__ int v_st(int k, int c) { const int kk = (k & ~0xC) | ((k & 4) << 1) | ((k & 8) >> 1); return ((kk >> 3) * 4 + (c >> 5)) * 512 + ((kk & 7) * 32 + (c & 31)) * 2; }
__device__ __forceinline__ int v_rd_base(int lane) { return ((lane & 3) << 3) | (((lane >> 2) & 3) << 6) | (((lane >> 4) & 1) << 5) | (((lane >> 5) & 1) << 8); }
__device__ __forceinline__ unsigned cvtpk(float lo, float hi) { unsigned r; asm volatile("v_cvt_pk_bf16_f32 %0, %1, %2" : "=v"(r) : "v"(lo), "v"(hi)); return r; }
__device__ __forceinline__ bf16x8 pack8p(const f32x16& p, int b) { v4u w = {cvtpk(p[b + 0], p[b + 1]), cvtpk(p[b + 2], p[b + 3]), cvtpk(p[b + 4], p[b + 5]), cvtpk(p[b + 6], p[b + 7])}; return __builtin_bit_cast(bf16x8, w); }
__device__ __forceinline__ float ex2(float x) { return __builtin_amdgcn_exp2f(x); }
__device__ __forceinline__ float lg2(float x) { return __builtin_amdgcn_logf(x); }

struct AttnP { const bf16* Q; int qpitch, qhs; const bf16* K; int kpitch, khs; const bf16* V; int vpitch, vhs; const bf16* Gt; int gpitch; bf16* O;
               const bf16* KR; const float* sskp; const float* sspe; const float* gq; const float* gk; const float* rc; const float* rs; };
template <int MODE>
__device__ __forceinline__ void attn_phase(LAS unsigned char* lds, const AttnP& P, int G, int vcu, LAS unsigned* ecnt) {
    const bf16* Qp = P.Q; const int qpitch = P.qpitch, qhs = P.qhs; const bf16* Kp = P.K; const int kpitch = P.kpitch, khs = P.khs; const bf16* Vp = P.V; const int vpitch = P.vpitch, vhs = P.vhs;
    const bf16* Gp = P.Gt; const int gpitch = P.gpitch; bf16* Op = P.O;
    constexpr int DQK = MODE == 0 ? 192 : 128, ND = DQK / 16, KPITCH = DQK * 2, SHM_K = 64 * KPITCH, KP = SHM_K / 8192, VOFF = 2 * SHM_K, RKOFF = VOFF + 2 * SHM_V, QROFF = RKOFF + 8192, NDR = 8;
    int tid_l = threadIdx.x; asm volatile("" : "+v"(tid_l));
    const int tid = tid_l, wid = __builtin_amdgcn_readfirstlane(tid >> 6), lane = tid & 63, r32 = lane & 31, hi = lane >> 5;
    unsigned koff[KP], voff[2]; bool krope[KP];
#pragma unroll
    for (int i = 0; i < KP; ++i) { const int L = (wid * KP + i) * 1024 + lane * 16, v = L / KPITCH, sb = L % KPITCH;
        const int swz = MODE == 0 ? (((v >> 1) & 7) << 4) : ((v & 15) << 4), cb = sb ^ swz, vi = v & 31;
        const int key = (v & 32) + (vi & 3) + 4 * (vi >> 3) + 16 * ((vi >> 2) & 1);
        if (MODE == 0) { const int dim = cb >> 1; krope[i] = dim >= 128; koff[i] = krope[i] ? (unsigned)(key * 64 + dim - 128) : (unsigned)(key * kpitch + dim); }
        else koff[i] = (unsigned)(key * kpitch + (cb >> 1)); }
#pragma unroll
    for (int i = 0; i < 2; ++i) { const int L = (wid * 2 + i) * 1024 + lane * 16, sub = L >> 9, within = L & 511, kk = (sub >> 2) * 8 + (within >> 6);
        const int u = (kk & ~0xC) | ((kk & 4) << 1) | ((kk & 8) >> 1);
        const int key = (u & ~0x18) | ((u & 8) << 1) | ((u & 16) >> 1);
        const int c = (sub & 3) * 32 + ((within & 63) >> 4) * 8;
        voff[i] = (unsigned)(key * vpitch + c); }
    const int kswz = MODE == 0 ? (((r32 >> 1) & 7) << 4) : ((r32 & 15) << 4);
    const int krow = r32 * KPITCH;
    const int vb0 = (int)(uintptr_t)lds + VOFF + v_rd_base(lane);
    LAS unsigned char* qrl = lds + QROFF + wid * 4096 + lane * 16;
    const float NEG_INF = -__builtin_inff();
    constexpr float SB_CUT = -160.f;
    int un = 0;
    if (MODE == 1) { if (tid < 64) ecnt[tid] = 0u; asm volatile("s_waitcnt lgkmcnt(0)\n\ts_barrier" ::: "memory"); }

    for (int item = vcu; item < 512; item += G) {
        const int bh = item >> 2, pp = item & 3, b = bh >> 5, h = bh & 31;
        const bf16* Kh = Kp + (size_t)b * SEQ * kpitch + h * khs; const bf16* Vh = Vp + (size_t)b * SEQ * vpitch + h * vhs;
        const bf16* KRh = MODE == 0 ? P.KR + (size_t)b * SEQ * 64 : nullptr;
        if (MODE == 0) {
            asm volatile("s_waitcnt lgkmcnt(0)\n\ts_barrier" ::: "memory");
            LAS float* rkl = (LAS float*)(lds + RKOFF);
#pragma unroll
            for (int i = 0; i < SEQ / 512; ++i) { const int key = tid + 512 * i; const size_t kt_ = (size_t)b * SEQ + key; const f32x4 sk = *(const GAS f32x4*)(P.sskp + (kt_ * NH + h) * 4);
                rkl[key] = 1.f / sqrtf((((sk.x + sk.y) + (sk.z + sk.w)) + P.sspe[kt_]) * (1.f / QKD) + EPS); }
            asm volatile("s_waitcnt lgkmcnt(0)\n\ts_barrier" ::: "memory");
        }
        for (int pass = 0; pass < 2; ++pass) {
            const int qb = pass ? pp : 7 - pp, qlo = qb * 256 + wid * 32, NT = 4 * (qb + 1), jmax = (qlo + 31) >> 6;
            const size_t mrow = (size_t)b * SEQ + qlo + r32;
            bf16x8 qr[ND];
#pragma unroll
            for (int d0 = 0; d0 < ND; ++d0) qr[d0] = *(const bf16x8*)(Qp + mrow * qpitch + h * qhs + d0 * 16 + hi * 8);
            if (MODE == 0) {
                float ss = 0.f;
#pragma unroll
                for (int d0 = 0; d0 < ND; ++d0) { float f[8]; unpack8(__builtin_bit_cast(v4u, qr[d0]), f);
#pragma unroll
                    for (int e = 0; e < 8; ++e) ss += f[e] * f[e]; }
                { auto rr = __builtin_amdgcn_permlane32_swap(__float_as_uint(ss), __float_as_uint(ss), false, false); ss = __uint_as_float(rr[0]) + __uint_as_float(rr[1]); }
                const float rq = Q_SCALE_MLA / sqrtf(ss * (1.f / QKD) + EPS);
#pragma unroll
                for (int d0 = 0; d0 < 8; ++d0) { float f[8]; unpack8(__builtin_bit_cast(v4u, qr[d0]), f); const int dd = d0 * 16 + hi * 8;
                    const f32x4 a0 = *(const GAS f32x4*)(P.gq + dd), a1 = *(const GAS f32x4*)(P.gq + dd + 4), b0 = *(const GAS f32x4*)(P.gk + dd), b1 = *(const GAS f32x4*)(P.gk + dd + 4);
                    f[0] *= rq * a0.x * b0.x; f[1] *= rq * a0.y * b0.y; f[2] *= rq * a0.z * b0.z; f[3] *= rq * a0.w * b0.w; f[4] *= rq * a1.x * b1.x; f[5] *= rq * a1.y * b1.y; f[6] *= rq * a1.z * b1.z; f[7] *= rq * a1.w * b1.w;
                    qr[d0] = __builtin_bit_cast(bf16x8, pack8(f)); }
                const int pos = qlo + r32;
#pragma unroll
                for (int dd = 0; dd < 2; ++dd) { float x1[8], x2[8], o1[8], o2[8]; unpack8(__builtin_bit_cast(v4u, qr[8 + dd]), x1); unpack8(__builtin_bit_cast(v4u, qr[10 + dd]), x2);
                    const int ri = dd * 16 + hi * 8;
                    const f32x4 ga0 = *(const GAS f32x4*)(P.gq + 128 + ri), ga1 = *(const GAS f32x4*)(P.gq + 128 + ri + 4), gb0 = *(const GAS f32x4*)(P.gq + 160 + ri), gb1 = *(const GAS f32x4*)(P.gq + 160 + ri + 4);
                    const f32x4 c0 = *(const GAS f32x4*)(P.rc + pos * 32 + ri), c1 = *(const GAS f32x4*)(P.rc + pos * 32 + ri + 4), s0 = *(const GAS f32x4*)(P.rs + pos * 32 + ri), s1 = *(const GAS f32x4*)(P.rs + pos * 32 + ri + 4);
                    const float gA[8] = {ga0.x, ga0.y, ga0.z, ga0.w, ga1.x, ga1.y, ga1.z, ga1.w}, gB[8] = {gb0.x, gb0.y, gb0.z, gb0.w, gb1.x, gb1.y, gb1.z, gb1.w};
                    const float cs[8] = {c0.x, c0.y, c0.z, c0.w, c1.x, c1.y, c1.z, c1.w}, sn[8] = {s0.x, s0.y, s0.z, s0.w, s1.x, s1.y, s1.z, s1.w};
#pragma unroll
                    for (int e = 0; e < 8; ++e) { const float a = x1[e] * gA[e], bq = x2[e] * gB[e]; o1[e] = (a * cs[e] - bq * sn[e]) * rq; o2[e] = (a * sn[e] + bq * cs[e]) * rq; }
                    *(LAS bf16x8*)(qrl + dd * 1024) = __builtin_bit_cast(bf16x8, pack8(o1)); *(LAS bf16x8*)(qrl + (2 + dd) * 1024) = __builtin_bit_cast(bf16x8, pack8(o2)); }
            }
            f32x16 o[4];
#pragma unroll
            for (int d0 = 0; d0 < 4; ++d0) o[d0] = f32x16{};
            float m_reg = -1e30f, l_reg = 0.f, carry = 0.f; bool wdone = false;
            LAS unsigned* ebank = ecnt + (un & 1) * 32;
#define FA_DMA(j, KB) do { const bf16* kb_ = Kh + (size_t)(j) * 64 * kpitch; const bf16* vb_ = Vh + (size_t)(j) * 64 * vpitch; const bf16* kr_ = MODE == 0 ? KRh + (size_t)(j) * 64 * 64 : nullptr; \
            _Pragma("unroll") for (int i_ = 0; i_ < KP; ++i_) __builtin_amdgcn_global_load_lds((const unsigned*)(((MODE == 0 && krope[i_]) ? kr_ : kb_) + koff[i_]), (LAS unsigned*)(lds + (KB) * SHM_K + (wid * KP + i_) * 1024), 16, 0, 0); \
            _Pragma("unroll") for (int i_ = 0; i_ < 2; ++i_) __builtin_amdgcn_global_load_lds((const unsigned*)(vb_ + voff[i_]), (LAS unsigned*)(lds + VOFF + (KB) * SHM_V + (wid * 2 + i_) * 1024), 16, 0, 0); } while (0)
#define FA_WAITBAR() asm volatile("s_waitcnt vmcnt(0) lgkmcnt(0)\n\ts_barrier" ::: "memory")
#define FA_TRRD(dst, off) asm volatile("ds_read_b64_tr_b16 %0, %1 offset:%2" : "=&v"(dst) : "v"(vb0), "i"(off) : "memory")
#define FA_PV_D0(d0, VB) do { s16x4 l0, l1, l2, l3, h0, h1, h2, h3; constexpr int b_ = (VB) * SHM_V + (d0) * 512; \
            FA_TRRD(l0, b_); FA_TRRD(h0, b_ + 2048); FA_TRRD(l1, b_ + 4096); FA_TRRD(h1, b_ + 6144); FA_TRRD(l2, b_ + 8192); FA_TRRD(h2, b_ + 10240); FA_TRRD(l3, b_ + 12288); FA_TRRD(h3, b_ + 14336); \
            asm volatile("s_waitcnt lgkmcnt(0)" ::: "memory"); FA_SBAR(); \
            o[d0] = __builtin_amdgcn_mfma_f32_32x32x16_bf16((bf16x8){l0[0], l0[1], l0[2], l0[3], h0[0], h0[1], h0[2], h0[3]}, pa0, o[d0], 0, 0, 0); \
            o[d0] = __builtin_amdgcn_mfma_f32_32x32x16_bf16((bf16x8){l1[0], l1[1], l1[2], l1[3], h1[0], h1[1], h1[2], h1[3]}, pa1, o[d0], 0, 0, 0); \
            o[d0] = __builtin_amdgcn_mfma_f32_32x32x16_bf16((bf16x8){l2[0], l2[1], l2[2], l2[3], h2[0], h2[1], h2[2], h2[3]}, pa2, o[d0], 0, 0, 0); \
            o[d0] = __builtin_amdgcn_mfma_f32_32x32x16_bf16((bf16x8){l3[0], l3[1], l3[2], l3[3], h3[0], h3[1], h3[2], h3[3]}, pa3, o[d0], 0, 0, 0); } while (0)
#define FA_STEP(t, KB) do { const int j = MODE == 0 ? (t) : NT - 1 - (t); \
            if ((t) + 1 < NT) { const int jn = MODE == 0 ? (t) + 1 : NT - 2 - (t); FA_DMA(jn, (KB) ^ 1); } \
            if (j <= jmax && !(MODE == 1 && wdone)) { \
                f32x16 p0 = f32x16{}, p1 = f32x16{}; \
                _Pragma("unroll") for (int d0 = 0; d0 < ND; ++d0) { const int cb = d0 * 32 + hi * 16; const LAS unsigned char* a = lds + (KB) * SHM_K + krow + (cb ^ kswz); \
                    const bf16x8 k0 = *(const LAS bf16x8*)a, k1 = *(const LAS bf16x8*)(a + 32 * KPITCH); \
                    const bf16x8 qf = d0 < NDR ? qr[d0 < NDR ? d0 : 0] : *(const LAS bf16x8*)(qrl + (d0 - NDR) * 1024); \
                    p0 = __builtin_amdgcn_mfma_f32_32x32x16_bf16(k0, qf, p0, 0, 0, 0); p1 = __builtin_amdgcn_mfma_f32_32x32x16_bf16(k1, qf, p1, 0, 0, 0); } \
                const int kb = j * 64, dq = qlo + r32 - kb - 16 * hi; \
                if (MODE == 0) { \
                    { const LAS float* rkw = (const LAS float*)(lds + RKOFF) + kb; \
                      _Pragma("unroll") for (int g_ = 0; g_ < 4; ++g_) { const f32x4 ra = *(const LAS f32x4*)(rkw + 16 * hi + 4 * g_), rb = *(const LAS f32x4*)(rkw + 32 + 16 * hi + 4 * g_); \
                          p0[4 * g_] *= ra.x; p0[4 * g_ + 1] *= ra.y; p0[4 * g_ + 2] *= ra.z; p0[4 * g_ + 3] *= ra.w; p1[4 * g_] *= rb.x; p1[4 * g_ + 1] *= rb.y; p1[4 * g_ + 2] *= rb.z; p1[4 * g_ + 3] *= rb.w; } } \
                    if (kb + 63 > qlo) { _Pragma("unroll") for (int r = 0; r < 16; ++r) { if (r > dq) p0[r] = NEG_INF; if (r + 32 > dq) p1[r] = NEG_INF; } } \
                    float pmax = p0[0]; _Pragma("unroll") for (int r = 1; r < 16; ++r) pmax = fmaxf(pmax, p0[r]); _Pragma("unroll") for (int r = 0; r < 16; ++r) pmax = fmaxf(pmax, p1[r]); \
                    { auto rr = __builtin_amdgcn_permlane32_swap(__float_as_uint(pmax), __float_as_uint(pmax), false, false); pmax = fmaxf(__uint_as_float(rr[0]), __uint_as_float(rr[1])); } \
                    if (!__all(pmax - m_reg <= 11.5f)) { const float mn = fmaxf(m_reg, pmax), alpha = ex2(m_reg - mn); m_reg = mn; l_reg *= alpha; \
                        _Pragma("unroll") for (int d0 = 0; d0 < 4; ++d0) _Pragma("unroll") for (int r = 0; r < 16; ++r) o[d0][r] *= alpha; } \
                    float ps = 0.f; \
                    _Pragma("unroll") for (int r = 0; r < 16; ++r) { p0[r] = ex2(p0[r] - m_reg); p1[r] = ex2(p1[r] - m_reg); ps += p0[r] + p1[r]; } \
                    l_reg += ps; \
                } else { \
                    f32x16 e0, e1; \
                    _Pragma("unroll") for (int r = 0; r < 16; ++r) { const float t0 = p0[r], t1 = p1[r]; \
                        const float b0 = fminf(t0, 0.f) - lg2(1.f + ex2(-fabsf(t0))), b1 = fminf(t1, 0.f) - lg2(1.f + ex2(-fabsf(t1))); \
                        p0[r] = b0; e0[r] = b0 - t0; p1[r] = b1; e1[r] = b1 - t1; } \
                    if (kb + 63 >= qlo) { _Pragma("unroll") for (int r = 0; r < 16; ++r) { if (r >= dq) { p0[r] = NEG_INF; e0[r] = 0.f; } if (r + 32 >= dq) { p1[r] = NEG_INF; e1[r] = 0.f; } } } \
                    float s0 = 0.f, s1 = 0.f; \
                    _Pragma("unroll") for (int r = 15; r >= 0; --r) { const float x0 = e0[r], x1 = e1[r]; e0[r] = s0; e1[r] = s1; s0 += x0; s1 += x1; } \
                    const auto r1 = __builtin_amdgcn_permlane32_swap(__float_as_uint(s0), __float_as_uint(s1), false, false); \
                    const auto r2 = __builtin_amdgcn_permlane32_swap(__float_as_uint(s1), __float_as_uint(s0), false, false); \
                    const float ps0 = __uint_as_float(hi ? r2[0] : r1[1]), ps1 = __uint_as_float(hi ? r1[0] : r2[1]); \
                    const float off1 = carry + (hi ? 0.f : ps1), off0 = carry + s1 + ps1 + (hi ? 0.f : ps0); \
                    carry += (s0 + s1) + (ps0 + ps1); \
                    _Pragma("unroll") for (int r = 0; r < 16; ++r) { p0[r] = ex2(p0[r] + (e0[r] + off0)); p1[r] = ex2(p1[r] + (e1[r] + off1)); } \
                } \
                const bf16x8 pa0 = pack8p(p0, 0), pa1 = pack8p(p0, 8), pa2 = pack8p(p1, 0), pa3 = pack8p(p1, 8); \
                FA_PV_D0(0, KB); FA_PV_D0(1, KB); FA_PV_D0(2, KB); FA_PV_D0(3, KB); \
                if (MODE == 1) { if (__all(carry < SB_CUT)) wdone = true; } \
            } \
            if (MODE == 1 && wdone && lane == 0) __hip_atomic_fetch_add(ebank + (t), 1u, __ATOMIC_RELAXED, __HIP_MEMORY_SCOPE_WORKGROUP); \
            FA_WAITBAR(); \
            if (MODE == 1) stop = *(volatile LAS unsigned*)(ebank + (t)) == 8u; } while (0)

            FA_DMA(MODE == 0 ? 0 : NT - 1, 0);
            FA_WAITBAR();
            if (MODE == 1) { if (tid < 32) ecnt[((un + 1) & 1) * 32 + tid] = 0u; ++un; }
            bool stop = false;
            for (int t = 0; t < NT; t += 2) { FA_STEP(t, 0); if (MODE == 1 && stop) break; FA_STEP(t + 1, 1); if (MODE == 1 && stop) break; }
            float inv = 1.f;
            if (MODE == 0) { auto rr = __builtin_amdgcn_permlane32_swap(__float_as_uint(l_reg), __float_as_uint(l_reg), false, false); inv = 1.f / (__uint_as_float(rr[0]) + __uint_as_float(rr[1])); }
            int lane_e = lane; asm volatile("" : "+v"(lane_e));
            const size_t mrow_e = (size_t)b * SEQ + qlo + (lane_e & 31);
            const bf16* grow = Gp + mrow_e * gpitch + h * 128 + 4 * (lane_e >> 5); bf16* orow = Op + mrow_e * DM + h * 128 + 4 * (lane_e >> 5);
#pragma unroll
            for (int d0 = 0; d0 < 4; ++d0)
#pragma unroll
                for (int g4 = 0; g4 < 4; ++g4) { const v2u gw2 = *(const GAS v2u*)(grow + d0 * 32 + g4 * 8);
                    const float g0 = bf_lo(gw2.x), g1 = bf_hi(gw2.x), g2 = bf_lo(gw2.y), g3 = bf_hi(gw2.y);
                    const float y0 = o[d0][g4 * 4 + 0] * inv * g0 * __builtin_amdgcn_rcpf(1.f + ex2(-1.4426950408889634f * g0)), y1 = o[d0][g4 * 4 + 1] * inv * g1 * __builtin_amdgcn_rcpf(1.f + ex2(-1.4426950408889634f * g1));
                    const float y2 = o[d0][g4 * 4 + 2] * inv * g2 * __builtin_amdgcn_rcpf(1.f + ex2(-1.4426950408889634f * g2)), y3 = o[d0][g4 * 4 + 3] * inv * g3 * __builtin_amdgcn_rcpf(1.f + ex2(-1.4426950408889634f * g3));
                    v2u w; w.x = cvtpk(y0, y1); w.y = cvtpk(y2, y3); *(GAS v2u*)(orow + d0 * 32 + g4 * 8) = w; }
        }
    }
#undef FA_DMA
#undef FA_WAITBAR
#undef FA_TRRD
#undef FA_PV_D0
#undef FA_STEP
}
}
struct Args { const float* in[13]; float* out; unsigned char* ws; int ph_lo, ph_hi; };
__global__ void __launch_bounds__(NWAVES * 64, 2) hybrid_fwd(Args args) {
    extern __shared__ __attribute__((aligned(16))) unsigned char lds_raw[];
    LAS unsigned char* lds = (LAS unsigned char*)lds_raw;
    volatile LAS unsigned* MISC = (volatile LAS unsigned*)(lds + MISC_OFF);
    const int tid = threadIdx.x, lane = tid & 63, wave = __builtin_amdgcn_readfirstlane(tid >> 6);
    const int G = gridDim.x, bx = blockIdx.x;
    const int vcu = (G % 8 == 0) ? (bx % 8) * (G / 8) + bx / 8 : bx;
    const int gw = vcu * NWAVES + wave, NGW = G * NWAVES;
    unsigned char* ws = args.ws;
    gu32* ctl = (gu32*)(ws + WS_CTL);
    for (int u = tid; u < (LDS_BYTES - LDSCTL_OFF) / 4; u += NWAVES * 64) ((LAS unsigned*)(lds + LDSCTL_OFF))[u] = 0u;
    __syncthreads();
#if MK_ONE_LAUNCH
    XcdBarrier bar = xcd_barrier_post((unsigned*)(ctl + CW_BAR), MISC + 8);
#define GRID_BAR() xcd_barrier(bar)
#else
    (void)MISC; (void)ctl;
#define GRID_BAR() do { } while (0)
#endif
    const int lo = args.ph_lo, hi = args.ph_hi;
#define IN(k) (lo <= (k) && (k) < hi)
#define SEAM(k) do { if (IN(k) && IN((k) + 1)) GRID_BAR(); } while (0)
    const float* x_in = args.in[0]; float* out = args.out;
    float* ropec = (float*)(ws + WS_ROPE); float* ropes = ropec + SEQ * 32;
    bf16* XB = (bf16*)(ws + A_XN); bf16* PROJ = (bf16*)(ws + A_PROJ);
    bf16* QRAW = (bf16*)(ws + A_QRAW); bf16* KVRAW = (bf16*)(ws + A_KVRAW); bf16* OG = (bf16*)(ws + A_OG);
    bf16* KPER = (bf16*)(ws + A_KPER); float* SSPE = (float*)(ws + A_SSPE); float* SSKP = (float*)(ws + A_SSKP);
    unsigned long long* SSX = (unsigned long long*)(ws + WS_SS);
    unsigned long long* SSQ = SSX + 4 * M; unsigned long long* SSKV = SSX + 6 * M;

    if (IN(0)) {
        LAS float* scr = (LAS float*)(lds + RING_OFF + wave * 16384);
        x_to_bf16_rows(x_in, XB, SSX, gw, NGW, lane);
        for (int j = 0; j < 2; ++j) {
            unsigned char* wl = ws + WS_W + (size_t)j * W_LAYER;
            p0_transpose(args.in[2] + (size_t)j * DM * MLA_IN, DM, MLA_IN, (bf16*)(wl + W_IN_MLA), scr, gw, NGW, lane, args.in[1] + (size_t)j * DM);
            p0_transpose(args.in[4] + (size_t)j * QL * NQ, QL, NQ, (bf16*)(wl + W_QB), scr, gw, NGW, lane, args.in[3] + (size_t)j * QL);
            p0_transpose(args.in[6] + (size_t)j * KVL * NKV, KVL, NKV, (bf16*)(wl + W_KVB), scr, gw, NGW, lane, args.in[5] + (size_t)j * KVL);
            p0_transpose(args.in[9] + (size_t)j * DM * DM, DM, DM, (bf16*)(wl + W_OUT_MLA), scr, gw, NGW, lane);
            p0_transpose(args.in[11] + (size_t)j * DM * SB_IN, DM, SB_IN, (bf16*)(wl + W_IN_SB), scr, gw, NGW, lane, args.in[10] + (size_t)j * DM, DM, Q_SCALE_SB);
            p0_transpose(args.in[12] + (size_t)j * DM * DM, DM, DM, (bf16*)(wl + W_OUT_SB), scr, gw, NGW, lane);
            GAS v4u* pad = (GAS v4u*)(wl + W_IN_MLA + (size_t)MLA_IN * DM * 2);
            for (int i = vcu * 512 + tid; i < (MLA_INP - MLA_IN) * DM * 2 / 16; i += G * 512) pad[i] = (v4u){0u, 0u, 0u, 0u};
        }
        for (int i = vcu * 512 + tid; i < SEQ * 32; i += G * 512) { const int pos = i >> 5, p = i & 31;
            const float inv = 1.0f / powf(10000.0f, (float)(2 * p) / 64.0f), ang = (float)pos * inv; ropec[i] = cosf(ang); ropes[i] = sinf(ang); }
    }
    SEAM(0);

    for (int L = 0; L < 2; ++L) {
        const int pb = 1 + 7 * L;
        unsigned char* wl = ws + WS_W + (size_t)L * W_LAYER;
        const float* xa = (L == 0) ? x_in : (const float*)out;
        if (IN(pb + 0)) { pg8::Gemm g{XB, (const bf16*)(wl + W_IN_MLA), M, MLA_INP, DM, DM}; pg8::StaticOrder S; S.init(M, MLA_INP, G, bx);
            pg8::EpiBf16S<1> E{PROJ, MLA_INP, SSX + (size_t)(2 * L) * M, 1.f / DM, SSQ + (size_t)L * M, SSKV + (size_t)L * M};
            pg8::gemm_phase<pg8::EpiBf16S<1>, pg8::StaticOrder, PG8_ALIGN, PG8_SP2>(lds + RING_OFF, g, S, E); }
        SEAM(pb + 0);
        if (IN(pb + 1)) {
            kpe_rows(PROJ, args.in[8] + (size_t)L * QKD, ropec, ropes, KPER, SSPE, gw, NGW, lane);
            { pg8::Gemm g{PROJ, (const bf16*)(wl + W_QB), M, NQ, QL, MLA_INP}; pg8::StaticOrder S; S.init(M, NQ, G, bx);
              pg8::EpiBf16S<0> E{QRAW, NQ, SSQ + (size_t)L * M, 1.f / QL, nullptr, nullptr}; pg8::gemm_phase<pg8::EpiBf16S<0>, pg8::StaticOrder, PG8_ALIGN, PG8_SP2>(lds + RING_OFF, g, S, E); }
            { pg8::Gemm g{PROJ + C_KVLAT, (const bf16*)(wl + W_KVB), M, NKV, KVL, MLA_INP}; pg8::StaticOrder S; S.init(M, NKV, G, bx);
              pg8::EpiKV E{KVRAW, NKV, SSKV + (size_t)L * M, 1.f / KVL, SSKP}; pg8::gemm_phase<pg8::EpiKV, pg8::StaticOrder, PG8_ALIGN, PG8_SP2>(lds + RING_OFF, g, S, E); }
        }
        SEAM(pb + 1);
        if (IN(pb + 2)) { const fa::AttnP P{QRAW, NQ, QKD, KVRAW, NKV, 256, KVRAW + 128, NKV, 256, PROJ + C_GATE, MLA_INP, OG, KPER, SSKP, SSPE, args.in[7] + (size_t)L * QKD, args.in[8] + (size_t)L * QKD, ropec, ropes};
            fa::attn_phase<0>(lds, P, G, vcu, (LAS unsigned*)(lds + LDSCTL_OFF)); }
        SEAM(pb + 2);
        if (IN(pb + 3)) { pg8::Gemm g{OG, (const bf16*)(wl + W_OUT_MLA), M, DM, DM, DM}; pg8::StaticOrder S; S.init(M, DM, G, bx);
            pg8::EpiResF32X E{xa, out, DM, XB, SSX + (size_t)(2 * L + 1) * M}; pg8::gemm_phase<pg8::EpiResF32X, pg8::StaticOrder, PG8_ALIGN, PG8_SP2>(lds + RING_OFF, g, S, E); }
        SEAM(pb + 3);
        if (IN(pb + 4)) { pg8::Gemm g{XB, (const bf16*)(wl + W_IN_SB), M, SB_IN, DM, DM}; pg8::StaticOrder S; S.init(M, SB_IN, G, bx);
            pg8::EpiBf16S<0> E{PROJ, SB_IN, SSX + (size_t)(2 * L + 1) * M, 1.f / DM, nullptr, nullptr}; pg8::gemm_phase<pg8::EpiBf16S<0>, pg8::StaticOrder, PG8_ALIGN, PG8_SP2>(lds + RING_OFF, g, S, E); }
        SEAM(pb + 4);
        if (IN(pb + 5)) { const fa::AttnP P{PROJ, SB_IN, 128, PROJ + C_SBK, SB_IN, 128, PROJ + C_SBV, SB_IN, 128, PROJ + C_SBG, SB_IN, OG, nullptr, nullptr, nullptr, nullptr, nullptr, nullptr, nullptr};
            fa::attn_phase<1>(lds, P, G, vcu, (LAS unsigned*)(lds + LDSCTL_OFF)); }
        SEAM(pb + 5);
        if (IN(pb + 6)) { pg8::Gemm g{OG, (const bf16*)(wl + W_OUT_SB), M, DM, DM, DM}; pg8::StaticOrder S; S.init(M, DM, G, bx);
            pg8::EpiResF32X E{out, out, DM, (L == 0) ? XB : (bf16*)nullptr, SSX + (size_t)2 * M}; pg8::gemm_phase<pg8::EpiResF32X, pg8::StaticOrder, PG8_ALIGN, PG8_SP2>(lds + RING_OFF, g, S, E); }
        SEAM(pb + 6);
    }
#undef IN
#undef SEAM
}

extern "C" void kernel_launch(void* const* d_in, const int* in_sizes, int n_in, void* d_out, int out_size, void* d_ws, size_t ws_size, hipStream_t stream) {
    static int grid = 0;
    if (grid == 0) {
        if (n_in != 13 || in_sizes[0] != M * DM || out_size != M * DM || ws_size < WS_END) { fprintf(stderr, "kernel_launch: unexpected shapes (n_in %d, in0 %d, out %d, ws %zu; need ws >= %zu); nothing launched\n", n_in, n_in > 0 ? in_sizes[0] : -1, out_size, ws_size, (size_t)WS_END); grid = -1; return; }
        int dev = 0, cus = 0, per_cu = 0;
        if (hipGetDevice(&dev) != hipSuccess || hipDeviceGetAttribute(&cus, hipDeviceAttributeMultiprocessorCount, dev) != hipSuccess) { fprintf(stderr, "kernel_launch: device query failed\n"); grid = -1; return; }
        if (hipFuncSetAttribute((const void*)hybrid_fwd, hipFuncAttributeMaxDynamicSharedMemorySize, LDS_BYTES) != hipSuccess) { fprintf(stderr, "kernel_launch: hipFuncSetAttribute failed\n"); grid = -1; return; }
        if (hipOccupancyMaxActiveBlocksPerMultiprocessor(&per_cu, (const void*)hybrid_fwd, NWAVES * 64, LDS_BYTES) != hipSuccess || per_cu < 1)
            fprintf(stderr, "kernel_launch: note: occupancy query reports %d workgroups per CU\n", per_cu);
        (void)hipGetLastError();
        grid = cus;
    }
    if (grid < 0) return;
    if (hipMemsetAsync((char*)d_ws + WS_CTL, 0, CTL_ZERO_BYTES, stream) != hipSuccess) { fprintf(stderr, "kernel_launch: memset failed\n"); return; }
    Args a{};
    for (int i = 0; i < 13; ++i) a.in[i] = (const float*)d_in[i];
    a.out = (float*)d_out; a.ws = (unsigned char*)d_ws;
#if MK_ONE_LAUNCH
    a.ph_lo = 0; a.ph_hi = N_PHASES;
    hipLaunchKernelGGL(hybrid_fwd, dim3(grid), dim3(NWAVES * 64), LDS_BYTES, stream, a);
#ifdef PROBE_PHASES
    { static const int probe_ph[] = {PROBE_PHASES};
      for (int r = 0; r < PROBE_NREP; ++r) for (int ph : probe_ph) { a.ph_lo = ph; a.ph_hi = ph + 1; hipLaunchKernelGGL(hybrid_fwd, dim3(grid), dim3(NWAVES * 64), LDS_BYTES, stream, a); } }
#endif
#else
    for (int ph = 0; ph < N_PHASES; ++ph) { a.ph_lo = ph; a.ph_hi = ph + 1; hipLaunchKernelGGL(hybrid_fwd, dim3(grid), dim3(NWAVES * 64), LDS_BYTES, stream, a); }
#endif
    const hipError_t le = hipPeekAtLastError();
    if (le != hipSuccess) fprintf(stderr, "kernel_launch: launch failed: %s\n", hipGetErrorName(le));
}
```

```cpp
#include <hip/hip_runtime.h>
#include <cstdio>
#include <cstdint>
#ifndef PROBE_GEMM
#define PROBE_GEMM 0
#endif
#ifndef PG8_POSTEPI
#define PG8_POSTEPI 0
#endif
namespace pg8 {
#define PG8_LAS __attribute__((address_space(3)))
typedef unsigned short bf16_t;
typedef short bf16x8 __attribute__((ext_vector_type(8)));
typedef float f32x4 __attribute__((ext_vector_type(4)));

#ifndef PG8_WT
#define PG8_WT 0
#endif
typedef unsigned u32x4 __attribute__((ext_vector_type(4)));
__device__ __forceinline__ void st16_wt(void* p, u32x4 v) {
#if PG8_WT
    asm volatile("global_store_dwordx4 %0, %1, off sc1\n\ts_nop 1" :: "v"(p), "v"(v));
#else
    *(u32x4*)p = v;
#endif
}
constexpr int BM = 256, BK = 64, HALF = 128, HTB = HALF * BK * 2  , STAGE_BYTES = 8 * HTB, NXCD = 8, WGM = 8;

__host__ __device__ __forceinline__ int lds_byte(int r, int c) { const int st = (r >> 4) * 2 + (c >> 5), rr = r & 15, cc = c & 31, ob = rr * 64 + cc * 2; return st * 1024 + (ob ^ (((ob >> 9) & 1) << 5)); }
__host__ __device__ __forceinline__ void stage_rc(int b, int& R, int& C) { const int st = b / 1024, sb = b % 1024, swz = sb ^ (((sb >> 9) & 1) << 5); R = (st >> 1) * 16 + swz / 64; C = (st & 1) * 32 + (swz % 64) / 2; }
__host__ __device__ __forceinline__ int perm32(int rho) { const int n = rho >> 4, i = rho & 15; return 8 * (i >> 2) + 4 * n + (i & 3); }

struct Unit { int pm, pn; };
struct Gemm { const bf16_t* A; const bf16_t* Bt; int M, N, K, lda; };

struct StaticOrder {
    int nM, nN, nwg, G, c;
    __host__ __device__ void init(int M, int N, int G_, int c_) { nM = M / BM; nN = N / BM; nwg = nM * nN; G = G_; c = c_; }
    __host__ __device__ bool next(int i, Unit& u) const {
        const long L = (long)i * G + c; if (L >= nwg) return false;
        int wgid = (int)L; { const int q = nwg / NXCD, r = nwg % NXCD, xcd = wgid % NXCD, off = wgid / NXCD; wgid = (xcd < r ? xcd * (q + 1) : r * (q + 1) + (xcd - r) * q) + off; }
        const int nig = WGM * nN, gid = wgid / nig, fm = gid * WGM, gsz = (nM - fm) < WGM ? (nM - fm) : WGM;
        u.pm = fm + ((wgid % nig) % gsz); u.pn = (wgid % nig) / gsz; return true;
    }
    __device__ __forceinline__ void a_ready(const Unit&) const {}
    __device__ __forceinline__ void done(const Unit&) const {}
};

__device__ __forceinline__ unsigned cvt_pk_bf16(float lo, float hi) { unsigned r; asm volatile("v_cvt_pk_bf16_f32 %0, %1, %2" : "=v"(r) : "v"(lo), "v"(hi)); return r; }
struct EpiBf16 {
    static constexpr bool PERM = true, AFTER_DRAIN = false; static constexpr bool HAS_TABLE = false; static constexpr int NST = 0;
    bf16_t* O; int ldc;
    __device__ __forceinline__ void operator()(const f32x4 (&acc)[2][2][4][2], const Unit& u, int wr, int wc, int fr, int fq, int ui) const {
        const int row0 = u.pm * BM + wr * 64 + fr; const int col0 = u.pn * BM + wc * 32 + 8 * fq;
#pragma unroll
        for (int ai = 0; ai < 2; ++ai)
#pragma unroll
            for (int m = 0; m < 4; ++m) { bf16_t* rowp = O + (size_t)(row0 + ai * HALF + m * 16) * ldc + col0;
#pragma unroll
                for (int bj = 0; bj < 2; ++bj) { const f32x4 v0 = acc[ai][bj][m][0], v1 = acc[ai][bj][m][1];
                    u32x4 w; w.x = cvt_pk_bf16(v0[0], v0[1]); w.y = cvt_pk_bf16(v0[2], v0[3]); w.z = cvt_pk_bf16(v1[0], v1[1]); w.w = cvt_pk_bf16(v1[2], v1[3]);
                    *(u32x4*)(rowp + bj * HALF) = w; } }
    }
};
struct EpiResF32 {
    static constexpr bool PERM = true, AFTER_DRAIN = false; static constexpr bool HAS_TABLE = false; static constexpr int NST = 0;
    const float* base; float* out; int ldc;
    __device__ __forceinline__ void operator()(const f32x4 (&acc)[2][2][4][2], const Unit& u, int wr, int wc, int fr, int fq, int ui) const {
        const int row0 = u.pm * BM + wr * 64 + fr; const int col0 = u.pn * BM + wc * 32 + 8 * fq;
#pragma unroll
        for (int ai = 0; ai < 2; ++ai)
#pragma unroll
            for (int m = 0; m < 4; ++m) { const size_t off = (size_t)(row0 + ai * HALF + m * 16) * ldc + col0;
#pragma unroll
                for (int bj = 0; bj < 2; ++bj) {
                    const f32x4 b0 = *(const f32x4*)(base + off + bj * HALF), b1 = *(const f32x4*)(base + off + bj * HALF + 4);
                    *(f32x4*)(out + off + bj * HALF) = b0 + acc[ai][bj][m][0]; *(f32x4*)(out + off + bj * HALF + 4) = b1 + acc[ai][bj][m][1]; } }
    }
};

constexpr float SS_FIX = 1048576.f, SS_UNFIX = 1.f / 1048576.f;
__device__ __forceinline__ float rstd_of(const unsigned long long* ss, int row, float inv_n) { return 1.f / sqrtf((float)ss[row] * (SS_UNFIX * inv_n) + 1e-6f); }
__device__ __forceinline__ void ss_add(unsigned long long* ss, int row, float part, int fq) {
    part += __shfl_xor(part, 16); part += __shfl_xor(part, 32);
    if (fq == 0) atomicAdd(ss + row, (unsigned long long)(part * SS_FIX));
}
__device__ __forceinline__ void rstd_table_fill(PG8_LAS float* rst, const unsigned long long* ss, float inv_n, const StaticOrder& S, int tid) {
    int tl = tid; asm volatile("" : "+v"(tl));
    const int half = __builtin_amdgcn_readfirstlane(tl >> 8), r = tl & (BM - 1);
    for (int i0 = 0; ; i0 += 8) {
        Unit u; unsigned long long raw[4]; bool ok[4];
#pragma unroll
        for (int k = 0; k < 4; ++k) { ok[k] = S.next(i0 + 2 * k + half, u); raw[k] = ok[k] ? ss[u.pm * BM + r] : 0ull; }
#pragma unroll
        for (int k = 0; k < 4; ++k) if (ok[k]) rst[(i0 + 2 * k + half) * BM + r] = 1.f / sqrtf((float)raw[k] * (SS_UNFIX * inv_n) + 1e-6f);
        if (!ok[3]) break;
    }
    asm volatile("s_waitcnt vmcnt(0) lgkmcnt(0)\n\ts_barrier" ::: "memory");
}
template <int SSMODE> struct EpiBf16S {
    static constexpr bool PERM = true, AFTER_DRAIN = false; static constexpr bool HAS_TABLE = true; static constexpr int NST = 16;
    bf16_t* O; int ldc; const PG8_LAS float* rst; unsigned long long* ss1; unsigned long long* ss2; bf16_t* O1; bf16_t* O2; const unsigned long long* ssin; float inv_n;
    __device__ __forceinline__ void operator()(const f32x4 (&acc)[2][2][4][2], const Unit& u, int wr, int wc, int fr, int fq, int ui) const {
        const int row0 = u.pm * BM + wr * 64 + fr; int col0 = u.pn * BM + wc * 32 + 8 * fq;
        bf16_t* Ob = O; int ld = ldc;
        if (SSMODE == 1) { if (u.pn < 4) { Ob = O1; ld = 1024; } else if (u.pn < 6) { Ob = O2; ld = 512; col0 -= 1024; } }
#pragma unroll
        for (int ai = 0; ai < 2; ++ai)
#pragma unroll
            for (int m = 0; m < 4; ++m) { const int row = row0 + ai * HALF + m * 16; const float rs = rst[ui * BM + (row - u.pm * BM)]; bf16_t* rowp = Ob + (size_t)row * ld + col0; float part = 0.f;
#pragma unroll
                for (int bj = 0; bj < 2; ++bj) { const f32x4 v0 = acc[ai][bj][m][0] * rs, v1 = acc[ai][bj][m][1] * rs;
                    if (SSMODE == 1) part += (v0[0] * v0[0] + v0[1] * v0[1]) + (v0[2] * v0[2] + v0[3] * v0[3]) + (v1[0] * v1[0] + v1[1] * v1[1]) + (v1[2] * v1[2] + v1[3] * v1[3]);
                    u32x4 w; w.x = cvt_pk_bf16(v0[0], v0[1]); w.y = cvt_pk_bf16(v0[2], v0[3]); w.z = cvt_pk_bf16(v1[0], v1[1]); w.w = cvt_pk_bf16(v1[2], v1[3]);
                    st16_wt(rowp + bj * HALF, w); }
                if (SSMODE == 1) { if (u.pn < 6) ss_add(u.pn < 4 ? ss1 : ss2, row, part, fq); } }
    }
};
struct EpiResHL {
    static constexpr bool PERM = true, AFTER_DRAIN = false; static constexpr bool HAS_TABLE = false; static constexpr int NST = 48;
    bf16_t* hi; bf16_t* lo; int ldc; float* outf; unsigned long long* ss;
    static __device__ __forceinline__ float blo_(unsigned w) { return __uint_as_float(w << 16); }
    static __device__ __forceinline__ float bhi_(unsigned w) { return __uint_as_float(w & 0xffff0000u); }
    __device__ __forceinline__ void operator()(f32x4 (&acc)[2][2][4][2], const Unit& u, int wr, int wc, int fr, int fq, int ui) const {
        const int row0 = u.pm * BM + wr * 64 + fr; const int col0 = u.pn * BM + wc * 32 + 8 * fq;
        u32x4 ph[2][2], pl[2][2];
#define ERX_LOAD(ai, mh) do { _Pragma("unroll") for (int m2 = 0; m2 < 2; ++m2) { const size_t off = (size_t)(row0 + (ai) * HALF + (2 * (mh) + m2) * 16) * ldc + col0; \
            _Pragma("unroll") for (int bj = 0; bj < 2; ++bj) { ph[m2][bj] = *(const u32x4*)(hi + off + bj * HALF); pl[m2][bj] = *(const u32x4*)(lo + off + bj * HALF); } } asm volatile("" ::: "memory"); } while (0)
#define ERX_SUM(ai, mh) do { _Pragma("unroll") for (int m2 = 0; m2 < 2; ++m2) _Pragma("unroll") for (int bj = 0; bj < 2; ++bj) { const u32x4 h_ = ph[m2][bj], l_ = pl[m2][bj]; \
            acc[ai][bj][2 * (mh) + m2][0] += (f32x4){blo_(h_.x) + blo_(l_.x), bhi_(h_.x) + bhi_(l_.x), blo_(h_.y) + blo_(l_.y), bhi_(h_.y) + bhi_(l_.y)}; \
            acc[ai][bj][2 * (mh) + m2][1] += (f32x4){blo_(h_.z) + blo_(l_.z), bhi_(h_.z) + bhi_(l_.z), blo_(h_.w) + blo_(l_.w), bhi_(h_.w) + bhi_(l_.w)}; \
            asm volatile("" : "+v"(acc[ai][bj][2 * (mh) + m2][0]), "+v"(acc[ai][bj][2 * (mh) + m2][1])); } } while (0)
#define ERX_STORE(ai, mh) do { _Pragma("unroll") for (int m2 = 0; m2 < 2; ++m2) { const int m = 2 * (mh) + m2; const int row = row0 + (ai) * HALF + m * 16; const size_t off = (size_t)row * ldc + col0; float part = 0.f; \
            _Pragma("unroll") for (int bj = 0; bj < 2; ++bj) { const f32x4 o0 = acc[ai][bj][m][0], o1 = acc[ai][bj][m][1]; \
                if (outf) { st16_wt(outf + off + bj * HALF, __builtin_bit_cast(u32x4, o0)); st16_wt(outf + off + bj * HALF + 4, __builtin_bit_cast(u32x4, o1)); } \
                else { part += (o0[0] * o0[0] + o0[1] * o0[1]) + (o0[2] * o0[2] + o0[3] * o0[3]) + (o1[0] * o1[0] + o1[1] * o1[1]) + (o1[2] * o1[2] + o1[3] * o1[3]); \
                    u32x4 w; w.x = cvt_pk_bf16(o0[0], o0[1]); w.y = cvt_pk_bf16(o0[2], o0[3]); w.z = cvt_pk_bf16(o1[0], o1[1]); w.w = cvt_pk_bf16(o1[2], o1[3]); \
                    u32x4 r; r.x = cvt_pk_bf16(o0[0] - blo_(w.x), o0[1] - bhi_(w.x)); r.y = cvt_pk_bf16(o0[2] - blo_(w.y), o0[3] - bhi_(w.y)); r.z = cvt_pk_bf16(o1[0] - blo_(w.z), o1[1] - bhi_(w.z)); r.w = cvt_pk_bf16(o1[2] - blo_(w.w), o1[3] - bhi_(w.w)); \
                    st16_wt(hi + off + bj * HALF, w); st16_wt(lo + off + bj * HALF, r); } } \
            if (!outf) ss_add(ss, row, part, fq); } asm volatile("" ::: "memory"); } while (0)
        ERX_LOAD(0, 0); ERX_SUM(0, 0); ERX_LOAD(0, 1); ERX_STORE(0, 0); ERX_SUM(0, 1); ERX_LOAD(1, 0); ERX_STORE(0, 1); ERX_SUM(1, 0); ERX_LOAD(1, 1); ERX_STORE(1, 0); ERX_SUM(1, 1); ERX_STORE(1, 1);
#undef ERX_LOAD
#undef ERX_SUM
#undef ERX_STORE
    }
};
struct EpiKV {
    static constexpr bool PERM = true, AFTER_DRAIN = false; static constexpr bool HAS_TABLE = true; static constexpr int NST = 16;
    bf16_t* O; int ldc; const PG8_LAS float* rst; float* sskp; const unsigned long long* ssin; float inv_n;
    __device__ __forceinline__ void operator()(const f32x4 (&acc)[2][2][4][2], const Unit& u, int wr, int wc, int fr, int fq, int ui) const {
        const int row0 = u.pm * BM + wr * 64 + fr; const int col0 = u.pn * BM + wc * 32 + 8 * fq;
#pragma unroll
        for (int ai = 0; ai < 2; ++ai)
#pragma unroll
            for (int m = 0; m < 4; ++m) { const int row = row0 + ai * HALF + m * 16; const float rs = rst[ui * BM + (row - u.pm * BM)]; bf16_t* rowp = O + (size_t)row * ldc + col0; float part = 0.f;
#pragma unroll
                for (int bj = 0; bj < 2; ++bj) { const f32x4 v0 = acc[ai][bj][m][0] * rs, v1 = acc[ai][bj][m][1] * rs;
                    if (bj == 0) part = (v0[0] * v0[0] + v0[1] * v0[1]) + (v0[2] * v0[2] + v0[3] * v0[3]) + (v1[0] * v1[0] + v1[1] * v1[1]) + (v1[2] * v1[2] + v1[3] * v1[3]);
                    u32x4 w; w.x = cvt_pk_bf16(v0[0], v0[1]); w.y = cvt_pk_bf16(v0[2], v0[3]); w.z = cvt_pk_bf16(v1[0], v1[1]); w.w = cvt_pk_bf16(v1[2], v1[3]);
                    st16_wt(rowp + bj * HALF, w); }
                part += __shfl_xor(part, 16); part += __shfl_xor(part, 32);
                if (fq == 0) sskp[((size_t)row * 32 + u.pn) * 4 + wc] = part; }
    }
};

template <class Epi, class Sched, bool ALIGN_EPI = false, bool SP2 = false>
__device__ __forceinline__ void gemm_phase(PG8_LAS unsigned char* lds, const Gemm g, const Sched& S, const Epi& E, unsigned* tp = nullptr) {
#if PROBE_GEMM
    const unsigned tg0 = (unsigned)__builtin_amdgcn_s_memtime(); unsigned tgk = 0;
#endif
    int tid_l = threadIdx.x; asm volatile("" : "+v"(tid_l));
    const int tid = tid_l, wid = __builtin_amdgcn_readfirstlane(tid >> 6), lane = tid & 63, wr = wid >> 2, wc = wid & 3, fr = lane & 15, fq = lane >> 4;
    const int K = g.K, nt = K / BK;
    unsigned voffA[2], voffB[2];
#pragma unroll
    for (int i = 0; i < 2; ++i) { int R, C; stage_rc(tid * 16 + i * 8192, R, C); const int Rb = Epi::PERM ? ((R & ~31) + perm32(R & 31)) : R;
        voffA[i] = (unsigned)(R * g.lda + C) * 2u; voffB[i] = (unsigned)(Rb * K + C) * 2u; }
    const size_t kstep = (size_t)(BK * 2);
    const size_t hstep = (size_t)HALF * K * 2;
    const size_t tstep = 2 * hstep;
    const size_t hstepA = (size_t)HALF * g.lda * 2, tstepA = 2 * hstepA;
    const unsigned ldsw = (unsigned)wid * 1024u;
    const int aoff = lds_byte(wr * 64 + fr, fq * 8), boff = lds_byte(wc * 32 + fr, fq * 8);
#define PG8_SA(b, h) (((b) * 2 + (h)) * HTB)
#define PG8_SB(b, h) ((4 + (b) * 2 + (h)) * HTB)
#define PG8_STAGE(bufoff, gbase, voff) do { _Pragma("unroll") for (int _i = 0; _i < 2; ++_i) \
        __builtin_amdgcn_global_load_lds((const unsigned*)((const char*)(gbase) + (voff)[_i]), (PG8_LAS unsigned*)(lds + (bufoff) + ldsw + _i * 8192), 16, 0, 0); } while (0)
#define PG8_LDA(dst, b, h) do { _Pragma("unroll") for (int m = 0; m < 4; ++m) _Pragma("unroll") for (int k = 0; k < 2; ++k) dst[m][k] = *(const PG8_LAS bf16x8*)(lds + PG8_SA(b, h) + aoff + m * 2048 + k * 1024); } while (0)
#define PG8_LDB(dst, b, h) do { _Pragma("unroll") for (int n = 0; n < 2; ++n) _Pragma("unroll") for (int k = 0; k < 2; ++k) dst[n][k] = *(const PG8_LAS bf16x8*)(lds + PG8_SB(b, h) + boff + n * 2048 + k * 1024); } while (0)
#define PG8_MMA(ai, bj, At, Bt) do { __builtin_amdgcn_s_setprio(1); _Pragma("unroll") for (int m = 0; m < 4; ++m) _Pragma("unroll") for (int n = 0; n < 2; ++n) _Pragma("unroll") for (int k = 0; k < 2; ++k) \
        acc[ai][bj][m][n] = __builtin_amdgcn_mfma_f32_16x16x32_bf16(Bt[n][k], At[m][k], acc[ai][bj][m][n], 0, 0, 0); __builtin_amdgcn_s_setprio(0); } while (0)
#define PG8_WAIT_V(n) asm volatile("s_waitcnt vmcnt(" #n ")" ::: "memory")
#define PG8_WAIT_L(n) asm volatile("s_waitcnt lgkmcnt(" #n ")" ::: "memory")
#define PG8_WAIT_VP(post_) asm volatile("s_waitcnt vmcnt(%1)\n\ts_cmp_lg_u32 %0, 0\n\ts_cbranch_scc1 .Lpg8post%=\n\ts_waitcnt vmcnt(8)\n.Lpg8post%=:" :: "s"(post_), "n"(8 + Epi::NST) : "memory", "scc")
#define PG8_BAR __builtin_amdgcn_s_barrier()
#define PG8_SCHED __builtin_amdgcn_sched_barrier(0)
    Unit cur, nxt; int ui = 0;
    if (!S.next(0, cur)) return;
    f32x4 acc[2][2][4][2];
#pragma unroll
    for (int a = 0; a < 2; ++a)
#pragma unroll
        for (int b = 0; b < 2; ++b)
#pragma unroll
            for (int m = 0; m < 4; ++m)
#pragma unroll
                for (int n = 0; n < 2; ++n) acc[a][b][m][n] = (f32x4){0.f, 0.f, 0.f, 0.f};
    bf16x8 At[4][2], B0[2][2], B1[2][2];
    const char* cA = (const char*)g.A + (size_t)cur.pm * tstepA; const char* cB = (const char*)g.Bt + (size_t)cur.pn * tstep;
    S.a_ready(cur);
    if constexpr (SP2) {
        PG8_STAGE(PG8_SB(0, 0), cB, voffB); PG8_STAGE(PG8_SB(0, 1), cB + hstep, voffB); PG8_STAGE(PG8_SA(0, 0), cA, voffA); PG8_STAGE(PG8_SA(0, 1), cA + hstepA, voffA);
        if (wr == 1) PG8_BAR;
        PG8_WAIT_V(2); PG8_BAR;
        PG8_STAGE(PG8_SB(1, 0), cB + kstep, voffB); PG8_STAGE(PG8_SA(1, 0), cA + kstep, voffA); PG8_STAGE(PG8_SB(1, 1), cB + hstep + kstep, voffB);
        PG8_WAIT_V(6); PG8_BAR;
        if (PG8_POSTEPI) PG8_STAGE(PG8_SA(1, 1), cA + kstep + hstepA, voffA);
    } else {
        PG8_STAGE(PG8_SB(0, 0), cB, voffB); PG8_STAGE(PG8_SA(0, 0), cA, voffA); PG8_STAGE(PG8_SB(0, 1), cB + hstep, voffB); PG8_STAGE(PG8_SA(0, 1), cA + hstepA, voffA);
        if (wr == 1) PG8_BAR;
        PG8_WAIT_V(4); PG8_BAR;
        PG8_STAGE(PG8_SB(1, 0), cB + kstep, voffB); PG8_STAGE(PG8_SA(1, 0), cA + kstep, voffA); PG8_STAGE(PG8_SB(1, 1), cB + hstep + kstep, voffB);
        PG8_WAIT_V(6); PG8_BAR;
    }
    for (;;) {
        const bool has_next = S.next(ui + 1, nxt);
        const char* nA = has_next ? (const char*)g.A + (size_t)nxt.pm * tstepA : cA; const char* nB = has_next ? (const char*)g.Bt + (size_t)nxt.pn * tstep : cB;
#if PROBE_GEMM
        const unsigned tk0 = (unsigned)__builtin_amdgcn_s_memtime();
#endif
        for (int t = 0; t < nt; t += 2) {
            const bool last = (t == nt - 2);
            const char* a1 = cA + (size_t)(t + 1) * kstep;
            const char* a2 = last ? nA : cA + (size_t)(t + 2) * kstep; const char* b2 = last ? nB : cB + (size_t)(t + 2) * kstep;
            const char* a3 = a2 + kstep; const char* b3 = b2 + kstep;
            if (last && has_next) S.a_ready(nxt);
            if constexpr (SP2) {
            const int post = __builtin_amdgcn_readfirstlane((PG8_POSTEPI && t == 0 && ui > 0) ? 1 : 0);
            PG8_LDB(B0, 0, 0); PG8_LDB(B1, 0, 1); PG8_SCHED; PG8_LDA(At, 0, 0); if (!PG8_POSTEPI) PG8_STAGE(PG8_SA(1, 1), a1 + hstepA, voffA);
            PG8_WAIT_VP(post); PG8_WAIT_L(0); PG8_BAR; PG8_MMA(0, 0, At, B0); PG8_MMA(0, 1, At, B1); PG8_BAR; PG8_SCHED;
            PG8_LDA(At, 0, 1); PG8_STAGE(PG8_SB(0, 0), b2, voffB); PG8_STAGE(PG8_SB(0, 1), b2 + hstep, voffB); PG8_STAGE(PG8_SA(0, 0), a2, voffA);
            PG8_WAIT_VP(post); PG8_WAIT_L(0); PG8_BAR; PG8_MMA(1, 0, At, B0); PG8_MMA(1, 1, At, B1); PG8_BAR; PG8_SCHED;
            PG8_LDB(B0, 1, 0); PG8_LDB(B1, 1, 1); PG8_SCHED; PG8_LDA(At, 1, 0); PG8_STAGE(PG8_SA(0, 1), a2 + hstepA, voffA);
            PG8_WAIT_VP(post); PG8_WAIT_L(0); PG8_BAR; PG8_MMA(0, 0, At, B0); PG8_MMA(0, 1, At, B1); PG8_BAR; PG8_SCHED;
            PG8_LDA(At, 1, 1); PG8_STAGE(PG8_SB(1, 0), b3, voffB); PG8_STAGE(PG8_SB(1, 1), b3 + hstep, voffB); PG8_STAGE(PG8_SA(1, 0), a3, voffA);
            PG8_WAIT_V(8); PG8_WAIT_L(0); PG8_BAR; PG8_MMA(1, 0, At, B0); PG8_MMA(1, 1, At, B1); PG8_BAR; PG8_SCHED;
            if (PG8_POSTEPI) PG8_STAGE(PG8_SA(1, 1), a3 + hstepA, voffA);
            } else {
            PG8_LDB(B0, 0, 0); PG8_SCHED; PG8_LDA(At, 0, 0); PG8_STAGE(PG8_SA(1, 1), a1 + hstepA, voffA);
            PG8_WAIT_L(8); PG8_BAR; PG8_WAIT_L(0); PG8_MMA(0, 0, At, B0); PG8_BAR; PG8_SCHED;
            PG8_LDB(B1, 0, 1); PG8_STAGE(PG8_SB(0, 0), b2, voffB);
            PG8_BAR; PG8_WAIT_L(0); PG8_MMA(0, 1, At, B1); PG8_BAR;
            PG8_LDA(At, 0, 1); PG8_STAGE(PG8_SA(0, 0), a2, voffA);
            PG8_BAR; PG8_WAIT_L(0); PG8_MMA(1, 0, At, B0); PG8_BAR; PG8_SCHED;
            PG8_STAGE(PG8_SB(0, 1), b2 + hstep, voffB);
            PG8_WAIT_V(6); PG8_BAR; PG8_MMA(1, 1, At, B1); PG8_BAR;
            PG8_LDB(B0, 1, 0); PG8_SCHED; PG8_LDA(At, 1, 0); PG8_STAGE(PG8_SA(0, 1), a2 + hstepA, voffA);
            PG8_WAIT_L(8); PG8_BAR; PG8_WAIT_L(0); PG8_MMA(0, 0, At, B0); PG8_BAR; PG8_SCHED;
            PG8_LDB(B1, 1, 1); PG8_STAGE(PG8_SB(1, 0), b3, voffB);
            PG8_BAR; PG8_WAIT_L(0); PG8_MMA(0, 1, At, B1); PG8_BAR;
            PG8_LDA(At, 1, 1); PG8_STAGE(PG8_SA(1, 0), a3, voffA);
            PG8_BAR; PG8_WAIT_L(0); PG8_MMA(1, 0, At, B0); PG8_BAR; PG8_SCHED;
            PG8_STAGE(PG8_SB(1, 1), b3 + hstep, voffB);
            PG8_WAIT_V(6); PG8_BAR; PG8_MMA(1, 1, At, B1); PG8_BAR;
            }
        }
#if PROBE_GEMM
        tgk += (unsigned)__builtin_amdgcn_s_memtime() - tk0;
#endif
        if constexpr (ALIGN_EPI) { if (wr == 0) PG8_BAR; }
        if constexpr (!Epi::AFTER_DRAIN) { E(acc, cur, wr, wc, fr, fq, ui); S.done(cur); }
        if (!has_next) break;
#pragma unroll
        for (int a = 0; a < 2; ++a)
#pragma unroll
            for (int b = 0; b < 2; ++b)
#pragma unroll
                for (int m = 0; m < 4; ++m)
#pragma unroll
                    for (int n = 0; n < 2; ++n) acc[a][b][m][n] = (f32x4){0.f, 0.f, 0.f, 0.f};
        cur = nxt; cA = nA; cB = nB; ++ui;
        if constexpr (ALIGN_EPI) { if (wr == 1) PG8_BAR; }
    }
    PG8_WAIT_V(0);
    if constexpr (!ALIGN_EPI) { if (wr == 0) PG8_BAR; }
    PG8_BAR;
    if constexpr (Epi::AFTER_DRAIN) { E.fused(acc, cur, wr, wc, fr, fq, lds, wid, lane); S.done(cur); }
#if PROBE_GEMM
    if (tp) *tp += (PROBE_GEMM == 1) ? tgk : ((unsigned)__builtin_amdgcn_s_memtime() - tg0);
#endif
#undef PG8_SA
#undef PG8_SB
#undef PG8_STAGE
#undef PG8_LDA
#undef PG8_LDB
#undef PG8_MMA
#undef PG8_WAIT_V
#undef PG8_WAIT_L
#undef PG8_WAIT_VP
#undef PG8_BAR
#undef PG8_SCHED
}
}
#ifndef PG8_SP2
#define PG8_SP2 true
#endif
#ifndef PG8_ALIGN
#define PG8_ALIGN true
#endif

constexpr int NWAVES = 8;
#ifndef MK_ONE_LAUNCH
#define MK_ONE_LAUNCH 1
#endif

#define PROBE_NREP 2
#define PROBE_SEG 0
#define PROBE_BAR 0
#define PROBE_BLOCK 0
#define PROBE_BAR2 0
#define PROBE_BARMASK 0x7fffu
#define PROBE_SITE 8
#define PROBE_MODE 0
#define PROBE_SHIFT 0
constexpr int M = 8192, DM = 4096, SEQ = 2048, NH = 32;
constexpr int MLA_IN = 5696, MLA_INP = 5888, QL = 1024, KVL = 512, QKD = 192, NQ = NH * QKD, NKV = NH * 256;
constexpr int C_KVLAT = 1024, C_KPE = 1536, C_GATE = 1600;
constexpr int SB_IN = 16384, C_SBK = 4096, C_SBV = 8192, C_SBG = 12288;
constexpr float EPS = 1e-6f;
constexpr float Q_SCALE_MLA = 0.07216878364870323f * 1.4426950408889634f;
constexpr float Q_SCALE_SB = 0.08838834764831845f * 1.4426950408889634f;
constexpr int N_PHASES = 15;
#ifndef OUTPROJ_STAGGER
#define OUTPROJ_STAGGER 0
#endif

constexpr size_t MiB = 1u << 20;
constexpr size_t WS_CTL = 0, CTL_ZERO_BYTES = 1 * MiB;
constexpr size_t WS_ROPE = 1 * MiB;
constexpr size_t WS_W = 2 * MiB, W_LAYER = 258 * MiB;
constexpr size_t W_IN_MLA = 0, W_QB = 46 * MiB, W_KVB = 58 * MiB, W_OUT_MLA = 66 * MiB, W_IN_SB = 98 * MiB, W_OUT_SB = 226 * MiB;
constexpr size_t WS_ACT = WS_W + 2 * W_LAYER;
constexpr size_t A_XN = WS_ACT, A_PROJ = WS_ACT + 64 * MiB, A_QN = WS_ACT + 320 * MiB, A_KVN = WS_ACT + 336 * MiB, A_QRAW = WS_ACT + 344 * MiB,
                 A_KVRAW = WS_ACT + 440 * MiB, A_KPER = WS_ACT + 568 * MiB  , A_SSPE = WS_ACT + 570 * MiB  , A_SSKP = WS_ACT + 572 * MiB  , A_XLO = WS_ACT + 600 * MiB  , A_OG = WS_ACT + 760 * MiB, WS_END = WS_ACT + 824 * MiB;
constexpr int CW_TMO = 0, CW_P0Q = 2048  , CW_BAR = 4096;
constexpr size_t WS_SS = 64 * 1024, SS_BYTES = 64 * 1024;

constexpr int RING_OFF = 0, RING_BYTES = 131072;
constexpr int LDSCTL_OFF = RING_BYTES, MISC_OFF = LDSCTL_OFF + 320;
constexpr int LDS_BYTES = 147456;

#define GAS __attribute__((address_space(1)))
#define LAS __attribute__((address_space(3)))
typedef unsigned short bf16;
typedef unsigned v4u __attribute__((ext_vector_type(4)));
typedef unsigned v2u __attribute__((ext_vector_type(2)));
typedef float f32x4 __attribute__((ext_vector_type(4)));
typedef GAS unsigned gu32;
#define RLX_AGENT __ATOMIC_RELAXED, __HIP_MEMORY_SCOPE_AGENT
#define LDS_WAIT() asm volatile("s_waitcnt lgkmcnt(0)" ::: "memory")
__device__ __forceinline__ float bf_lo(unsigned w) { return __uint_as_float(w << 16); }
__device__ __forceinline__ float bf_hi(unsigned w) { return __uint_as_float(w & 0xffff0000u); }
__device__ __forceinline__ unsigned pk2(float lo, float hi) { return pg8::cvt_pk_bf16(lo, hi); }
__device__ __forceinline__ void unpack8(v4u w, float (&f)[8]) { f[0] = bf_lo(w.x); f[1] = bf_hi(w.x); f[2] = bf_lo(w.y); f[3] = bf_hi(w.y); f[4] = bf_lo(w.z); f[5] = bf_hi(w.z); f[6] = bf_lo(w.w); f[7] = bf_hi(w.w); }
__device__ __forceinline__ v4u pack8(const float (&f)[8]) { v4u w; w.x = pk2(f[0], f[1]); w.y = pk2(f[2], f[3]); w.z = pk2(f[4], f[5]); w.w = pk2(f[6], f[7]); return w; }

#define XB_TMO      128
#define XB_XCNT(j)  (256  + 64 * (j))
#define XB_XSUB(j)  (1280 + 64 * (j))
#define XB_XGEN(j)  (2304 + 64 * (j))
#define XB_TOP      3328
#define XB_TOPGEN   3392
#define XCD_BAR_WORDS 3456
#define XB_SPIN_CAP (1u << 18)

__device__ __forceinline__ unsigned xb_ld(unsigned* p)              { return __hip_atomic_load(p, __ATOMIC_RELAXED, __HIP_MEMORY_SCOPE_AGENT); }
__device__ __forceinline__ unsigned xb_add(unsigned* p, unsigned v) { return __hip_atomic_fetch_add(p, v, __ATOMIC_RELAXED, __HIP_MEMORY_SCOPE_AGENT); }
__device__ __forceinline__ unsigned xb_xcc_id() { return (unsigned)__builtin_amdgcn_s_getreg((3 << 11) | 20) & 0xFu; }
#define XB_SPIN(cond, bar) do { unsigned _sp = 0; while (cond) { __builtin_amdgcn_s_sleep(1); \
    if ((++_sp & 255u) == 0u) { if (xb_ld(&(bar)[XB_TMO])) break; if (_sp > XB_SPIN_CAP) { atomicAdd(&(bar)[XB_TMO], 1u); break; } } } } while (0)

struct XcdBarrier {
    unsigned* bar; unsigned x;
    volatile LAS unsigned* st;
};

__device__ __forceinline__ XcdBarrier xcd_barrier_post(unsigned* bar, volatile LAS unsigned* st) {
    XcdBarrier b; b.bar = bar; b.x = xb_xcc_id(); b.st = st;
    if (threadIdx.x == 0) (void)xb_add(&bar[XB_XCNT(b.x)], 1u);
    return b;
}
__device__ __forceinline__ void xcd_barrier_complete(unsigned* bar, unsigned x, unsigned& nloc, unsigned& nx) {
    const unsigned G = gridDim.x * gridDim.y * gridDim.z;
    unsigned sum, cnt, mine, sp = 0u;
    for (;;) {
        sum = 0u; cnt = 0u; mine = 0u;
#pragma unroll
        for (unsigned j = 0; j < 16; ++j) { const unsigned c = xb_ld(&bar[XB_XCNT(j)]); sum += c; cnt += (c > 0u) ? 1u : 0u; mine = (j == x) ? c : mine; }
        if (sum == G) break;
        __builtin_amdgcn_s_sleep(1);
        if ((++sp & 255u) == 0u) { if (xb_ld(&bar[XB_TMO])) break; if (sp > XB_SPIN_CAP) { atomicAdd(&bar[XB_TMO], 1u); break; } }
    }
    nloc = mine > 0u ? mine : 1u; nx = cnt > 0u ? cnt : 1u;
}

__device__ __forceinline__ void xcd_barrier(const XcdBarrier& b) {
    asm volatile("s_waitcnt vmcnt(0)" ::: "memory");
    __syncthreads();
    if (threadIdx.x == 0) {
        unsigned* bar = b.bar;
        __builtin_amdgcn_s_waitcnt(0);
        unsigned nloc = b.st[0], nx = b.st[1];
        if (nloc == 0u) { xcd_barrier_complete(bar, b.x, nloc, nx); b.st[0] = nloc; b.st[1] = nx; }
        const unsigned old = xb_add(&bar[XB_XSUB(b.x)], 1u);
        const unsigned gen = old / nloc;
        if (old + 1u == (gen + 1u) * nloc) {
            __builtin_amdgcn_fence(__ATOMIC_RELEASE, "agent");
            asm volatile("s_waitcnt vmcnt(0)" ::: "memory");
            const unsigned og = xb_add(&bar[XB_TOP], 1u);
            const unsigned tg = og / nx;
            if (og + 1u == (tg + 1u) * nx) xb_add(&bar[XB_TOPGEN], 1u);
            else XB_SPIN(xb_ld(&bar[XB_TOPGEN]) == tg, bar);
            __builtin_amdgcn_fence(__ATOMIC_ACQUIRE, "agent");
            xb_add(&bar[XB_XGEN(b.x)], 1u);
            asm volatile("s_waitcnt vmcnt(0)" ::: "memory");
        } else {
            XB_SPIN(xb_ld(&bar[XB_XGEN(b.x)]) == gen, bar);
            __builtin_amdgcn_fence(__ATOMIC_ACQUIRE, "agent");
            asm volatile("s_waitcnt vmcnt(0)" ::: "memory");
        }
    }
    __syncthreads();
}

#define LAUNDER_V(x) asm volatile("" : "+v"(x))
__device__ __forceinline__ float wave_sum(float v) {
#pragma unroll
    for (int o = 1; o < 64; o <<= 1) v += __shfl_xor(v, o);
    return v;
}
__device__ __forceinline__ void p0_item_load(const float* W, int N, int item, int lane, f32x4 (&v)[16]) {
    const int nblk = N / 64, kb = item / nblk, nb = item % nblk, k0 = 64 * kb, n0 = 64 * nb, rr = lane >> 4, c4 = (lane & 15) * 4;
#pragma unroll
    for (int i = 0; i < 16; ++i) v[i] = *(const GAS f32x4*)(W + (size_t)(k0 + 4 * i + rr) * N + n0 + c4);
}
__device__ __forceinline__ void p0_item_store(const f32x4 (&v)[16], int K, int N, bf16* WT, LAS float* scr, int item, int lane, int nscale, float scale, const float* kg) {
    const int nblk = N / 64, kb = item / nblk, nb = item % nblk, k0 = 64 * kb, n0 = 64 * nb;
    const int rr = lane >> 4, c4 = (lane & 15) * 4;
#pragma unroll
    for (int i = 0; i < 16; ++i) { const int k = 4 * i + rr; *(LAS f32x4*)(scr + k * 64 + (c4 ^ ((k >> 3) * 4))) = v[i]; }
    LDS_WAIT(); asm volatile("" ::: "memory");
    const int c = lane & 7, nl = lane >> 3;
    f32x4 ga = (f32x4){1.f, 1.f, 1.f, 1.f}, gb = ga;
    if (kg) { ga = *(const GAS f32x4*)(kg + k0 + 8 * c); gb = *(const GAS f32x4*)(kg + k0 + 8 * c + 4); }
#pragma unroll
    for (int j = 0; j < 8; ++j) { const int n = nl + 8 * j; const LAS float* s = scr + (8 * c) * 64 + (n ^ (4 * c));
        const float sc = (n0 + n) < nscale ? scale : 1.f;
        v4u o; o.x = pk2(s[0 * 64] * (sc * ga.x), s[1 * 64] * (sc * ga.y)); o.y = pk2(s[2 * 64] * (sc * ga.z), s[3 * 64] * (sc * ga.w)); o.z = pk2(s[4 * 64] * (sc * gb.x), s[5 * 64] * (sc * gb.y)); o.w = pk2(s[6 * 64] * (sc * gb.z), s[7 * 64] * (sc * gb.w));
        *(GAS v4u*)(WT + (size_t)(n0 + n) * K + k0 + 8 * c) = o; }
    LDS_WAIT(); asm volatile("" ::: "memory");
}
__device__ __forceinline__ void p0_transpose(const float* W, int K, int N, bf16* WT, LAS float* scr, int gw, int NGW, int lane, const float* kg = nullptr, int nscale = 0, float scale = 1.f) {
    LAUNDER_V(lane);
    const int items = (K / 64) * (N / 64);
    f32x4 va[16], vb[16];
    int it = gw;
    if (it < items) p0_item_load(W, N, it, lane, va);
    for (; it < items; it += 2 * NGW) {
        const int it1 = it + NGW, it2 = it + 2 * NGW;
        if (it1 < items) p0_item_load(W, N, it1, lane, vb);
        p0_item_store(va, K, N, WT, scr, it, lane, nscale, scale, kg);
        if (it1 < items) { if (it2 < items) p0_item_load(W, N, it2, lane, va); p0_item_store(vb, K, N, WT, scr, it1, lane, nscale, scale, kg); }
    }
}
__device__ __forceinline__ void x_to_bf16_rows(const float* x, bf16* xb, bf16* xlo, unsigned long long* ss, int gw, int NGW, int lane) {
    LAUNDER_V(lane);
    for (int m = 2 * gw; m < M; m += 2 * NGW) {
        const GAS f32x4* xr = (const GAS f32x4*)(x + (size_t)m * DM) + lane;
        f32x4 v[16], w[16]; float s = 0.f, t = 0.f;
#pragma unroll
        for (int j = 0; j < 16; ++j) { v[j] = xr[64 * j]; w[j] = xr[DM / 4 + 64 * j]; }
#pragma unroll
        for (int j = 0; j < 16; ++j) { s += (v[j].x * v[j].x + v[j].y * v[j].y) + (v[j].z * v[j].z + v[j].w * v[j].w); t += (w[j].x * w[j].x + w[j].y * w[j].y) + (w[j].z * w[j].z + w[j].w * w[j].w); }
#pragma unroll
        for (int o = 1; o < 64; o <<= 1) { s += __shfl_xor(s, o); t += __shfl_xor(t, o); }
        if (lane == 0) { ss[m] = (unsigned long long)(s * pg8::SS_FIX); ss[m + 1] = (unsigned long long)(t * pg8::SS_FIX); }
        GAS v2u* o8 = (GAS v2u*)(xb + (size_t)m * DM) + lane; GAS v2u* l8 = (GAS v2u*)(xlo + (size_t)m * DM) + lane;
#pragma unroll
        for (int j = 0; j < 16; ++j) { v2u o, q, ol, ql; o.x = pk2(v[j].x, v[j].y); o.y = pk2(v[j].z, v[j].w); o8[64 * j] = o; q.x = pk2(w[j].x, w[j].y); q.y = pk2(w[j].z, w[j].w); o8[DM / 4 + 64 * j] = q;
            ol.x = pk2(v[j].x - bf_lo(o.x), v[j].y - bf_hi(o.x)); ol.y = pk2(v[j].z - bf_lo(o.y), v[j].w - bf_hi(o.y)); l8[64 * j] = ol;
            ql.x = pk2(w[j].x - bf_lo(q.x), w[j].y - bf_hi(q.x)); ql.y = pk2(w[j].z - bf_lo(q.y), w[j].w - bf_hi(q.y)); l8[DM / 4 + 64 * j] = ql; }
    }
}
constexpr int P0_T0 = (DM / 64) * (MLA_IN / 64), P0_T1 = (QL / 64) * (NQ / 64), P0_T2 = (KVL / 64) * (NKV / 64), P0_T3 = (DM / 64) * (DM / 64), P0_T4 = (DM / 64) * (SB_IN / 64), P0_T5 = P0_T3;
constexpr int P1_CHUNK = 8;
constexpr int FQ_KV0 = P0_T1 + P0_T2, FQ_OM0 = FQ_KV0 + P0_T3, FQ_IS0 = FQ_OM0 + P0_T4, FQ_OS0 = FQ_IS0 + P0_T5, FQ_IM1 = FQ_OS0 + P0_T0, FQ_KV1 = FQ_IM1 + P0_T1 + P0_T2, FQ_OM1 = FQ_KV1 + P0_T3,
              FQ_IS1 = FQ_OM1 + P0_T4, FQ_OS1 = FQ_IS1 + P0_T5, FQ_ITEMS = FQ_OS1;
struct P1Fill {
    const float* const* in; unsigned char* ws; gu32* q; LAS float* scr; int cbase, cpos;
    __device__ __forceinline__ bool item(int lane, int limit = FQ_ITEMS) {
        if (cpos >= P1_CHUNK) { unsigned v = 0; if (lane == 0) v = __hip_atomic_fetch_add(q, (unsigned)P1_CHUNK, __ATOMIC_RELAXED, __HIP_MEMORY_SCOPE_AGENT); cbase = __builtin_amdgcn_readfirstlane((int)v); cpos = 0; }
        int r = cbase + cpos;
        if (r >= limit) return false;
        ++cpos;
        LAUNDER_V(lane);
        int z_; asm volatile("s_mov_b32 %0, 0" : "=s"(z_));
        const float* const* in = this->in + z_; unsigned char* ws = this->ws + z_;
        const int j = r >= FQ_OS0 ? 1 : 0; if (j) r -= FQ_OS0; else r += P0_T0;
        unsigned char* wl = ws + WS_W + (size_t)j * W_LAYER;
        const float* W; bf16* WT; const float* kg = nullptr; int K, N, nscale = 0; float scale = 1.f;
        if (r < P0_T0) { W = in[2] + (size_t)j * DM * MLA_IN; K = DM; N = MLA_IN; WT = (bf16*)(wl + W_IN_MLA); kg = in[1] + (size_t)j * DM; }
        else if ((r -= P0_T0) < P0_T1) { W = in[4] + (size_t)j * QL * NQ; K = QL; N = NQ; WT = (bf16*)(wl + W_QB); kg = in[3] + (size_t)j * QL; }
        else if ((r -= P0_T1) < P0_T2) { W = in[6] + (size_t)j * KVL * NKV; K = KVL; N = NKV; WT = (bf16*)(wl + W_KVB); kg = in[5] + (size_t)j * KVL; }
        else if ((r -= P0_T2) < P0_T3) { W = in[9] + (size_t)j * DM * DM; K = DM; N = DM; WT = (bf16*)(wl + W_OUT_MLA); }
        else if ((r -= P0_T3) < P0_T4) { W = in[11] + (size_t)j * DM * SB_IN; K = DM; N = SB_IN; WT = (bf16*)(wl + W_IN_SB); kg = in[10] + (size_t)j * DM; nscale = DM; scale = Q_SCALE_SB; }
        else { r -= P0_T4; W = in[12] + (size_t)j * DM * DM; K = DM; N = DM; WT = (bf16*)(wl + W_OUT_SB); }
        f32x4 v[16]; p0_item_load(W, N, r, lane, v); p0_item_store(v, K, N, WT, scr, r, lane, nscale, scale, kg);
        return true;
    }
};
__device__ __forceinline__ void xcd_barrier_fill(const XcdBarrier& b, P1Fill& F, int wave, int lane) {
    asm volatile("s_waitcnt vmcnt(0)" ::: "memory");
    if (threadIdx.x == 0) b.st[2] = 0u;
    __syncthreads();
    if (wave == 0) {
        if (threadIdx.x == 0) {
            unsigned* bar = b.bar;
            __builtin_amdgcn_s_waitcnt(0);
            unsigned nloc = b.st[0], nx = b.st[1];
            if (nloc == 0u) { xcd_barrier_complete(bar, b.x, nloc, nx); b.st[0] = nloc; b.st[1] = nx; }
            const unsigned old = xb_add(&bar[XB_XSUB(b.x)], 1u);
            const unsigned gen = old / nloc;
            if (old + 1u == (gen + 1u) * nloc) {
                __builtin_amdgcn_fence(__ATOMIC_RELEASE, "agent");
                asm volatile("s_waitcnt vmcnt(0)" ::: "memory");
                const unsigned og = xb_add(&bar[XB_TOP], 1u);
                const unsigned tg = og / nx;
                if (og + 1u == (tg + 1u) * nx) xb_add(&bar[XB_TOPGEN], 1u);
                else { b.st[2] = 1u; XB_SPIN(xb_ld(&bar[XB_TOPGEN]) == tg, bar); }
                __builtin_amdgcn_fence(__ATOMIC_ACQUIRE, "agent");
                xb_add(&bar[XB_XGEN(b.x)], 1u);
                asm volatile("s_waitcnt vmcnt(0)" ::: "memory");
            } else {
                b.st[2] = 1u;
                XB_SPIN(xb_ld(&bar[XB_XGEN(b.x)]) == gen, bar);
                __builtin_amdgcn_fence(__ATOMIC_ACQUIRE, "agent");
                asm volatile("s_waitcnt vmcnt(0)" ::: "memory");
            }
            b.st[2] = 2u;
        }
    } else {
        while (b.st[2] == 0u) __builtin_amdgcn_s_sleep(1);
        while (b.st[2] == 1u) { if (!F.item(lane)) { while (b.st[2] == 1u) __builtin_amdgcn_s_sleep(2); break; } }
    }
    __syncthreads();
}

__device__ __forceinline__ void kpe_rows(const bf16* proj, const float* gk, const float* ropec, const float* ropes, bf16* kper, float* sspe, int gw, int NGW, int lane) {
    LAUNDER_V(lane);
    const int tk = lane >> 3, c = lane & 7;
    float g[8];
#pragma unroll
    for (int e = 0; e < 8; ++e) g[e] = gk[128 + 8 * c + e];
    for (int m0 = 8 * gw; m0 < M; m0 += 8 * NGW) { const int m = m0 + tk, pos = m & (SEQ - 1);
        float f[8], x[8], pr[8], o[8]; unpack8(*(const GAS v4u*)(proj + (size_t)m * MLA_INP + C_KPE + 8 * c), f);
        float ss = 0.f;
#pragma unroll
        for (int e = 0; e < 8; ++e) { ss += f[e] * f[e]; x[e] = f[e] * g[e]; }
        ss += __shfl_xor(ss, 1); ss += __shfl_xor(ss, 2); ss += __shfl_xor(ss, 4);
        if (c == 0) sspe[m] = ss;
#pragma unroll
        for (int e = 0; e < 8; ++e) pr[e] = __shfl_xor(x[e], 4);
        const float* cs = ropec + pos * 32 + (c & 3) * 8; const float* sn = ropes + pos * 32 + (c & 3) * 8;
#pragma unroll
        for (int e = 0; e < 8; ++e) o[e] = (c < 4) ? (x[e] * cs[e] - pr[e] * sn[e]) : (pr[e] * sn[e] + x[e] * cs[e]);
        *(GAS v4u*)(kper + (size_t)m * 64 + 8 * c) = pack8(o); }
}


namespace fa {
typedef short bf16x8 __attribute__((ext_vector_type(8)));
typedef short s16x4 __attribute__((ext_vector_type(4)));
typedef float f32x16 __attribute__((ext_vector_type(16)));
typedef float f32x2 __attribute__((ext_vector_type(2)));
#define FA_SBAR() __builtin_amdgcn_sched_barrier(0)
#ifndef FA_PV_DEFER
#define FA_PV_DEFER 1
#endif
#ifndef FA_PP2_LAG
#define FA_PP2_LAG 0
#endif
#ifndef FA_PP2
#define FA_PP2 0
#endif
#ifndef FA_PP
#define FA_PP 0
#endif
constexpr int SHM_V = 16384;
__device__ __forceinline__ int v_st(int k, int c) { const int kk = (k & ~0xC) | ((k & 4) << 1) | ((k & 8) >> 1); return ((kk >> 3) * 4 + (c >> 5)) * 512 + ((kk & 7) * 32 + (c & 31)) * 2; }
__device__ __forceinline__ int v_rd_base(int lane) { return ((lane & 3) << 3) | (((lane >> 2) & 3) << 6) | (((lane >> 4) & 1) << 5) | (((lane >> 5) & 1) << 8); }
__device__ __forceinline__ unsigned cvtpk(float lo, float hi) { unsigned r; asm volatile("v_cvt_pk_bf16_f32 %0, %1, %2" : "=v"(r) : "v"(lo), "v"(hi)); return r; }
__device__ __forceinline__ bf16x8 pack8p(const f32x16& p, int b) { v4u w = {cvtpk(p[b + 0], p[b + 1]), cvtpk(p[b + 2], p[b + 3]), cvtpk(p[b + 4], p[b + 5]), cvtpk(p[b + 6], p[b + 7])}; return __builtin_bit_cast(bf16x8, w); }
__device__ __forceinline__ float ex2(float x) { return __builtin_amdgcn_exp2f(x); }
__device__ __forceinline__ float lg2(float x) { return __builtin_amdgcn_logf(x); }

struct AttnP { const bf16* Q; int qpitch, qhs; const bf16* K; int kpitch, khs; const bf16* V; int vpitch, vhs; const bf16* Gt; int gpitch; bf16* O;
               const bf16* KR; const float* sskp; const float* sspe; const float* gq; const float* gk; const float* rc; const float* rs; };
template <int MODE>
__device__ __forceinline__ void attn_phase(LAS unsigned char* lds, const AttnP& P, int G, int vcu, LAS unsigned* ecnt, unsigned& tacc) {
#if PROBE_SEG
    unsigned t_prev = 0;
#define FA_STAMP_ON(k) (PROBE_SEG == 9 || (k) == 0 || (k) == PROBE_SEG || ((k) == PROBE_SEG - 1 && PROBE_SEG >= 2 && PROBE_SEG <= 4))
#define FA_STAMP(k) do { if (PROBE_MODE == MODE && FA_STAMP_ON(k)) { asm volatile("" ::: "memory"); const unsigned t_now = (unsigned)__builtin_amdgcn_s_memtime(); asm volatile("s_waitcnt lgkmcnt(0)" ::: "memory"); if (PROBE_SEG == (k) || (PROBE_SEG == 9 && (k) != 0)) tacc += t_now - t_prev; t_prev = t_now; } } while (0)
#else
#define FA_STAMP(k) do { } while (0)
#endif
    const bf16* Qp = P.Q; const int qpitch = P.qpitch, qhs = P.qhs; const bf16* Kp = P.K; const int kpitch = P.kpitch, khs = P.khs; const bf16* Vp = P.V; const int vpitch = P.vpitch, vhs = P.vhs;
    const bf16* Gp = P.Gt; const int gpitch = P.gpitch; bf16* Op = P.O;
    constexpr int DQK = MODE == 0 ? 192 : 128, ND = DQK / 16, KPITCH = DQK * 2, SHM_K = 64 * KPITCH, KP = SHM_K / 8192, VOFF = 2 * SHM_K, NVB = (MODE == 0 && (FA_PP2 || FA_PV_DEFER)) ? 3 : 2, RKOFF = VOFF + NVB * SHM_V, QROFF = RKOFF + 8192, NDR = (PROBE_SEG && MODE == 0) ? 7 : 8, GTOFF = 131072 + 1024  ;
    int tid_l = threadIdx.x; asm volatile("" : "+v"(tid_l));
    const int tid = tid_l, wid = __builtin_amdgcn_readfirstlane(tid >> 6), lane = tid & 63;
#define FA_QRBASE ((MODE == 0 && (FA_PP2 || FA_PV_DEFER) && wid >= 6) ? 133120 + (wid - 6) * 4096 : QROFF + wid * (NDR < 8 ? 5120 : 4096))
#define FA_LANE_ADDRS(ln) const int r32 = (ln) & 31, hi = (ln) >> 5; const int kswz = MODE == 0 ? (((r32 >> 1) & 7) << 4) : ((r32 & 15) << 4); const int krow = r32 * KPITCH; \
        const int vb0 = (int)(uintptr_t)lds + VOFF + v_rd_base(ln); LAS unsigned char* qrl = lds + FA_QRBASE + (ln) * 16;
    const float NEG_INF = -__builtin_inff();
    constexpr float SB_CUT = -160.f;
    int un = 0;
    if (MODE == 1) { if (tid < 64) ecnt[tid] = 0u; asm volatile("s_waitcnt lgkmcnt(0)\n\ts_barrier" ::: "memory"); }

#define FA_DMA_OFFS(koff, krope, voff) unsigned koff[KP], voff[2]; bool krope[KP]; { int ln_ = lane; asm volatile("" : "+v"(ln_)); \
            _Pragma("unroll") for (int i_ = 0; i_ < KP; ++i_) { const int L = (wid * KP + i_) * 1024 + ln_ * 16, v = L / KPITCH, sb = L % KPITCH; \
                const int swz = MODE == 0 ? (((v >> 1) & 7) << 4) : ((v & 15) << 4), cb = sb ^ swz, vi = v & 31, dim = cb >> 1; \
                const int key = (v & 32) + (vi & 3) + 4 * (vi >> 3) + 16 * ((vi >> 2) & 1);                     \
                krope[i_] = MODE == 0 && dim >= 128; koff[i_] = krope[i_] ? (unsigned)(key * 64 + dim - 128) : (unsigned)(key * kpitch + dim); } \
            _Pragma("unroll") for (int i_ = 0; i_ < 2; ++i_) { const int L = (wid * 2 + i_) * 1024 + ln_ * 16, sub = L >> 9, within = L & 511, kk = (sub >> 2) * 8 + (within >> 6); \
                const int u_ = (kk & ~0xC) | ((kk & 4) << 1) | ((kk & 8) >> 1);                                    \
                const int key = (u_ & ~0x18) | ((u_ & 8) << 1) | ((u_ & 16) >> 1);                                  \
                voff[i_] = (unsigned)(key * vpitch + (sub & 3) * 32 + ((within & 63) >> 4) * 8); } }
#define FA_DMA_GO(koff, krope, voff, Kh_, Vh_, KRh_, j, KB) do { const bf16* kb_ = (Kh_) + (size_t)(j) * 64 * kpitch; const bf16* vb_ = (Vh_) + (size_t)(j) * 64 * vpitch; const bf16* kr_ = MODE == 0 ? (KRh_) + (size_t)(j) * 64 * 64 : nullptr; \
            _Pragma("unroll") for (int i_ = 0; i_ < KP; ++i_) __builtin_amdgcn_global_load_lds((const unsigned*)(((MODE == 0 && krope[i_]) ? kr_ : kb_) + koff[i_]), (LAS unsigned*)(lds + (KB) * SHM_K + (wid * KP + i_) * 1024), 16, 0, 0); \
            _Pragma("unroll") for (int i_ = 0; i_ < 2; ++i_) __builtin_amdgcn_global_load_lds((const unsigned*)(vb_ + voff[i_]), (LAS unsigned*)(lds + VOFF + (KB) * SHM_V + (wid * 2 + i_) * 1024), 16, 0, 0); } while (0)
#define FA_WAITBAR() asm volatile("s_waitcnt vmcnt(0) lgkmcnt(0)\n\ts_barrier" ::: "memory")
#define FA_TRRD(dst, off) asm volatile("ds_read_b64_tr_b16 %0, %1 offset:%2" : "=&v"(dst) : "v"(vb0), "i"(off) : "memory")
#define FA_PV_D0(d0, VB) do { s16x4 l0, l1, l2, l3, h0, h1, h2, h3; constexpr int b_ = (VB) * SHM_V + (d0) * 512; \
            FA_TRRD(l0, b_); FA_TRRD(h0, b_ + 2048); FA_TRRD(l1, b_ + 4096); FA_TRRD(h1, b_ + 6144); FA_TRRD(l2, b_ + 8192); FA_TRRD(h2, b_ + 10240); FA_TRRD(l3, b_ + 12288); FA_TRRD(h3, b_ + 14336); \
            asm volatile("s_waitcnt lgkmcnt(0)" ::: "memory"); FA_SBAR(); \
            o[d0] = __builtin_amdgcn_mfma_f32_32x32x16_bf16((bf16x8){l0[0], l0[1], l0[2], l0[3], h0[0], h0[1], h0[2], h0[3]}, pa0, o[d0], 0, 0, 0); \
            o[d0] = __builtin_amdgcn_mfma_f32_32x32x16_bf16((bf16x8){l1[0], l1[1], l1[2], l1[3], h1[0], h1[1], h1[2], h1[3]}, pa1, o[d0], 0, 0, 0); \
            o[d0] = __builtin_amdgcn_mfma_f32_32x32x16_bf16((bf16x8){l2[0], l2[1], l2[2], l2[3], h2[0], h2[1], h2[2], h2[3]}, pa2, o[d0], 0, 0, 0); \
            o[d0] = __builtin_amdgcn_mfma_f32_32x32x16_bf16((bf16x8){l3[0], l3[1], l3[2], l3[3], h3[0], h3[1], h3[2], h3[3]}, pa3, o[d0], 0, 0, 0); } while (0)
#define FA_STEP(t, KB) do { const int j = MODE == 0 ? (t) : NT - 1 - (t); int ln_s = lane; asm volatile("" : "+v"(ln_s)); FA_LANE_ADDRS(ln_s) \
            FA_STAMP(0); \
            if ((t) + 1 < NT) { const int jn = MODE == 0 ? (t) + 1 : NT - 2 - (t); FA_DMA_GO(sko, skr, svo, Kh, Vh, KRh, jn, (KB) ^ 1); } \
            if (j <= jmax && !(MODE == 1 && wdone)) { \
                f32x16 p0 = f32x16{}, p1 = f32x16{}; \
                _Pragma("unroll") for (int d0 = 0; d0 < ND; ++d0) { const int cb = d0 * 32 + hi * 16; const LAS unsigned char* a = lds + (KB) * SHM_K + krow + (cb ^ kswz); \
                    const bf16x8 k0 = *(const LAS bf16x8*)a, k1 = *(const LAS bf16x8*)(a + 32 * KPITCH); \
                    const bf16x8 qf = d0 < NDR ? qr[d0 < NDR ? d0 : 0] : *(const LAS bf16x8*)(qrl + (d0 == 7 ? 4 : d0 - 8) * 1024); \
                    p0 = __builtin_amdgcn_mfma_f32_32x32x16_bf16(k0, qf, p0, 0, 0, 0); p1 = __builtin_amdgcn_mfma_f32_32x32x16_bf16(k1, qf, p1, 0, 0, 0); } \
                const int kb = j * 64, dq = qlo + r32 - kb - 16 * hi; \
                if (PROBE_SEG) { asm volatile("" : "+v"(p0), "+v"(p1)); FA_STAMP(1); }     \
                if (MODE == 0) { \
                    { const LAS float* rkw = (const LAS float*)(lds + RKOFF) + kb; \
                      _Pragma("unroll") for (int g_ = 0; g_ < 4; ++g_) { const f32x4 ra = *(const LAS f32x4*)(rkw + 16 * hi + 4 * g_), rb = *(const LAS f32x4*)(rkw + 32 + 16 * hi + 4 * g_); \
                          p0[4 * g_] *= ra.x; p0[4 * g_ + 1] *= ra.y; p0[4 * g_ + 2] *= ra.z; p0[4 * g_ + 3] *= ra.w; p1[4 * g_] *= rb.x; p1[4 * g_ + 1] *= rb.y; p1[4 * g_ + 2] *= rb.z; p1[4 * g_ + 3] *= rb.w; } } \
                    if (kb + 63 > qlo) { _Pragma("unroll") for (int r = 0; r < 16; ++r) { if (r > dq) p0[r] = NEG_INF; if (r + 32 > dq) p1[r] = NEG_INF; } } \
                    float pmax = p0[0]; _Pragma("unroll") for (int r = 1; r < 16; ++r) pmax = fmaxf(pmax, p0[r]); _Pragma("unroll") for (int r = 0; r < 16; ++r) pmax = fmaxf(pmax, p1[r]); \
                    { auto rr = __builtin_amdgcn_permlane32_swap(__float_as_uint(pmax), __float_as_uint(pmax), false, false); pmax = fmaxf(__uint_as_float(rr[0]), __uint_as_float(rr[1])); } \
                    if (!__all(pmax - m_reg <= 11.5f)) { const float mn = fmaxf(m_reg, pmax), alpha = ex2(m_reg - mn); m_reg = mn; l_reg *= alpha; \
                        _Pragma("unroll") for (int d0 = 0; d0 < 4; ++d0) _Pragma("unroll") for (int r = 0; r < 16; ++r) o[d0][r] *= alpha; } \
                    float ps = 0.f; \
                    _Pragma("unroll") for (int r = 0; r < 16; r += 2) { const f32x2 a0 = (f32x2){p0[r], p0[r + 1]} - (f32x2){m_reg, m_reg}, a1 = (f32x2){p1[r], p1[r + 1]} - (f32x2){m_reg, m_reg}; \
                        p0[r] = ex2(a0.x); p0[r + 1] = ex2(a0.y); p1[r] = ex2(a1.x); p1[r + 1] = ex2(a1.y); ps += (p0[r] + p1[r]) + (p0[r + 1] + p1[r + 1]); } \
                    l_reg += ps; \
                } else { \
                    f32x16 e0, e1;     \
                    _Pragma("unroll") for (int r = 0; r < 16; r += 2) { const f32x2 t0 = {p0[r], p0[r + 1]}, t1 = {p1[r], p1[r + 1]}; \
                        const f32x2 x0 = (f32x2){ex2(-fabsf(t0.x)), ex2(-fabsf(t0.y))} + (f32x2){1.f, 1.f}, x1 = (f32x2){ex2(-fabsf(t1.x)), ex2(-fabsf(t1.y))} + (f32x2){1.f, 1.f}; \
                        const f32x2 b0 = (f32x2){fminf(t0.x, 0.f), fminf(t0.y, 0.f)} - (f32x2){lg2(x0.x), lg2(x0.y)}, b1 = (f32x2){fminf(t1.x, 0.f), fminf(t1.y, 0.f)} - (f32x2){lg2(x1.x), lg2(x1.y)}; \
                        const f32x2 d0 = b0 - t0, d1 = b1 - t1; \
                        p0[r] = b0.x; p0[r + 1] = b0.y; e0[r] = d0.x; e0[r + 1] = d0.y; p1[r] = b1.x; p1[r + 1] = b1.y; e1[r] = d1.x; e1[r + 1] = d1.y; } \
                    if (kb + 63 >= qlo) { _Pragma("unroll") for (int r = 0; r < 16; ++r) { if (r >= dq) { p0[r] = NEG_INF; e0[r] = 0.f; } if (r + 32 >= dq) { p1[r] = NEG_INF; e1[r] = 0.f; } } } \
                    float s0 = 0.f, s1 = 0.f; \
                    _Pragma("unroll") for (int r = 15; r >= 0; --r) { const float x0 = e0[r], x1 = e1[r]; e0[r] = s0; e1[r] = s1; s0 += x0; s1 += x1; } \
                    const auto r1 = __builtin_amdgcn_permlane32_swap(__float_as_uint(s0), __float_as_uint(s1), false, false); \
                    const auto r2 = __builtin_amdgcn_permlane32_swap(__float_as_uint(s1), __float_as_uint(s0), false, false); \
                    const float ps0 = __uint_as_float(hi ? r2[0] : r1[1]), ps1 = __uint_as_float(hi ? r1[0] : r2[1]); \
                    const float off1 = carry + (hi ? 0.f : ps1), off0 = carry + s1 + ps1 + (hi ? 0.f : ps0); \
                    carry += (s0 + s1) + (ps0 + ps1); \
                    _Pragma("unroll") for (int r = 0; r < 16; r += 2) { const f32x2 a0 = (f32x2){p0[r], p0[r + 1]} + ((f32x2){e0[r], e0[r + 1]} + (f32x2){off0, off0}), a1 = (f32x2){p1[r], p1[r + 1]} + ((f32x2){e1[r], e1[r + 1]} + (f32x2){off1, off1}); \
                        p0[r] = ex2(a0.x); p0[r + 1] = ex2(a0.y); p1[r] = ex2(a1.x); p1[r + 1] = ex2(a1.y); } \
                } \
                const bf16x8 pa0 = pack8p(p0, 0), pa1 = pack8p(p0, 8), pa2 = pack8p(p1, 0), pa3 = pack8p(p1, 8); \
                FA_STAMP(2); \
                FA_PV_D0(0, KB); FA_PV_D0(1, KB); FA_PV_D0(2, KB); FA_PV_D0(3, KB); \
                FA_STAMP(3); \
                if (MODE == 1) { if (__all(carry < SB_CUT)) wdone = true; } \
            } \
            if (MODE == 1 && wdone && lane == 0) __hip_atomic_fetch_add(ebank + (t), 1u, __ATOMIC_RELAXED, __HIP_MEMORY_SCOPE_WORKGROUP); \
            FA_WAITBAR(); FA_STAMP(4); \
            if (MODE == 1) stop = *(volatile LAS unsigned*)(ebank + (t)) == 8u; } while (0)


#define FA_DMA_K(koff, krope, Kh_, KRh_, j, KB) do { const bf16* kb_ = (Kh_) + (size_t)(j) * 64 * kpitch; const bf16* kr_ = MODE == 0 ? (KRh_) + (size_t)(j) * 64 * 64 : nullptr; \
            _Pragma("unroll") for (int i_ = 0; i_ < KP; ++i_) __builtin_amdgcn_global_load_lds((const unsigned*)(((MODE == 0 && krope[i_]) ? kr_ : kb_) + koff[i_]), (LAS unsigned*)(lds + (KB) * SHM_K + (wid * KP + i_) * 1024), 16, 0, 0); } while (0)
#define FA_DMA_V(voff, Vh_, j, KB) do { const bf16* vb_ = (Vh_) + (size_t)(j) * 64 * vpitch; \
            _Pragma("unroll") for (int i_ = 0; i_ < 2; ++i_) __builtin_amdgcn_global_load_lds((const unsigned*)(vb_ + voff[i_]), (LAS unsigned*)(lds + VOFF + (KB) * SHM_V + (wid * 2 + i_) * 1024), 16, 0, 0); } while (0)
#define FA_SLOT_END(more_, na, nb) do { FA_SBAR(); if (more_) { if (!grpB) asm volatile("s_waitcnt vmcnt(" #na ") lgkmcnt(0)\n\ts_barrier" ::: "memory"); else asm volatile("s_waitcnt vmcnt(" #nb ") lgkmcnt(0)\n\ts_barrier" ::: "memory"); } \
            else asm volatile("s_waitcnt vmcnt(0) lgkmcnt(0)\n\ts_barrier" ::: "memory"); FA_SBAR(); } while (0)
#define FA_S1(t, KB) do { const int j = (t); int ln_s = lane; asm volatile("" : "+v"(ln_s)); FA_LANE_ADDRS(ln_s) \
            const bool more_ = (t) + 1 < NT; \
            if (more_) { if (!grpB) FA_DMA_K(sko, skr, Kh, KRh, (t) + 1, (KB) ^ 1); else FA_DMA_V(svo, Vh, (t) + 1, (KB) ^ 1); } \
            if (j <= jmax) { \
                p0 = f32x16{}; p1 = f32x16{}; \
                _Pragma("unroll") for (int d0 = 0; d0 < ND; ++d0) { const int cb = d0 * 32 + hi * 16; const LAS unsigned char* a = lds + (KB) * SHM_K + krow + (cb ^ kswz); \
                    const bf16x8 k0 = *(const LAS bf16x8*)a, k1 = *(const LAS bf16x8*)(a + 32 * KPITCH); \
                    const bf16x8 qf = d0 < NDR ? qr[d0 < NDR ? d0 : 0] : *(const LAS bf16x8*)(qrl + (d0 == 7 ? 4 : d0 - 8) * 1024); \
                    p0 = __builtin_amdgcn_mfma_f32_32x32x16_bf16(k0, qf, p0, 0, 0, 0); p1 = __builtin_amdgcn_mfma_f32_32x32x16_bf16(k1, qf, p1, 0, 0, 0); } \
                const int kb = j * 64, dq = qlo + r32 - kb - 16 * hi; \
                { const LAS float* rkw = (const LAS float*)(lds + RKOFF) + kb; \
                  _Pragma("unroll") for (int g_ = 0; g_ < 4; ++g_) { const f32x4 ra = *(const LAS f32x4*)(rkw + 16 * hi + 4 * g_), rb = *(const LAS f32x4*)(rkw + 32 + 16 * hi + 4 * g_); \
                      p0[4 * g_] *= ra.x; p0[4 * g_ + 1] *= ra.y; p0[4 * g_ + 2] *= ra.z; p0[4 * g_ + 3] *= ra.w; p1[4 * g_] *= rb.x; p1[4 * g_ + 1] *= rb.y; p1[4 * g_ + 2] *= rb.z; p1[4 * g_ + 3] *= rb.w; } } \
                if (kb + 63 > qlo) { _Pragma("unroll") for (int r = 0; r < 16; ++r) { if (r > dq) p0[r] = NEG_INF; if (r + 32 > dq) p1[r] = NEG_INF; } } \
                float pmax = p0[0]; _Pragma("unroll") for (int r = 1; r < 16; ++r) pmax = fmaxf(pmax, p0[r]); _Pragma("unroll") for (int r = 0; r < 16; ++r) pmax = fmaxf(pmax, p1[r]); \
                { auto rr = __builtin_amdgcn_permlane32_swap(__float_as_uint(pmax), __float_as_uint(pmax), false, false); pmax = fmaxf(__uint_as_float(rr[0]), __uint_as_float(rr[1])); } \
                if (!__all(pmax - m_reg <= 11.5f)) { const float mn = fmaxf(m_reg, pmax), alpha = ex2(m_reg - mn); m_reg = mn; l_reg *= alpha; \
                    _Pragma("unroll") for (int d0 = 0; d0 < 4; ++d0) _Pragma("unroll") for (int r = 0; r < 16; ++r) o[d0][r] *= alpha; } \
                (void)vb0; \
            } \
            FA_SLOT_END(more_, 3, 2); } while (0)
#define FA_S2(t, KB) do { const int j = (t); int ln_s = lane; asm volatile("" : "+v"(ln_s)); FA_LANE_ADDRS(ln_s) \
            const bool more_ = grpB ? (t) + 2 < NT : (t) + 1 < NT; \
            if (more_) { if (!grpB) FA_DMA_V(svo, Vh, (t) + 1, (KB) ^ 1); else FA_DMA_K(sko, skr, Kh, KRh, (t) + 2, (KB)); } \
            if (j <= jmax) { \
                float ps = 0.f; \
                _Pragma("unroll") for (int r = 0; r < 16; ++r) { p0[r] = ex2(p0[r] - m_reg); p1[r] = ex2(p1[r] - m_reg); ps += p0[r] + p1[r]; } \
                l_reg += ps; \
                const bf16x8 pa0 = pack8p(p0, 0), pa1 = pack8p(p0, 8), pa2 = pack8p(p1, 0), pa3 = pack8p(p1, 8); \
                FA_PV_D0(0, KB); FA_PV_D0(1, KB); FA_PV_D0(2, KB); FA_PV_D0(3, KB); \
                (void)krow; (void)kswz; (void)qrl; \
            } \
            FA_SLOT_END(more_, 2, 3); } while (0)

#define FA_QK2(t) do { const int j = (t); int ln_s = lane; asm volatile("" : "+v"(ln_s)); FA_LANE_ADDRS(ln_s) (void)vb0; \
            if (j <= jmax) { const LAS unsigned char* kt_ = lds + ((t) & 1) * SHM_K + krow; p0 = f32x16{}; p1 = f32x16{}; \
                _Pragma("unroll") for (int d0 = 0; d0 < ND; ++d0) { const int cb = d0 * 32 + hi * 16; const LAS unsigned char* a = kt_ + (cb ^ kswz); \
                    const bf16x8 k0 = *(const LAS bf16x8*)a, k1 = *(const LAS bf16x8*)(a + 32 * KPITCH); \
                    const bf16x8 qf = d0 < NDR ? qr[d0 < NDR ? d0 : 0] : *(const LAS bf16x8*)(qrl + (d0 == 7 ? 4 : d0 - 8) * 1024); \
                    p0 = __builtin_amdgcn_mfma_f32_32x32x16_bf16(k0, qf, p0, 0, 0, 0); p1 = __builtin_amdgcn_mfma_f32_32x32x16_bf16(k1, qf, p1, 0, 0, 0); } } } while (0)
#define FA_SMPV2(t, vs_) do { const int j = (t); int ln_s = lane; asm volatile("" : "+v"(ln_s)); \
            if (j <= jmax) { const int r32 = ln_s & 31, hi = ln_s >> 5; const int vb0 = (int)(uintptr_t)lds + VOFF + (vs_) * SHM_V + v_rd_base(ln_s); \
                const int kb = j * 64, dq = qlo + r32 - kb - 16 * hi; \
                { const LAS float* rkw = (const LAS float*)(lds + RKOFF) + kb; \
                  _Pragma("unroll") for (int g_ = 0; g_ < 4; ++g_) { const f32x4 ra = *(const LAS f32x4*)(rkw + 16 * hi + 4 * g_), rb = *(const LAS f32x4*)(rkw + 32 + 16 * hi + 4 * g_); \
                      p0[4 * g_] *= ra.x; p0[4 * g_ + 1] *= ra.y; p0[4 * g_ + 2] *= ra.z; p0[4 * g_ + 3] *= ra.w; p1[4 * g_] *= rb.x; p1[4 * g_ + 1] *= rb.y; p1[4 * g_ + 2] *= rb.z; p1[4 * g_ + 3] *= rb.w; } } \
                if (kb + 63 > qlo) { _Pragma("unroll") for (int r = 0; r < 16; ++r) { if (r > dq) p0[r] = NEG_INF; if (r + 32 > dq) p1[r] = NEG_INF; } } \
                float pmax = p0[0]; _Pragma("unroll") for (int r = 1; r < 16; ++r) pmax = fmaxf(pmax, p0[r]); _Pragma("unroll") for (int r = 0; r < 16; ++r) pmax = fmaxf(pmax, p1[r]); \
                { auto rr = __builtin_amdgcn_permlane32_swap(__float_as_uint(pmax), __float_as_uint(pmax), false, false); pmax = fmaxf(__uint_as_float(rr[0]), __uint_as_float(rr[1])); } \
                if (!__all(pmax - m_reg <= 11.5f)) { const float mn = fmaxf(m_reg, pmax), alpha = ex2(m_reg - mn); m_reg = mn; l_reg *= alpha; \
                    _Pragma("unroll") for (int d0 = 0; d0 < 4; ++d0) _Pragma("unroll") for (int r = 0; r < 16; ++r) o[d0][r] *= alpha; } \
                float ps = 0.f; \
                _Pragma("unroll") for (int r = 0; r < 16; r += 2) { const f32x2 a0 = (f32x2){p0[r], p0[r + 1]} - (f32x2){m_reg, m_reg}, a1 = (f32x2){p1[r], p1[r + 1]} - (f32x2){m_reg, m_reg}; \
                    p0[r] = ex2(a0.x); p0[r + 1] = ex2(a0.y); p1[r] = ex2(a1.x); p1[r + 1] = ex2(a1.y); ps += (p0[r] + p1[r]) + (p0[r + 1] + p1[r + 1]); } \
                l_reg += ps; \
                const bf16x8 pa0 = pack8p(p0, 0), pa1 = pack8p(p0, 8), pa2 = pack8p(p1, 0), pa3 = pack8p(p1, 8); \
                FA_PV_D0(0, 0); FA_PV_D0(1, 0); FA_PV_D0(2, 0); FA_PV_D0(3, 0); } } while (0)
#define FA_STEP2(t) do { \
            if ((t) + 1 < NT) { FA_DMA_K(sko, skr, Kh, KRh, (t) + 1, ((t) + 1) & 1); FA_DMA_V(svo, Vh, (t) + 1, vs1); } \
            if (grpB && (t) > 0) FA_SMPV2((t) - 1, vsp); \
            FA_QK2(t); \
            if (!grpB || (t) + 1 == NT) FA_SMPV2(t, vs0); \
            FA_WAITBAR(); vsp = vs0; vs0 = vs1; vs1 = vs1 == 2 ? 0 : vs1 + 1; } while (0)

#define FA_SM3(t) do { const int j = (t); int ln_s = lane; asm volatile("" : "+v"(ln_s)); \
            if (j <= jmax) { const int r32 = ln_s & 31, hi = ln_s >> 5; \
                const int kb = j * 64, dq = qlo + r32 - kb - 16 * hi; \
                { const LAS float* rkw = (const LAS float*)(lds + RKOFF) + kb; \
                  _Pragma("unroll") for (int g_ = 0; g_ < 4; ++g_) { const f32x4 ra = *(const LAS f32x4*)(rkw + 16 * hi + 4 * g_), rb = *(const LAS f32x4*)(rkw + 32 + 16 * hi + 4 * g_); \
                      p0[4 * g_] *= ra.x; p0[4 * g_ + 1] *= ra.y; p0[4 * g_ + 2] *= ra.z; p0[4 * g_ + 3] *= ra.w; p1[4 * g_] *= rb.x; p1[4 * g_ + 1] *= rb.y; p1[4 * g_ + 2] *= rb.z; p1[4 * g_ + 3] *= rb.w; } } \
                if (kb + 63 > qlo) { _Pragma("unroll") for (int r = 0; r < 16; ++r) { if (r > dq) p0[r] = NEG_INF; if (r + 32 > dq) p1[r] = NEG_INF; } } \
                float pmax = p0[0]; _Pragma("unroll") for (int r = 1; r < 16; ++r) pmax = fmaxf(pmax, p0[r]); _Pragma("unroll") for (int r = 0; r < 16; ++r) pmax = fmaxf(pmax, p1[r]); \
                { auto rr = __builtin_amdgcn_permlane32_swap(__float_as_uint(pmax), __float_as_uint(pmax), false, false); pmax = fmaxf(__uint_as_float(rr[0]), __uint_as_float(rr[1])); } \
                if (!__all(pmax - m_reg <= 11.5f)) { const float mn = fmaxf(m_reg, pmax), alpha = ex2(m_reg - mn); m_reg = mn; l_reg *= alpha; \
                    _Pragma("unroll") for (int d0 = 0; d0 < 4; ++d0) _Pragma("unroll") for (int r = 0; r < 16; ++r) o[d0][r] *= alpha; } \
                float ps = 0.f; \
                _Pragma("unroll") for (int r = 0; r < 16; r += 2) { const f32x2 a0 = (f32x2){p0[r], p0[r + 1]} - (f32x2){m_reg, m_reg}, a1 = (f32x2){p1[r], p1[r + 1]} - (f32x2){m_reg, m_reg}; \
                    p0[r] = ex2(a0.x); p0[r + 1] = ex2(a0.y); p1[r] = ex2(a1.x); p1[r + 1] = ex2(a1.y); ps += (p0[r] + p1[r]) + (p0[r + 1] + p1[r + 1]); } \
                l_reg += ps; \
                pa0 = pack8p(p0, 0); pa1 = pack8p(p0, 8); pa2 = pack8p(p1, 0); pa3 = pack8p(p1, 8); } } while (0)
#define FA_PV3(t, vs_) do { int ln_s = lane; asm volatile("" : "+v"(ln_s)); \
            if ((t) <= jmax) { const int vb0 = (int)(uintptr_t)lds + VOFF + (vs_) * SHM_V + v_rd_base(ln_s); FA_PV_D0(0, 0); FA_PV_D0(1, 0); FA_PV_D0(2, 0); FA_PV_D0(3, 0); } } while (0)
#define FA_STEP3(t) do { \
            if ((t) + 1 < NT) { FA_DMA_K(sko, skr, Kh, KRh, (t) + 1, ((t) + 1) & 1); FA_DMA_V(svo, Vh, (t) + 1, vs1); } \
            FA_QK2(t); \
            if ((t) > 0) FA_PV3((t) - 1, vsp); \
            FA_SM3(t); \
            if ((t) + 1 == NT) FA_PV3(t, vs0); \
            FA_WAITBAR(); vsp = vs0; vs0 = vs1; vs1 = vs1 == 2 ? 0 : vs1 + 1; } while (0)

    const int nunits = vcu < 512 ? 2 * ((512 - vcu + G - 1) / G) : 0;
#define FA_UNIT(u_, b_, h_, qb_) do { const int it_ = vcu + G * ((u_) >> 1), bh_ = it_ >> 2, pp_ = it_ & 3; b_ = bh_ >> 5; h_ = bh_ & 31; qb_ = ((u_) & 1) ? pp_ : 7 - pp_; } while (0)
    LAS float* gtl = (LAS float*)(lds + GTOFF);
    if (MODE == 0) { if (tid < QKD) gtl[tid] = tid < 128 ? P.gq[tid] * P.gk[tid] : P.gq[tid]; }
    bf16x8 qr[ND]; f32x16 o[4];
    float m_reg = -1e30f, l_reg = 0.f, carry = 0.f; bool wdone = false; LAS unsigned* ebank = ecnt;
    int b = 0, h = 0, qlo = 0, NT = 0, jmax = 0; const bf16* Kh = nullptr; const bf16* Vh = nullptr; const bf16* KRh = nullptr;
    for (int u = -1; u < nunits; ++u) {
        if (u >= 0) {
            bool stop = false;
            FA_DMA_OFFS(sko, skr, svo)
            if (MODE == 0 && FA_PV_DEFER) {
                f32x16 p0 = f32x16{}, p1 = f32x16{}; bf16x8 pa0 = bf16x8{}, pa1 = bf16x8{}, pa2 = bf16x8{}, pa3 = bf16x8{}; int vsp = 0, vs0 = 0, vs1 = 1;
                for (int t = 0; t < NT; ++t) FA_STEP3(t);
            } else if (MODE == 0 && FA_PP2) {
                const bool grpB = FA_PP2_LAG && wid >= 4; f32x16 p0 = f32x16{}, p1 = f32x16{}; int vsp = 0, vs0 = 0, vs1 = 1;
                for (int t = 0; t < NT; ++t) FA_STEP2(t);
            } else if (MODE == 0 && FA_PP) {
                const bool grpB = wid >= 4; f32x16 p0 = f32x16{}, p1 = f32x16{};
                if (grpB) { FA_DMA_K(sko, skr, Kh, KRh, 1, 1); asm volatile("s_barrier" ::: "memory"); }
                for (int t = 0; t < NT; t += 2) { FA_S1(t, 0); FA_S2(t, 0); FA_S1(t + 1, 1); FA_S2(t + 1, 1); }
                if (!grpB) asm volatile("s_barrier" ::: "memory");
            } else
            for (int t = 0; t < NT; t += 2) { FA_STEP(t, 0); if (MODE == 1 && stop) break; FA_STEP(t + 1, 1); if (MODE == 1 && stop) break; }
        }
        FA_STAMP(0);
        const bool has_next = u + 1 < nunits;
        int b2 = 0, h2 = 0, q2 = 0; if (has_next) FA_UNIT(u + 1, b2, h2, q2);
        const int qlo2 = q2 * 256 + wid * 32, NT2 = 4 * (q2 + 1);
        const bf16* Kh2 = Kp + (size_t)b2 * SEQ * kpitch + h2 * khs; const bf16* Vh2 = Vp + (size_t)b2 * SEQ * vpitch + h2 * vhs; const bf16* KRh2 = MODE == 0 ? P.KR + (size_t)b2 * SEQ * 64 : nullptr;
        int lane_e = lane; asm volatile("" : "+v"(lane_e));
        const int er = lane_e >> 3, ec = lane_e & 7;
        v2u gv[16];
        const bf16* grow = Gp + ((size_t)b * SEQ + qlo + er) * gpitch + h * 128 + 4 * ec;
#define FA_LOAD_G(half) do { if (MODE == 0 || (half) == 0) { _Pragma("unroll") for (int ps = 0; ps < (MODE == 1 ? 4 : 2); ++ps) _Pragma("unroll") for (int i = 0; i < 4; ++i) gv[(2 * (half) + ps) * 4 + i] = *(const GAS v2u*)(grow + (size_t)(8 * i) * gpitch + 32 * (2 * (half) + ps)); } asm volatile("" ::: "memory"); } while (0)
        FA_LOAD_G(0); FA_LOAD_G(1);
        f32x4 csv[8]; f32x4 skv[4]; float spv[4];
        { const size_t mr_ = (size_t)b2 * SEQ + qlo2 + (lane_e & 31);
#pragma unroll
            for (int d0 = 0; d0 < ND; ++d0) qr[d0] = *(const bf16x8*)(Qp + mr_ * qpitch + h2 * qhs + d0 * 16 + (lane_e >> 5) * 8);
        }
        asm volatile("" ::: "memory");
        if (has_next) { FA_DMA_OFFS(tko, tkr, tvo) FA_DMA_GO(tko, tkr, tvo, Kh2, Vh2, KRh2, MODE == 0 ? 0 : NT2 - 1, 0); }
        asm volatile("" ::: "memory");
#define FA_LOAD_CS() do { if (MODE == 0) { const int pos = qlo2 + (lane_e & 31); \
            _Pragma("unroll") for (int dd = 0; dd < 2; ++dd) { const int ri = dd * 16 + (lane_e >> 5) * 8; \
                csv[dd * 4 + 0] = *(const GAS f32x4*)(P.rc + pos * 32 + ri); csv[dd * 4 + 1] = *(const GAS f32x4*)(P.rc + pos * 32 + ri + 4); \
                csv[dd * 4 + 2] = *(const GAS f32x4*)(P.rs + pos * 32 + ri); csv[dd * 4 + 3] = *(const GAS f32x4*)(P.rs + pos * 32 + ri + 4); } } asm volatile("" ::: "memory"); } while (0)
#define FA_LOAD_SK() do { if (MODE == 0) { \
            _Pragma("unroll") for (int i = 0; i < 4; ++i) { const size_t kt_ = (size_t)b2 * SEQ + tid + 512 * i; skv[i] = *(const GAS f32x4*)(P.sskp + (kt_ * NH + h2) * 4); spv[i] = P.sspe[kt_]; } } asm volatile("" ::: "memory"); } while (0)
        if (u >= 0) {
            float inv = 1.f;
            if (MODE == 0) { auto rr = __builtin_amdgcn_permlane32_swap(__float_as_uint(l_reg), __float_as_uint(l_reg), false, false); inv = 1.f / (__uint_as_float(rr[0]) + __uint_as_float(rr[1])); }
            LAS unsigned char* stg = lds + (MODE == 0 ? (wid < 5 ? SHM_K + wid * 4608 : VOFF + SHM_V + (wid - 5) * 4608) : 65536 + wid * 4608);
            LAS unsigned char* stw = stg + (lane_e & 31) * 144 + (lane_e >> 5) * 16;
            const LAS unsigned char* strd = stg + er * 144 + ec * 16;
            bf16* orow = Op + ((size_t)b * SEQ + qlo + er) * DM + h * 128 + 4 * ec;
#define FA_EPI_PASS(ps) do { \
                _Pragma("unroll") for (int g4 = 0; g4 < 4; ++g4) *(LAS f32x4*)(stw + g4 * 32) = (f32x4){o[ps][g4 * 4 + 0] * inv, o[ps][g4 * 4 + 1] * inv, o[ps][g4 * 4 + 2] * inv, o[ps][g4 * 4 + 3] * inv}; \
                _Pragma("unroll") for (int i = 0; i < 4; ++i) { const f32x4 ov = *(const LAS f32x4*)(strd + (8 * i) * 144); const v2u gq_ = gv[(ps) * 4 + i]; \
                    const float g0 = bf_lo(gq_.x), g1 = bf_hi(gq_.x), g2 = bf_lo(gq_.y), g3 = bf_hi(gq_.y); \
                    const float y0 = ov.x * g0 * __builtin_amdgcn_rcpf(1.f + ex2(-1.4426950408889634f * g0)), y1 = ov.y * g1 * __builtin_amdgcn_rcpf(1.f + ex2(-1.4426950408889634f * g1)); \
                    const float y2 = ov.z * g2 * __builtin_amdgcn_rcpf(1.f + ex2(-1.4426950408889634f * g2)), y3 = ov.w * g3 * __builtin_amdgcn_rcpf(1.f + ex2(-1.4426950408889634f * g3)); \
                    v2u w; w.x = cvtpk(y0, y1); w.y = cvtpk(y2, y3); *(GAS v2u*)(orow + (size_t)(8 * i) * DM + 32 * (ps)) = w; } \
                asm volatile("" ::: "memory"); } while (0)
            FA_EPI_PASS(0); FA_LOAD_SK(); FA_LOAD_CS(); FA_EPI_PASS(1); FA_EPI_PASS(2); FA_EPI_PASS(3);
        } else { FA_LOAD_SK(); FA_LOAD_CS(); }
        asm volatile("" ::: "memory");
        if (has_next) {
            if (MODE == 0 && ((u + 1) & 1) == 0) {
                LAS float* rkl = (LAS float*)(lds + RKOFF);
#pragma unroll
                for (int i = 0; i < 4; ++i) rkl[tid + 512 * i] = 1.f / sqrtf((((skv[i].x + skv[i].y) + (skv[i].z + skv[i].w)) + spv[i]) * (1.f / QKD) + EPS); }
            asm volatile("" ::: "memory");
            if (MODE == 0) {
                if (u < 0) asm volatile("s_waitcnt lgkmcnt(0)\n\ts_barrier" ::: "memory");
                float ss = 0.f;
#pragma unroll
                for (int d0 = 0; d0 < ND; ++d0) { float f[8]; unpack8(__builtin_bit_cast(v4u, qr[d0]), f);
#pragma unroll
                    for (int e = 0; e < 8; ++e) ss += f[e] * f[e]; }
                { auto rr = __builtin_amdgcn_permlane32_swap(__float_as_uint(ss), __float_as_uint(ss), false, false); ss = __uint_as_float(rr[0]) + __uint_as_float(rr[1]); }
                const float rq = Q_SCALE_MLA / sqrtf(ss * (1.f / QKD) + EPS);
                const int hi_e = lane_e >> 5; LAS unsigned char* qrl = lds + FA_QRBASE + lane_e * 16;
#pragma unroll
                for (int d0 = 0; d0 < 8; ++d0) { float f[8]; unpack8(__builtin_bit_cast(v4u, qr[d0]), f); const int dd = d0 * 16 + hi_e * 8;
                    const f32x4 a0 = *(const LAS f32x4*)(gtl + dd), a1 = *(const LAS f32x4*)(gtl + dd + 4);
                    f[0] *= rq * a0.x; f[1] *= rq * a0.y; f[2] *= rq * a0.z; f[3] *= rq * a0.w; f[4] *= rq * a1.x; f[5] *= rq * a1.y; f[6] *= rq * a1.z; f[7] *= rq * a1.w;
                    qr[d0] = __builtin_bit_cast(bf16x8, pack8(f)); }
                if (NDR < 8) *(LAS bf16x8*)(qrl + 4 * 1024) = qr[7];
#pragma unroll
                for (int dd = 0; dd < 2; ++dd) { float x1[8], x2[8], o1[8], o2[8]; unpack8(__builtin_bit_cast(v4u, qr[8 + dd]), x1); unpack8(__builtin_bit_cast(v4u, qr[10 + dd]), x2);
                    const int ri = dd * 16 + hi_e * 8;
                    const f32x4 ga0 = *(const LAS f32x4*)(gtl + 128 + ri), ga1 = *(const LAS f32x4*)(gtl + 128 + ri + 4), gb0 = *(const LAS f32x4*)(gtl + 160 + ri), gb1 = *(const LAS f32x4*)(gtl + 160 + ri + 4);
                    const f32x4 c0 = csv[dd * 4 + 0], c1 = csv[dd * 4 + 1], s0 = csv[dd * 4 + 2], s1 = csv[dd * 4 + 3];
                    const float gA[8] = {ga0.x, ga0.y, ga0.z, ga0.w, ga1.x, ga1.y, ga1.z, ga1.w}, gB[8] = {gb0.x, gb0.y, gb0.z, gb0.w, gb1.x, gb1.y, gb1.z, gb1.w};
                    const float cs[8] = {c0.x, c0.y, c0.z, c0.w, c1.x, c1.y, c1.z, c1.w}, sn[8] = {s0.x, s0.y, s0.z, s0.w, s1.x, s1.y, s1.z, s1.w};
#pragma unroll
                    for (int e = 0; e < 8; ++e) { const float a = x1[e] * gA[e], bq = x2[e] * gB[e]; o1[e] = (a * cs[e] - bq * sn[e]) * rq; o2[e] = (a * sn[e] + bq * cs[e]) * rq; }
                    *(LAS bf16x8*)(qrl + dd * 1024) = __builtin_bit_cast(bf16x8, pack8(o1)); *(LAS bf16x8*)(qrl + (2 + dd) * 1024) = __builtin_bit_cast(bf16x8, pack8(o2)); }
            }
            b = b2; h = h2; qlo = qlo2; NT = NT2; jmax = (qlo2 + 31) >> 6; Kh = Kh2; Vh = Vh2; KRh = KRh2;
#pragma unroll
            for (int d0 = 0; d0 < 4; ++d0) o[d0] = f32x16{};
            m_reg = -1e30f; l_reg = 0.f; carry = 0.f; wdone = false; ebank = ecnt + (un & 1) * 32;
            FA_STAMP(6);
            if (u >= 0) asm volatile("s_waitcnt vmcnt(12) lgkmcnt(0)\n\ts_barrier" ::: "memory");
            else FA_WAITBAR();
            FA_STAMP(5);
            if (MODE == 1) { if (tid < 32) ecnt[((un + 1) & 1) * 32 + tid] = 0u; ++un; }
        }
    }
#undef FA_UNIT
#undef FA_LOAD_CS
#undef FA_LOAD_G
#undef FA_LOAD_SK
#undef FA_EPI_PASS
#undef FA_DMA_OFFS
#undef FA_DMA_GO
#undef FA_WAITBAR
#undef FA_TRRD
#undef FA_PV_D0
#undef FA_STEP
#undef FA_STEP2
#undef FA_STEP3
#undef FA_SM3
#undef FA_PV3
#undef FA_QK2
#undef FA_SMPV2
#undef FA_QRBASE
#undef FA_S1
#undef FA_S2
#undef FA_SLOT_END
#undef FA_DMA_K
#undef FA_DMA_V
#undef FA_STAMP
}
}
struct Args { const float* in[13]; float* out; unsigned char* ws; int ph_lo, ph_hi; };
__global__ void __launch_bounds__(NWAVES * 64, 2) hybrid_fwd(Args args) {
    extern __shared__ __attribute__((aligned(16))) unsigned char lds_raw[];
    LAS unsigned char* lds = (LAS unsigned char*)lds_raw;
    volatile LAS unsigned* MISC = (volatile LAS unsigned*)(lds + MISC_OFF);
    const int tid = threadIdx.x, lane = tid & 63, wave = __builtin_amdgcn_readfirstlane(tid >> 6);
    const int G = gridDim.x, bx = blockIdx.x;
    const int vcu = (G % 8 == 0) ? (bx % 8) * (G / 8) + bx / 8 : bx;
    const int gw = vcu * NWAVES + wave, NGW = G * NWAVES;
    unsigned char* ws = args.ws;
    gu32* ctl = (gu32*)(ws + WS_CTL);
    for (int u = tid; u < (LDS_BYTES - LDSCTL_OFF) / 4; u += NWAVES * 64) ((LAS unsigned*)(lds + LDSCTL_OFF))[u] = 0u;
    __syncthreads();
#if MK_ONE_LAUNCH
    XcdBarrier bar = xcd_barrier_post((unsigned*)(ctl + CW_BAR), MISC + 8);
#if PROBE_BAR
#define GRID_BAR(kk) do { const unsigned tb0_ = (unsigned)__builtin_amdgcn_s_memtime(); xcd_barrier(bar); if ((PROBE_BARMASK >> (kk)) & 1u) tacc += (unsigned)__builtin_amdgcn_s_memtime() - tb0_; } while (0)
#else
#define GRID_BAR(kk) xcd_barrier(bar)
#endif
#else
    (void)MISC; (void)ctl;
#define GRID_BAR(kk) do { } while (0)
#endif
    const int lo = args.ph_lo, hi = args.ph_hi;
    P1Fill fill{args.in, ws, ctl + CW_P0Q, (LAS float*)(lds + RING_OFF + wave * 16384), 0, P1_CHUNK};
    unsigned tacc = 0;
#define IN(k) (lo <= (k) && (k) < hi)
#define SEAM(k) do { if (IN(k) && IN((k) + 1)) GRID_BAR(k); } while (0)
#if MK_ONE_LAUNCH
#if PROBE_BAR
#define SEAM_FILL(k) do { if (IN(k) && IN((k) + 1)) { const unsigned tb0_ = (unsigned)__builtin_amdgcn_s_memtime(); xcd_barrier_fill(bar, fill, wave, lane); if (PROBE_BAR == 1 && ((PROBE_BARMASK >> (k)) & 1u)) tacc += (unsigned)__builtin_amdgcn_s_memtime() - tb0_; } } while (0)
#else
#define SEAM_FILL(k) do { if (IN(k) && IN((k) + 1)) { xcd_barrier_fill(bar, fill, wave, lane); if (PROBE_BAR2) { xcd_barrier(bar); } } } while (0)
#endif
#else
#define SEAM_FILL(k) SEAM(k)
#endif
#define DRAIN(k, limit) do { if (IN(k)) { const unsigned td0_ = PROBE_BAR == 2 ? (unsigned)__builtin_amdgcn_s_memtime() : 0u; __syncthreads(); while (fill.item(lane, (limit))) { } if (PROBE_BAR == 2 && ((PROBE_BARMASK >> (k)) & 1u)) tacc += (unsigned)__builtin_amdgcn_s_memtime() - td0_; } } while (0)
    const float* x_in = args.in[0]; float* out = args.out;
    float* ropec = (float*)(ws + WS_ROPE); float* ropes = ropec + SEQ * 32;
    bf16* XB = (bf16*)(ws + A_XN); bf16* XLO = (bf16*)(ws + A_XLO); bf16* PROJ = (bf16*)(ws + A_PROJ);
    bf16* QLAT = (bf16*)(ws + A_QN); bf16* KVLAT = (bf16*)(ws + A_KVN); bf16* QRAW = (bf16*)(ws + A_QRAW); bf16* KVRAW = (bf16*)(ws + A_KVRAW); bf16* OG = (bf16*)(ws + A_OG);
    bf16* KPER = (bf16*)(ws + A_KPER); float* SSPE = (float*)(ws + A_SSPE); float* SSKP = (float*)(ws + A_SSKP);
    unsigned long long* SSX = (unsigned long long*)(ws + WS_SS);
    unsigned long long* SSQ = SSX + 4 * M; unsigned long long* SSKV = SSX + 6 * M;

    if (IN(0)) {
        LAS float* scr = (LAS float*)(lds + RING_OFF + wave * 16384);
        x_to_bf16_rows(x_in, XB, XLO, SSX, gw, NGW, lane);
        p0_transpose(args.in[2], DM, MLA_IN, (bf16*)(ws + WS_W + W_IN_MLA), scr, gw, NGW, lane, args.in[1]);
        { GAS v4u* pad = (GAS v4u*)(ws + WS_W + W_IN_MLA + (size_t)MLA_IN * DM * 2);
          for (int i = vcu * 512 + tid; i < (MLA_INP - MLA_IN) * DM * 2 / 16; i += G * 512) pad[i] = (v4u){0u, 0u, 0u, 0u}; }
        { GAS v4u* pad1 = (GAS v4u*)(ws + WS_W + W_LAYER + W_IN_MLA + (size_t)MLA_IN * DM * 2);
          for (int i = vcu * 512 + tid; i < (MLA_INP - MLA_IN) * DM * 2 / 16; i += G * 512) pad1[i] = (v4u){0u, 0u, 0u, 0u}; }
        for (int i = vcu * 512 + tid; i < SEQ * 32; i += G * 512) { const int pos = i >> 5, p = i & 31;
            const float inv = 1.0f / powf(10000.0f, (float)(2 * p) / 64.0f), ang = (float)pos * inv; ropec[i] = cosf(ang); ropes[i] = sinf(ang); }
    }
    SEAM_FILL(0);

    for (int L = 0; L < 2; ++L) {
        const int pb = 1 + 7 * L;
        unsigned char* wl = ws + WS_W + (size_t)L * W_LAYER;
        if (IN(pb + 0)) { pg8::Gemm g{XB, (const bf16*)(wl + W_IN_MLA), M, MLA_INP, DM, DM}; pg8::StaticOrder S; S.init(M, MLA_INP, G, bx);
            PG8_LAS float* rst = (PG8_LAS float*)(lds + LDSCTL_OFF + 2048);
            pg8::rstd_table_fill(rst, SSX + (size_t)(2 * L) * M, 1.f / DM, S, tid); pg8::EpiBf16S<1> E{PROJ, MLA_INP, rst, SSQ + (size_t)L * M, SSKV + (size_t)L * M, QLAT, KVLAT, nullptr, 0.f};
            pg8::gemm_phase<pg8::EpiBf16S<1>, pg8::StaticOrder, PG8_ALIGN, PG8_SP2>(lds + RING_OFF, g, S, E); }
        DRAIN(pb + 0, L == 0 ? FQ_KV0 : FQ_KV1);
        SEAM_FILL(pb + 0);
        if (IN(pb + 1)) {
            kpe_rows(PROJ, args.in[8] + (size_t)L * QKD, ropec, ropes, KPER, SSPE, gw, NGW, lane);
            { pg8::Gemm g{QLAT, (const bf16*)(wl + W_QB), M, NQ, QL, QL}; pg8::StaticOrder S; S.init(M, NQ, G, bx);
              PG8_LAS float* rst = (PG8_LAS float*)(lds + LDSCTL_OFF + 2048);
              pg8::rstd_table_fill(rst, SSQ + (size_t)L * M, 1.f / QL, S, tid); pg8::EpiBf16S<0> E{QRAW, NQ, rst, nullptr, nullptr, nullptr, nullptr, nullptr, 0.f}; pg8::gemm_phase<pg8::EpiBf16S<0>, pg8::StaticOrder, PG8_ALIGN, PG8_SP2>(lds + RING_OFF, g, S, E, PROBE_SITE == 2 ? &tacc : nullptr); }
            { pg8::Gemm g{KVLAT, (const bf16*)(wl + W_KVB), M, NKV, KVL, KVL}; pg8::StaticOrder S; S.init(M, NKV, G, bx);
              PG8_LAS float* rst = (PG8_LAS float*)(lds + LDSCTL_OFF + 2048);
              pg8::rstd_table_fill(rst, SSKV + (size_t)L * M, 1.f / KVL, S, tid); pg8::EpiKV E{KVRAW, NKV, rst, SSKP, nullptr, 0.f}; pg8::gemm_phase<pg8::EpiKV, pg8::StaticOrder, PG8_ALIGN, PG8_SP2>(lds + RING_OFF, g, S, E, PROBE_SITE == 3 ? &tacc : nullptr); }
        }
        SEAM_FILL(pb + 1);
        if (IN(pb + 2)) { const fa::AttnP P{QRAW, NQ, QKD, KVRAW, NKV, 256, KVRAW + 128, NKV, 256, PROJ + C_GATE, MLA_INP, OG, KPER, SSKP, SSPE, args.in[7] + (size_t)L * QKD, args.in[8] + (size_t)L * QKD, ropec, ropes};
            fa::attn_phase<0>(lds, P, G, vcu, (LAS unsigned*)(lds + LDSCTL_OFF), tacc); }
        DRAIN(pb + 2, L == 0 ? FQ_OM0 : FQ_OM1);
        SEAM_FILL(pb + 2);
        if (IN(pb + 3)) { if (OUTPROJ_STAGGER && (bx & 4)) { const unsigned long long t0_ = __builtin_amdgcn_s_memtime(); while (__builtin_amdgcn_s_memtime() - t0_ < (unsigned long long)OUTPROJ_STAGGER) { if (!fill.item(lane)) break; } __syncthreads(); }     pg8::Gemm g{OG, (const bf16*)(wl + W_OUT_MLA), M, DM, DM, DM}; pg8::StaticOrder S; S.init(M, DM, G, bx);
            pg8::EpiResHL E{XB, XLO, DM, nullptr, SSX + (size_t)(2 * L + 1) * M}; pg8::gemm_phase<pg8::EpiResHL, pg8::StaticOrder, PG8_ALIGN, PG8_SP2>(lds + RING_OFF, g, S, E, PROBE_SITE == 4 ? &tacc : nullptr); }
        DRAIN(pb + 3, L == 0 ? FQ_IS0 : FQ_IS1);
        SEAM_FILL(pb + 3);
        if (IN(pb + 4)) { pg8::Gemm g{XB, (const bf16*)(wl + W_IN_SB), M, SB_IN, DM, DM}; pg8::StaticOrder S; S.init(M, SB_IN, G, bx);
            PG8_LAS float* rst = (PG8_LAS float*)(lds + LDSCTL_OFF + 2048);
            pg8::rstd_table_fill(rst, SSX + (size_t)(2 * L + 1) * M, 1.f / DM, S, tid); pg8::EpiBf16S<0> E{PROJ, SB_IN, rst, nullptr, nullptr, nullptr, nullptr, nullptr, 0.f}; pg8::gemm_phase<pg8::EpiBf16S<0>, pg8::StaticOrder, PG8_ALIGN, PG8_SP2>(lds + RING_OFF, g, S, E, PROBE_SITE == 8 ? &tacc : nullptr); }
        SEAM_FILL(pb + 4);
        if (IN(pb + 5)) { const fa::AttnP P{PROJ, SB_IN, 128, PROJ + C_SBK, SB_IN, 128, PROJ + C_SBV, SB_IN, 128, PROJ + C_SBG, SB_IN, OG, nullptr, nullptr, nullptr, nullptr, nullptr, nullptr, nullptr};
            fa::attn_phase<1>(lds, P, G, vcu, (LAS unsigned*)(lds + LDSCTL_OFF), tacc); }
        DRAIN(pb + 5, L == 0 ? FQ_OS0 : FQ_OS1);
        SEAM_FILL(pb + 5);
        if (IN(pb + 6)) { if (OUTPROJ_STAGGER && (bx & 4)) { const unsigned long long t0_ = __builtin_amdgcn_s_memtime(); while (__builtin_amdgcn_s_memtime() - t0_ < (unsigned long long)OUTPROJ_STAGGER) { if (!fill.item(lane)) break; } __syncthreads(); }     pg8::Gemm g{OG, (const bf16*)(wl + W_OUT_SB), M, DM, DM, DM}; pg8::StaticOrder S; S.init(M, DM, G, bx);
            pg8::EpiResHL E{XB, XLO, DM, (L == 0) ? (float*)nullptr : out, SSX + (size_t)2 * M}; pg8::gemm_phase<pg8::EpiResHL, pg8::StaticOrder, PG8_ALIGN, PG8_SP2>(lds + RING_OFF, g, S, E); }
        DRAIN(pb + 6, L == 0 ? FQ_IM1 : FQ_ITEMS);
        SEAM_FILL(pb + 6);
    }
#if PROBE_SEG || PROBE_GEMM || PROBE_BAR
    if (bx == PROBE_BLOCK && wave == 0) { const unsigned long long t0 = __builtin_amdgcn_s_memrealtime(), want = (unsigned long long)(tacc >> PROBE_SHIFT); while (__builtin_amdgcn_s_memrealtime() - t0 < want) __builtin_amdgcn_s_sleep(8); }
#endif
#undef IN
#undef SEAM
}

extern "C" void kernel_launch(void* const* d_in, const int* in_sizes, int n_in, void* d_out, int out_size, void* d_ws, size_t ws_size, hipStream_t stream) {
    static int grid = 0;
    if (grid == 0) {
        if (n_in != 13 || in_sizes[0] != M * DM || out_size != M * DM || ws_size < WS_END) { fprintf(stderr, "kernel_launch: unexpected shapes (n_in %d, in0 %d, out %d, ws %zu; need ws >= %zu); nothing launched\n", n_in, n_in > 0 ? in_sizes[0] : -1, out_size, ws_size, (size_t)WS_END); grid = -1; return; }
        int dev = 0, cus = 0, per_cu = 0;
        if (hipGetDevice(&dev) != hipSuccess || hipDeviceGetAttribute(&cus, hipDeviceAttributeMultiprocessorCount, dev) != hipSuccess) { fprintf(stderr, "kernel_launch: device query failed\n"); grid = -1; return; }
        if (hipFuncSetAttribute((const void*)hybrid_fwd, hipFuncAttributeMaxDynamicSharedMemorySize, LDS_BYTES) != hipSuccess) { fprintf(stderr, "kernel_launch: hipFuncSetAttribute failed\n"); grid = -1; return; }
        if (hipOccupancyMaxActiveBlocksPerMultiprocessor(&per_cu, (const void*)hybrid_fwd, NWAVES * 64, LDS_BYTES) != hipSuccess || per_cu < 1)
            fprintf(stderr, "kernel_launch: note: occupancy query reports %d workgroups per CU\n", per_cu);
        (void)hipGetLastError();
        grid = cus;
    }
    if (grid < 0) return;
    if (hipMemsetAsync((char*)d_ws + WS_CTL, 0, CTL_ZERO_BYTES, stream) != hipSuccess) { fprintf(stderr, "kernel_launch: memset failed\n"); return; }
    Args a{};
    for (int i = 0; i < 13; ++i) a.in[i] = (const float*)d_in[i];
    a.out = (float*)d_out; a.ws = (unsigned char*)d_ws;
#if MK_ONE_LAUNCH
    a.ph_lo = 0; a.ph_hi = N_PHASES;
    hipLaunchKernelGGL(hybrid_fwd, dim3(grid), dim3(NWAVES * 64), LDS_BYTES, stream, a);
#ifdef PROBE_PHASES
    { static const int probe_ph[] = {PROBE_PHASES};
      for (int r = 0; r < PROBE_NREP; ++r) for (int ph : probe_ph) { a.ph_lo = ph; a.ph_hi = ph + 1; hipLaunchKernelGGL(hybrid_fwd, dim3(grid), dim3(NWAVES * 64), LDS_BYTES, stream, a); } }
#endif
#else
    for (int ph = 0; ph < N_PHASES; ++ph) { a.ph_lo = ph; a.ph_hi = ph + 1; hipLaunchKernelGGL(hybrid_fwd, dim3(grid), dim3(NWAVES * 64), LDS_BYTES, stream, a); }
#endif
    const hipError_t le = hipPeekAtLastError();
    if (le != hipSuccess) fprintf(stderr, "kernel_launch: launch failed: %s\n", hipGetErrorName(le));
}
```

```cpp
#include <hip/hip_runtime.h>
#include <cstdio>
#include <cstdint>
#ifndef PROBE_GEMM
#define PROBE_GEMM 0
#endif
#ifndef PG8_POSTEPI
#define PG8_POSTEPI 0
#endif
namespace pg8 {
#define PG8_LAS __attribute__((address_space(3)))
typedef unsigned short bf16_t;
typedef short bf16x8 __attribute__((ext_vector_type(8)));
typedef float f32x4 __attribute__((ext_vector_type(4)));

#ifndef PG8_WT
#define PG8_WT 0
#endif
typedef unsigned u32x4 __attribute__((ext_vector_type(4)));
__device__ __forceinline__ void st16_wt(void* p, u32x4 v) {
#if PG8_WT
    asm volatile("global_store_dwordx4 %0, %1, off sc1\n\ts_nop 1" :: "v"(p), "v"(v));
#else
    *(u32x4*)p = v;
#endif
}
constexpr int BM = 256, BK = 64, HALF = 128, HTB = HALF * BK * 2  , STAGE_BYTES = 8 * HTB, NXCD = 8, WGM = 8;

__host__ __device__ __forceinline__ int lds_byte(int r, int c) { const int st = (r >> 4) * 2 + (c >> 5), rr = r & 15, cc = c & 31, ob = rr * 64 + cc * 2; return st * 1024 + (ob ^ (((ob >> 9) & 1) << 5)); }
__host__ __device__ __forceinline__ void stage_rc(int b, int& R, int& C) { const int st = b / 1024, sb = b % 1024, swz = sb ^ (((sb >> 9) & 1) << 5); R = (st >> 1) * 16 + swz / 64; C = (st & 1) * 32 + (swz % 64) / 2; }
__host__ __device__ __forceinline__ int perm32(int rho) { const int n = rho >> 4, i = rho & 15; return 8 * (i >> 2) + 4 * n + (i & 3); }

struct Unit { int pm, pn; };
struct Gemm { const bf16_t* A; const bf16_t* Bt; int M, N, K, lda; };

struct StaticOrder {
    int nM, nN, nwg, G, c;
    __host__ __device__ void init(int M, int N, int G_, int c_) { nM = M / BM; nN = N / BM; nwg = nM * nN; G = G_; c = c_; }
    __host__ __device__ bool next(int i, Unit& u) const {
        const long L = (long)i * G + c; if (L >= nwg) return false;
        int wgid = (int)L; { const int q = nwg / NXCD, r = nwg % NXCD, xcd = wgid % NXCD, off = wgid / NXCD; wgid = (xcd < r ? xcd * (q + 1) : r * (q + 1) + (xcd - r) * q) + off; }
        const int nig = WGM * nN, gid = wgid / nig, fm = gid * WGM, gsz = (nM - fm) < WGM ? (nM - fm) : WGM;
        u.pm = fm + ((wgid % nig) % gsz); u.pn = (wgid % nig) / gsz; return true;
    }
    __device__ __forceinline__ void a_ready(const Unit&) const {}
    __device__ __forceinline__ void done(const Unit&) const {}
};

__device__ __forceinline__ unsigned cvt_pk_bf16(float lo, float hi) { unsigned r; asm volatile("v_cvt_pk_bf16_f32 %0, %1, %2" : "=v"(r) : "v"(lo), "v"(hi)); return r; }
struct EpiBf16 {
    static constexpr bool PERM = true, AFTER_DRAIN = false; static constexpr bool HAS_TABLE = false; static constexpr int NST = 0;
    bf16_t* O; int ldc;
    __device__ __forceinline__ void operator()(const f32x4 (&acc)[2][2][4][2], const Unit& u, int wr, int wc, int fr, int fq, int ui) const {
        const int row0 = u.pm * BM + wr * 64 + fr; const int col0 = u.pn * BM + wc * 32 + 8 * fq;
#pragma unroll
        for (int ai = 0; ai < 2; ++ai)
#pragma unroll
            for (int m = 0; m < 4; ++m) { bf16_t* rowp = O + (size_t)(row0 + ai * HALF + m * 16) * ldc + col0;
#pragma unroll
                for (int bj = 0; bj < 2; ++bj) { const f32x4 v0 = acc[ai][bj][m][0], v1 = acc[ai][bj][m][1];
                    u32x4 w; w.x = cvt_pk_bf16(v0[0], v0[1]); w.y = cvt_pk_bf16(v0[2], v0[3]); w.z = cvt_pk_bf16(v1[0], v1[1]); w.w = cvt_pk_bf16(v1[2], v1[3]);
                    *(u32x4*)(rowp + bj * HALF) = w; } }
    }
};
struct EpiResF32 {
    static constexpr bool PERM = true, AFTER_DRAIN = false; static constexpr bool HAS_TABLE = false; static constexpr int NST = 0;
    const float* base; float* out; int ldc;
    __device__ __forceinline__ void operator()(const f32x4 (&acc)[2][2][4][2], const Unit& u, int wr, int wc, int fr, int fq, int ui) const {
        const int row0 = u.pm * BM + wr * 64 + fr; const int col0 = u.pn * BM + wc * 32 + 8 * fq;
#pragma unroll
        for (int ai = 0; ai < 2; ++ai)
#pragma unroll
            for (int m = 0; m < 4; ++m) { const size_t off = (size_t)(row0 + ai * HALF + m * 16) * ldc + col0;
#pragma unroll
                for (int bj = 0; bj < 2; ++bj) {
                    const f32x4 b0 = *(const f32x4*)(base + off + bj * HALF), b1 = *(const f32x4*)(base + off + bj * HALF + 4);
                    *(f32x4*)(out + off + bj * HALF) = b0 + acc[ai][bj][m][0]; *(f32x4*)(out + off + bj * HALF + 4) = b1 + acc[ai][bj][m][1]; } }
    }
};

constexpr float SS_FIX = 1048576.f, SS_UNFIX = 1.f / 1048576.f;
__device__ __forceinline__ float rstd_of(const unsigned long long* ss, int row, float inv_n) { return 1.f / sqrtf((float)ss[row] * (SS_UNFIX * inv_n) + 1e-6f); }
__device__ __forceinline__ void ss_add(unsigned long long* ss, int row, float part, int fq) {
    part += __shfl_xor(part, 16); part += __shfl_xor(part, 32);
    if (fq == 0) atomicAdd(ss + row, (unsigned long long)(part * SS_FIX));
}
__device__ __forceinline__ void rstd_table_fill(PG8_LAS float* rst, const unsigned long long* ss, float inv_n, const StaticOrder& S, int tid) {
    int tl = tid; asm volatile("" : "+v"(tl));
    const int half = __builtin_amdgcn_readfirstlane(tl >> 8), r = tl & (BM - 1);
    for (int i0 = 0; ; i0 += 8) {
        Unit u; unsigned long long raw[4]; bool ok[4];
#pragma unroll
        for (int k = 0; k < 4; ++k) { ok[k] = S.next(i0 + 2 * k + half, u); raw[k] = ok[k] ? ss[u.pm * BM + r] : 0ull; }
#pragma unroll
        for (int k = 0; k < 4; ++k) if (ok[k]) rst[(i0 + 2 * k + half) * BM + r] = 1.f / sqrtf((float)raw[k] * (SS_UNFIX * inv_n) + 1e-6f);
        if (!ok[3]) break;
    }
    asm volatile("s_waitcnt vmcnt(0) lgkmcnt(0)\n\ts_barrier" ::: "memory");
}
template <int SSMODE> struct EpiBf16S {
    static constexpr bool PERM = true, AFTER_DRAIN = false; static constexpr bool HAS_TABLE = true; static constexpr int NST = 16;
    bf16_t* O; int ldc; const PG8_LAS float* rst; unsigned long long* ss1; unsigned long long* ss2; bf16_t* O1; bf16_t* O2; const unsigned long long* ssin; float inv_n;
    __device__ __forceinline__ void operator()(const f32x4 (&acc)[2][2][4][2], const Unit& u, int wr, int wc, int fr, int fq, int ui) const {
        const int row0 = u.pm * BM + wr * 64 + fr; int col0 = u.pn * BM + wc * 32 + 8 * fq;
        bf16_t* Ob = O; int ld = ldc;
        if (SSMODE == 1) { if (u.pn < 4) { Ob = O1; ld = 1024; } else if (u.pn < 6) { Ob = O2; ld = 512; col0 -= 1024; } }
#pragma unroll
        for (int ai = 0; ai < 2; ++ai)
#pragma unroll
            for (int m = 0; m < 4; ++m) { const int row = row0 + ai * HALF + m * 16; const float rs = rst[ui * BM + (row - u.pm * BM)]; bf16_t* rowp = Ob + (size_t)row * ld + col0; float part = 0.f;
#pragma unroll
                for (int bj = 0; bj < 2; ++bj) { const f32x4 v0 = acc[ai][bj][m][0] * rs, v1 = acc[ai][bj][m][1] * rs;
                    if (SSMODE == 1) part += (v0[0] * v0[0] + v0[1] * v0[1]) + (v0[2] * v0[2] + v0[3] * v0[3]) + (v1[0] * v1[0] + v1[1] * v1[1]) + (v1[2] * v1[2] + v1[3] * v1[3]);
                    u32x4 w; w.x = cvt_pk_bf16(v0[0], v0[1]); w.y = cvt_pk_bf16(v0[2], v0[3]); w.z = cvt_pk_bf16(v1[0], v1[1]); w.w = cvt_pk_bf16(v1[2], v1[3]);
                    st16_wt(rowp + bj * HALF, w); }
                if (SSMODE == 1) { if (u.pn < 6) ss_add(u.pn < 4 ? ss1 : ss2, row, part, fq); } }
    }
};
struct EpiResHL {
    static constexpr bool PERM = true, AFTER_DRAIN = false; static constexpr bool HAS_TABLE = false; static constexpr int NST = 48;
    bf16_t* hi; bf16_t* lo; int ldc; float* outf; unsigned long long* ss;
    static __device__ __forceinline__ float blo_(unsigned w) { return __uint_as_float(w << 16); }
    static __device__ __forceinline__ float bhi_(unsigned w) { return __uint_as_float(w & 0xffff0000u); }
    __device__ __forceinline__ void operator()(f32x4 (&acc)[2][2][4][2], const Unit& u, int wr, int wc, int fr, int fq, int ui) const {
        const int row0 = u.pm * BM + wr * 64 + fr; const int col0 = u.pn * BM + wc * 32 + 8 * fq;
        u32x4 ph[2][2], pl[2][2];
#define ERX_LOAD(ai, mh) do { _Pragma("unroll") for (int m2 = 0; m2 < 2; ++m2) { const size_t off = (size_t)(row0 + (ai) * HALF + (2 * (mh) + m2) * 16) * ldc + col0; \
            _Pragma("unroll") for (int bj = 0; bj < 2; ++bj) { ph[m2][bj] = *(const u32x4*)(hi + off + bj * HALF); pl[m2][bj] = *(const u32x4*)(lo + off + bj * HALF); } } asm volatile("" ::: "memory"); } while (0)
#define ERX_SUM(ai, mh) do { _Pragma("unroll") for (int m2 = 0; m2 < 2; ++m2) _Pragma("unroll") for (int bj = 0; bj < 2; ++bj) { const u32x4 h_ = ph[m2][bj], l_ = pl[m2][bj]; \
            acc[ai][bj][2 * (mh) + m2][0] += (f32x4){blo_(h_.x) + blo_(l_.x), bhi_(h_.x) + bhi_(l_.x), blo_(h_.y) + blo_(l_.y), bhi_(h_.y) + bhi_(l_.y)}; \
            acc[ai][bj][2 * (mh) + m2][1] += (f32x4){blo_(h_.z) + blo_(l_.z), bhi_(h_.z) + bhi_(l_.z), blo_(h_.w) + blo_(l_.w), bhi_(h_.w) + bhi_(l_.w)}; \
            asm volatile("" : "+v"(acc[ai][bj][2 * (mh) + m2][0]), "+v"(acc[ai][bj][2 * (mh) + m2][1])); } } while (0)
#define ERX_STORE(ai, mh) do { _Pragma("unroll") for (int m2 = 0; m2 < 2; ++m2) { const int m = 2 * (mh) + m2; const int row = row0 + (ai) * HALF + m * 16; const size_t off = (size_t)row * ldc + col0; float part = 0.f; \
            _Pragma("unroll") for (int bj = 0; bj < 2; ++bj) { const f32x4 o0 = acc[ai][bj][m][0], o1 = acc[ai][bj][m][1]; \
                if (outf) { st16_wt(outf + off + bj * HALF, __builtin_bit_cast(u32x4, o0)); st16_wt(outf + off + bj * HALF + 4, __builtin_bit_cast(u32x4, o1)); } \
                else { part += (o0[0] * o0[0] + o0[1] * o0[1]) + (o0[2] * o0[2] + o0[3] * o0[3]) + (o1[0] * o1[0] + o1[1] * o1[1]) + (o1[2] * o1[2] + o1[3] * o1[3]); \
                    u32x4 w; w.x = cvt_pk_bf16(o0[0], o0[1]); w.y = cvt_pk_bf16(o0[2], o0[3]); w.z = cvt_pk_bf16(o1[0], o1[1]); w.w = cvt_pk_bf16(o1[2], o1[3]); \
                    u32x4 r; r.x = cvt_pk_bf16(o0[0] - blo_(w.x), o0[1] - bhi_(w.x)); r.y = cvt_pk_bf16(o0[2] - blo_(w.y), o0[3] - bhi_(w.y)); r.z = cvt_pk_bf16(o1[0] - blo_(w.z), o1[1] - bhi_(w.z)); r.w = cvt_pk_bf16(o1[2] - blo_(w.w), o1[3] - bhi_(w.w)); \
                    st16_wt(hi + off + bj * HALF, w); st16_wt(lo + off + bj * HALF, r); } } \
            if (!outf) ss_add(ss, row, part, fq); } asm volatile("" ::: "memory"); } while (0)
        ERX_LOAD(0, 0); ERX_SUM(0, 0); ERX_LOAD(0, 1); ERX_STORE(0, 0); ERX_SUM(0, 1); ERX_LOAD(1, 0); ERX_STORE(0, 1); ERX_SUM(1, 0); ERX_LOAD(1, 1); ERX_STORE(1, 0); ERX_SUM(1, 1); ERX_STORE(1, 1);
#undef ERX_LOAD
#undef ERX_SUM
#undef ERX_STORE
    }
};
struct EpiKV {
    static constexpr bool PERM = true, AFTER_DRAIN = false; static constexpr bool HAS_TABLE = true; static constexpr int NST = 16;
    bf16_t* O; int ldc; const PG8_LAS float* rst; float* sskp; const unsigned long long* ssin; float inv_n;
    __device__ __forceinline__ void operator()(const f32x4 (&acc)[2][2][4][2], const Unit& u, int wr, int wc, int fr, int fq, int ui) const {
        const int row0 = u.pm * BM + wr * 64 + fr; const int col0 = u.pn * BM + wc * 32 + 8 * fq;
#pragma unroll
        for (int ai = 0; ai < 2; ++ai)
#pragma unroll
            for (int m = 0; m < 4; ++m) { const int row = row0 + ai * HALF + m * 16; const float rs = rst[ui * BM + (row - u.pm * BM)]; bf16_t* rowp = O + (size_t)row * ldc + col0; float part = 0.f;
#pragma unroll
                for (int bj = 0; bj < 2; ++bj) { const f32x4 v0 = acc[ai][bj][m][0] * rs, v1 = acc[ai][bj][m][1] * rs;
                    if (bj == 0) part = (v0[0] * v0[0] + v0[1] * v0[1]) + (v0[2] * v0[2] + v0[3] * v0[3]) + (v1[0] * v1[0] + v1[1] * v1[1]) + (v1[2] * v1[2] + v1[3] * v1[3]);
                    u32x4 w; w.x = cvt_pk_bf16(v0[0], v0[1]); w.y = cvt_pk_bf16(v0[2], v0[3]); w.z = cvt_pk_bf16(v1[0], v1[1]); w.w = cvt_pk_bf16(v1[2], v1[3]);
                    st16_wt(rowp + bj * HALF, w); }
                part += __shfl_xor(part, 16); part += __shfl_xor(part, 32);
                if (fq == 0) sskp[((size_t)row * 32 + u.pn) * 4 + wc] = part; }
    }
};

template <class Epi, class Sched, bool ALIGN_EPI = false, bool SP2 = false>
__device__ __forceinline__ void gemm_phase(PG8_LAS unsigned char* lds, const Gemm g, const Sched& S, const Epi& E, unsigned* tp = nullptr) {
#if PROBE_GEMM
    const unsigned tg0 = (unsigned)__builtin_amdgcn_s_memtime(); unsigned tgk = 0;
#endif
    int tid_l = threadIdx.x; asm volatile("" : "+v"(tid_l));
    const int tid = tid_l, wid = __builtin_amdgcn_readfirstlane(tid >> 6), lane = tid & 63, wr = wid >> 2, wc = wid & 3, fr = lane & 15, fq = lane >> 4;
    const int K = g.K, nt = K / BK;
    unsigned voffA[2], voffB[2];
#pragma unroll
    for (int i = 0; i < 2; ++i) { int R, C; stage_rc(tid * 16 + i * 8192, R, C); const int Rb = Epi::PERM ? ((R & ~31) + perm32(R & 31)) : R;
        voffA[i] = (unsigned)(R * g.lda + C) * 2u; voffB[i] = (unsigned)(Rb * K + C) * 2u; }
    const size_t kstep = (size_t)(BK * 2);
    const size_t hstep = (size_t)HALF * K * 2;
    const size_t tstep = 2 * hstep;
    const size_t hstepA = (size_t)HALF * g.lda * 2, tstepA = 2 * hstepA;
    const unsigned ldsw = (unsigned)wid * 1024u;
    const int aoff = lds_byte(wr * 64 + fr, fq * 8), boff = lds_byte(wc * 32 + fr, fq * 8);
#define PG8_SA(b, h) (((b) * 2 + (h)) * HTB)
#define PG8_SB(b, h) ((4 + (b) * 2 + (h)) * HTB)
#define PG8_STAGE(bufoff, gbase, voff) do { _Pragma("unroll") for (int _i = 0; _i < 2; ++_i) \
        __builtin_amdgcn_global_load_lds((const unsigned*)((const char*)(gbase) + (voff)[_i]), (PG8_LAS unsigned*)(lds + (bufoff) + ldsw + _i * 8192), 16, 0, 0); } while (0)
#define PG8_LDA(dst, b, h) do { _Pragma("unroll") for (int m = 0; m < 4; ++m) _Pragma("unroll") for (int k = 0; k < 2; ++k) dst[m][k] = *(const PG8_LAS bf16x8*)(lds + PG8_SA(b, h) + aoff + m * 2048 + k * 1024); } while (0)
#define PG8_LDB(dst, b, h) do { _Pragma("unroll") for (int n = 0; n < 2; ++n) _Pragma("unroll") for (int k = 0; k < 2; ++k) dst[n][k] = *(const PG8_LAS bf16x8*)(lds + PG8_SB(b, h) + boff + n * 2048 + k * 1024); } while (0)
#define PG8_MMA(ai, bj, At, Bt) do { __builtin_amdgcn_s_setprio(1); _Pragma("unroll") for (int m = 0; m < 4; ++m) _Pragma("unroll") for (int n = 0; n < 2; ++n) _Pragma("unroll") for (int k = 0; k < 2; ++k) \
        acc[ai][bj][m][n] = __builtin_amdgcn_mfma_f32_16x16x32_bf16(Bt[n][k], At[m][k], acc[ai][bj][m][n], 0, 0, 0); __builtin_amdgcn_s_setprio(0); } while (0)
#define PG8_WAIT_V(n) asm volatile("s_waitcnt vmcnt(" #n ")" ::: "memory")
#define PG8_WAIT_L(n) asm volatile("s_waitcnt lgkmcnt(" #n ")" ::: "memory")
#define PG8_WAIT_VP(post_) asm volatile("s_waitcnt vmcnt(%1)\n\ts_cmp_lg_u32 %0, 0\n\ts_cbranch_scc1 .Lpg8post%=\n\ts_waitcnt vmcnt(8)\n.Lpg8post%=:" :: "s"(post_), "n"(8 + Epi::NST) : "memory", "scc")
#define PG8_BAR __builtin_amdgcn_s_barrier()
#define PG8_SCHED __builtin_amdgcn_sched_barrier(0)
    Unit cur, nxt; int ui = 0;
    if (!S.next(0, cur)) return;
    f32x4 acc[2][2][4][2];
#pragma unroll
    for (int a = 0; a < 2; ++a)
#pragma unroll
        for (int b = 0; b < 2; ++b)
#pragma unroll
            for (int m = 0; m < 4; ++m)
#pragma unroll
                for (int n = 0; n < 2; ++n) acc[a][b][m][n] = (f32x4){0.f, 0.f, 0.f, 0.f};
    bf16x8 At[4][2], B0[2][2], B1[2][2];
    const char* cA = (const char*)g.A + (size_t)cur.pm * tstepA; const char* cB = (const char*)g.Bt + (size_t)cur.pn * tstep;
    S.a_ready(cur);
    if constexpr (SP2) {
        PG8_STAGE(PG8_SB(0, 0), cB, voffB); PG8_STAGE(PG8_SB(0, 1), cB + hstep, voffB); PG8_STAGE(PG8_SA(0, 0), cA, voffA); PG8_STAGE(PG8_SA(0, 1), cA + hstepA, voffA);
        if (wr == 1) PG8_BAR;
        PG8_WAIT_V(2); PG8_BAR;
        PG8_STAGE(PG8_SB(1, 0), cB + kstep, voffB); PG8_STAGE(PG8_SA(1, 0), cA + kstep, voffA); PG8_STAGE(PG8_SB(1, 1), cB + hstep + kstep, voffB);
        PG8_WAIT_V(6); PG8_BAR;
        if (PG8_POSTEPI) PG8_STAGE(PG8_SA(1, 1), cA + kstep + hstepA, voffA);
    } else {
        PG8_STAGE(PG8_SB(0, 0), cB, voffB); PG8_STAGE(PG8_SA(0, 0), cA, voffA); PG8_STAGE(PG8_SB(0, 1), cB + hstep, voffB); PG8_STAGE(PG8_SA(0, 1), cA + hstepA, voffA);
        if (wr == 1) PG8_BAR;
        PG8_WAIT_V(4); PG8_BAR;
        PG8_STAGE(PG8_SB(1, 0), cB + kstep, voffB); PG8_STAGE(PG8_SA(1, 0), cA + kstep, voffA); PG8_STAGE(PG8_SB(1, 1), cB + hstep + kstep, voffB);
        PG8_WAIT_V(6); PG8_BAR;
    }
    for (;;) {
        const bool has_next = S.next(ui + 1, nxt);
        const char* nA = has_next ? (const char*)g.A + (size_t)nxt.pm * tstepA : cA; const char* nB = has_next ? (const char*)g.Bt + (size_t)nxt.pn * tstep : cB;
#if PROBE_GEMM
        const unsigned tk0 = (unsigned)__builtin_amdgcn_s_memtime();
#endif
        for (int t = 0; t < nt; t += 2) {
            const bool last = (t == nt - 2);
            const char* a1 = cA + (size_t)(t + 1) * kstep;
            const char* a2 = last ? nA : cA + (size_t)(t + 2) * kstep; const char* b2 = last ? nB : cB + (size_t)(t + 2) * kstep;
            const char* a3 = a2 + kstep; const char* b3 = b2 + kstep;
            if (last && has_next) S.a_ready(nxt);
            if constexpr (SP2) {
            const int post = __builtin_amdgcn_readfirstlane((PG8_POSTEPI && t == 0 && ui > 0) ? 1 : 0);
            PG8_LDB(B0, 0, 0); PG8_LDB(B1, 0, 1); PG8_SCHED; PG8_LDA(At, 0, 0); if (!PG8_POSTEPI) PG8_STAGE(PG8_SA(1, 1), a1 + hstepA, voffA);
            PG8_WAIT_VP(post); PG8_WAIT_L(0); PG8_BAR; PG8_MMA(0, 0, At, B0); PG8_MMA(0, 1, At, B1); PG8_BAR; PG8_SCHED;
            PG8_LDA(At, 0, 1); PG8_STAGE(PG8_SB(0, 0), b2, voffB); PG8_STAGE(PG8_SB(0, 1), b2 + hstep, voffB); PG8_STAGE(PG8_SA(0, 0), a2, voffA);
            PG8_WAIT_VP(post); PG8_WAIT_L(0); PG8_BAR; PG8_MMA(1, 0, At, B0); PG8_MMA(1, 1, At, B1); PG8_BAR; PG8_SCHED;
            PG8_LDB(B0, 1, 0); PG8_LDB(B1, 1, 1); PG8_SCHED; PG8_LDA(At, 1, 0); PG8_STAGE(PG8_SA(0, 1), a2 + hstepA, voffA);
            PG8_WAIT_VP(post); PG8_WAIT_L(0); PG8_BAR; PG8_MMA(0, 0, At, B0); PG8_MMA(0, 1, At, B1); PG8_BAR; PG8_SCHED;
            PG8_LDA(At, 1, 1); PG8_STAGE(PG8_SB(1, 0), b3, voffB); PG8_STAGE(PG8_SB(1, 1), b3 + hstep, voffB); PG8_STAGE(PG8_SA(1, 0), a3, voffA);
            PG8_WAIT_V(8); PG8_WAIT_L(0); PG8_BAR; PG8_MMA(1, 0, At, B0); PG8_MMA(1, 1, At, B1); PG8_BAR; PG8_SCHED;
            if (PG8_POSTEPI) PG8_STAGE(PG8_SA(1, 1), a3 + hstepA, voffA);
            } else {
            PG8_LDB(B0, 0, 0); PG8_SCHED; PG8_LDA(At, 0, 0); PG8_STAGE(PG8_SA(1, 1), a1 + hstepA, voffA);
            PG8_WAIT_L(8); PG8_BAR; PG8_WAIT_L(0); PG8_MMA(0, 0, At, B0); PG8_BAR; PG8_SCHED;
            PG8_LDB(B1, 0, 1); PG8_STAGE(PG8_SB(0, 0), b2, voffB);
            PG8_BAR; PG8_WAIT_L(0); PG8_MMA(0, 1, At, B1); PG8_BAR;
            PG8_LDA(At, 0, 1); PG8_STAGE(PG8_SA(0, 0), a2, voffA);
            PG8_BAR; PG8_WAIT_L(0); PG8_MMA(1, 0, At, B0); PG8_BAR; PG8_SCHED;
            PG8_STAGE(PG8_SB(0, 1), b2 + hstep, voffB);
            PG8_WAIT_V(6); PG8_BAR; PG8_MMA(1, 1, At, B1); PG8_BAR;
            PG8_LDB(B0, 1, 0); PG8_SCHED; PG8_LDA(At, 1, 0); PG8_STAGE(PG8_SA(0, 1), a2 + hstepA, voffA);
            PG8_WAIT_L(8); PG8_BAR; PG8_WAIT_L(0); PG8_MMA(0, 0, At, B0); PG8_BAR; PG8_SCHED;
            PG8_LDB(B1, 1, 1); PG8_STAGE(PG8_SB(1, 0), b3, voffB);
            PG8_BAR; PG8_WAIT_L(0); PG8_MMA(0, 1, At, B1); PG8_BAR;
            PG8_LDA(At, 1, 1); PG8_STAGE(PG8_SA(1, 0), a3, voffA);
            PG8_BAR; PG8_WAIT_L(0); PG8_MMA(1, 0, At, B0); PG8_BAR; PG8_SCHED;
            PG8_STAGE(PG8_SB(1, 1), b3 + hstep, voffB);
            PG8_WAIT_V(6); PG8_BAR; PG8_MMA(1, 1, At, B1); PG8_BAR;
            }
        }
#if PROBE_GEMM
        tgk += (unsigned)__builtin_amdgcn_s_memtime() - tk0;
#endif
        if constexpr (ALIGN_EPI) { if (wr == 0) PG8_BAR; }
        if constexpr (!Epi::AFTER_DRAIN) { E(acc, cur, wr, wc, fr, fq, ui); S.done(cur); }
        if (!has_next) break;
#pragma unroll
        for (int a = 0; a < 2; ++a)
#pragma unroll
            for (int b = 0; b < 2; ++b)
#pragma unroll
                for (int m = 0; m < 4; ++m)
#pragma unroll
                    for (int n = 0; n < 2; ++n) acc[a][b][m][n] = (f32x4){0.f, 0.f, 0.f, 0.f};
        cur = nxt; cA = nA; cB = nB; ++ui;
        if constexpr (ALIGN_EPI) { if (wr == 1) PG8_BAR; }
    }
    PG8_WAIT_V(0);
    if constexpr (!ALIGN_EPI) { if (wr == 0) PG8_BAR; }
    PG8_BAR;
    if constexpr (Epi::AFTER_DRAIN) { E.fused(acc, cur, wr, wc, fr, fq, lds, wid, lane); S.done(cur); }
#if PROBE_GEMM
    if (tp) *tp += (PROBE_GEMM == 1) ? tgk : ((unsigned)__builtin_amdgcn_s_memtime() - tg0);
#endif
#undef PG8_SA
#undef PG8_SB
#undef PG8_STAGE
#undef PG8_LDA
#undef PG8_LDB
#undef PG8_MMA
#undef PG8_WAIT_V
#undef PG8_WAIT_L
#undef PG8_WAIT_VP
#undef PG8_BAR
#undef PG8_SCHED
}
}
#ifndef PG8_SP2
#define PG8_SP2 true
#endif
#ifndef PG8_ALIGN
#define PG8_ALIGN true
#endif

constexpr int NWAVES = 8;
#ifndef MK_ONE_LAUNCH
#define MK_ONE_LAUNCH 1
#endif

#define PROBE_NREP 2
#define PROBE_SEG 0
#define PROBE_BAR 0
#define PROBE_BLOCK 0
#define PROBE_BAR2 0
#define PROBE_BARMASK 0x7fffu
#define PROBE_SITE 8
#define PROBE_MODE 0
#define PROBE_SHIFT 0
constexpr int M = 8192, DM = 4096, SEQ = 2048, NH = 32;
constexpr int MLA_IN = 5696, MLA_INP = 5888, QL = 1024, KVL = 512, QKD = 192, NQ = NH * QKD, NKV = NH * 256;
constexpr int C_KVLAT = 1024, C_KPE = 1536, C_GATE = 1600;
constexpr int SB_IN = 16384, C_SBK = 4096, C_SBV = 8192, C_SBG = 12288;
constexpr float EPS = 1e-6f;
constexpr float Q_SCALE_MLA = 0.07216878364870323f * 1.4426950408889634f;
constexpr float Q_SCALE_SB = 0.08838834764831845f * 1.4426950408889634f;
constexpr int N_PHASES = 15;
#ifndef OUTPROJ_STAGGER
#define OUTPROJ_STAGGER 0
#endif

constexpr size_t MiB = 1u << 20;
constexpr size_t WS_CTL = 0, CTL_ZERO_BYTES = 1 * MiB;
constexpr size_t WS_ROPE = 1 * MiB;
constexpr size_t WS_W = 2 * MiB, W_LAYER = 258 * MiB;
constexpr size_t W_IN_MLA = 0, W_QB = 46 * MiB, W_KVB = 58 * MiB, W_OUT_MLA = 66 * MiB, W_IN_SB = 98 * MiB, W_OUT_SB = 226 * MiB;
constexpr size_t WS_ACT = WS_W + 2 * W_LAYER;
constexpr size_t A_XN = WS_ACT, A_PROJ = WS_ACT + 64 * MiB, A_QN = WS_ACT + 320 * MiB, A_KVN = WS_ACT + 336 * MiB, A_QRAW = WS_ACT + 344 * MiB,
                 A_KVRAW = WS_ACT + 440 * MiB, A_KPER = WS_ACT + 568 * MiB  , A_SSPE = WS_ACT + 570 * MiB  , A_SSKP = WS_ACT + 572 * MiB  , A_XLO = WS_ACT + 600 * MiB  , A_OG = WS_ACT + 760 * MiB, WS_END = WS_ACT + 824 * MiB;
constexpr int CW_TMO = 0, CW_P0Q = 2048  , CW_BAR = 4096;
constexpr size_t WS_SS = 64 * 1024, SS_BYTES = 64 * 1024;

constexpr int RING_OFF = 0, RING_BYTES = 131072;
constexpr int LDSCTL_OFF = RING_BYTES, MISC_OFF = LDSCTL_OFF + 320;
constexpr int LDS_BYTES = 147456;

#define GAS __attribute__((address_space(1)))
#define LAS __attribute__((address_space(3)))
typedef unsigned short bf16;
typedef unsigned v4u __attribute__((ext_vector_type(4)));
typedef unsigned v2u __attribute__((ext_vector_type(2)));
typedef float f32x4 __attribute__((ext_vector_type(4)));
typedef GAS unsigned gu32;
#define RLX_AGENT __ATOMIC_RELAXED, __HIP_MEMORY_SCOPE_AGENT
#define LDS_WAIT() asm volatile("s_waitcnt lgkmcnt(0)" ::: "memory")
__device__ __forceinline__ float bf_lo(unsigned w) { return __uint_as_float(w << 16); }
__device__ __forceinline__ float bf_hi(unsigned w) { return __uint_as_float(w & 0xffff0000u); }
__device__ __forceinline__ unsigned pk2(float lo, float hi) { return pg8::cvt_pk_bf16(lo, hi); }
__device__ __forceinline__ void unpack8(v4u w, float (&f)[8]) { f[0] = bf_lo(w.x); f[1] = bf_hi(w.x); f[2] = bf_lo(w.y); f[3] = bf_hi(w.y); f[4] = bf_lo(w.z); f[5] = bf_hi(w.z); f[6] = bf_lo(w.w); f[7] = bf_hi(w.w); }
__device__ __forceinline__ v4u pack8(const float (&f)[8]) { v4u w; w.x = pk2(f[0], f[1]); w.y = pk2(f[2], f[3]); w.z = pk2(f[4], f[5]); w.w = pk2(f[6], f[7]); return w; }

#define XB_TMO      128
#define XB_XCNT(j)  (256  + 64 * (j))
#define XB_XSUB(j)  (1280 + 64 * (j))
#define XB_XGEN(j)  (2304 + 64 * (j))
#define XB_TOP      3328
#define XB_TOPGEN   3392
#define XCD_BAR_WORDS 3456
#define XB_SPIN_CAP (1u << 18)

__device__ __forceinline__ unsigned xb_ld(unsigned* p)              { return __hip_atomic_load(p, __ATOMIC_RELAXED, __HIP_MEMORY_SCOPE_AGENT); }
__device__ __forceinline__ unsigned xb_add(unsigned* p, unsigned v) { return __hip_atomic_fetch_add(p, v, __ATOMIC_RELAXED, __HIP_MEMORY_SCOPE_AGENT); }
__device__ __forceinline__ unsigned xb_xcc_id() { return (unsigned)__builtin_amdgcn_s_getreg((3 << 11) | 20) & 0xFu; }
#define XB_SPIN(cond, bar) do { unsigned _sp = 0; while (cond) { __builtin_amdgcn_s_sleep(1); \
    if ((++_sp & 255u) == 0u) { if (xb_ld(&(bar)[XB_TMO])) break; if (_sp > XB_SPIN_CAP) { atomicAdd(&(bar)[XB_TMO], 1u); break; } } } } while (0)

struct XcdBarrier {
    unsigned* bar; unsigned x;
    volatile LAS unsigned* st;
};

__device__ __forceinline__ XcdBarrier xcd_barrier_post(unsigned* bar, volatile LAS unsigned* st) {
    XcdBarrier b; b.bar = bar; b.x = xb_xcc_id(); b.st = st;
    if (threadIdx.x == 0) (void)xb_add(&bar[XB_XCNT(b.x)], 1u);
    return b;
}
__device__ __forceinline__ void xcd_barrier_complete(unsigned* bar, unsigned x, unsigned& nloc, unsigned& nx) {
    const unsigned G = gridDim.x * gridDim.y * gridDim.z;
    unsigned sum, cnt, mine, sp = 0u;
    for (;;) {
        sum = 0u; cnt = 0u; mine = 0u;
#pragma unroll
        for (unsigned j = 0; j < 16; ++j) { const unsigned c = xb_ld(&bar[XB_XCNT(j)]); sum += c; cnt += (c > 0u) ? 1u : 0u; mine = (j == x) ? c : mine; }
        if (sum == G) break;
        __builtin_amdgcn_s_sleep(1);
        if ((++sp & 255u) == 0u) { if (xb_ld(&bar[XB_TMO])) break; if (sp > XB_SPIN_CAP) { atomicAdd(&bar[XB_TMO], 1u); break; } }
    }
    nloc = mine > 0u ? mine : 1u; nx = cnt > 0u ? cnt : 1u;
}

__device__ __forceinline__ void xcd_barrier(const XcdBarrier& b) {
    asm volatile("s_waitcnt vmcnt(0)" ::: "memory");
    __syncthreads();
    if (threadIdx.x == 0) {
        unsigned* bar = b.bar;
        __builtin_amdgcn_s_waitcnt(0);
        unsigned nloc = b.st[0], nx = b.st[1];
        if (nloc == 0u) { xcd_barrier_complete(bar, b.x, nloc, nx); b.st[0] = nloc; b.st[1] = nx; }
        const unsigned old = xb_add(&bar[XB_XSUB(b.x)], 1u);
        const unsigned gen = old / nloc;
        if (old + 1u == (gen + 1u) * nloc) {
            __builtin_amdgcn_fence(__ATOMIC_RELEASE, "agent");
            asm volatile("s_waitcnt vmcnt(0)" ::: "memory");
            const unsigned og = xb_add(&bar[XB_TOP], 1u);
            const unsigned tg = og / nx;
            if (og + 1u == (tg + 1u) * nx) xb_add(&bar[XB_TOPGEN], 1u);
            else XB_SPIN(xb_ld(&bar[XB_TOPGEN]) == tg, bar);
            __builtin_amdgcn_fence(__ATOMIC_ACQUIRE, "agent");
            xb_add(&bar[XB_XGEN(b.x)], 1u);
            asm volatile("s_waitcnt vmcnt(0)" ::: "memory");
        } else {
            XB_SPIN(xb_ld(&bar[XB_XGEN(b.x)]) == gen, bar);
            __builtin_amdgcn_fence(__ATOMIC_ACQUIRE, "agent");
            asm volatile("s_waitcnt vmcnt(0)" ::: "memory");
        }
    }
    __syncthreads();
}

#define LAUNDER_V(x) asm volatile("" : "+v"(x))
__device__ __forceinline__ float wave_sum(float v) {
#pragma unroll
    for (int o = 1; o < 64; o <<= 1) v += __shfl_xor(v, o);
    return v;
}
__device__ __forceinline__ void p0_item_load(const float* W, int N, int item, int lane, f32x4 (&v)[16]) {
    const int nblk = N / 64, kb = item / nblk, nb = item % nblk, k0 = 64 * kb, n0 = 64 * nb, rr = lane >> 4, c4 = (lane & 15) * 4;
#pragma unroll
    for (int i = 0; i < 16; ++i) v[i] = *(const GAS f32x4*)(W + (size_t)(k0 + 4 * i + rr) * N + n0 + c4);
}
__device__ __forceinline__ void p0_item_store(const f32x4 (&v)[16], int K, int N, bf16* WT, LAS float* scr, int item, int lane, int nscale, float scale, const float* kg) {
    const int nblk = N / 64, kb = item / nblk, nb = item % nblk, k0 = 64 * kb, n0 = 64 * nb;
    const int rr = lane >> 4, c4 = (lane & 15) * 4;
#pragma unroll
    for (int i = 0; i < 16; ++i) { const int k = 4 * i + rr; *(LAS f32x4*)(scr + k * 64 + (c4 ^ ((k >> 3) * 4))) = v[i]; }
    LDS_WAIT(); asm volatile("" ::: "memory");
    const int c = lane & 7, nl = lane >> 3;
    f32x4 ga = (f32x4){1.f, 1.f, 1.f, 1.f}, gb = ga;
    if (kg) { ga = *(const GAS f32x4*)(kg + k0 + 8 * c); gb = *(const GAS f32x4*)(kg + k0 + 8 * c + 4); }
#pragma unroll
    for (int j = 0; j < 8; ++j) { const int n = nl + 8 * j; const LAS float* s = scr + (8 * c) * 64 + (n ^ (4 * c));
        const float sc = (n0 + n) < nscale ? scale : 1.f;
        v4u o; o.x = pk2(s[0 * 64] * (sc * ga.x), s[1 * 64] * (sc * ga.y)); o.y = pk2(s[2 * 64] * (sc * ga.z), s[3 * 64] * (sc * ga.w)); o.z = pk2(s[4 * 64] * (sc * gb.x), s[5 * 64] * (sc * gb.y)); o.w = pk2(s[6 * 64] * (sc * gb.z), s[7 * 64] * (sc * gb.w));
        *(GAS v4u*)(WT + (size_t)(n0 + n) * K + k0 + 8 * c) = o; }
    LDS_WAIT(); asm volatile("" ::: "memory");
}
__device__ __forceinline__ void p0_transpose(const float* W, int K, int N, bf16* WT, LAS float* scr, int gw, int NGW, int lane, const float* kg = nullptr, int nscale = 0, float scale = 1.f) {
    LAUNDER_V(lane);
    const int items = (K / 64) * (N / 64);
    f32x4 va[16], vb[16];
    int it = gw;
    if (it < items) p0_item_load(W, N, it, lane, va);
    for (; it < items; it += 2 * NGW) {
        const int it1 = it + NGW, it2 = it + 2 * NGW;
        if (it1 < items) p0_item_load(W, N, it1, lane, vb);
        p0_item_store(va, K, N, WT, scr, it, lane, nscale, scale, kg);
        if (it1 < items) { if (it2 < items) p0_item_load(W, N, it2, lane, va); p0_item_store(vb, K, N, WT, scr, it1, lane, nscale, scale, kg); }
    }
}
__device__ __forceinline__ void x_to_bf16_rows(const float* x, bf16* xb, bf16* xlo, unsigned long long* ss, int gw, int NGW, int lane) {
    LAUNDER_V(lane);
    for (int m = 2 * gw; m < M; m += 2 * NGW) {
        const GAS f32x4* xr = (const GAS f32x4*)(x + (size_t)m * DM) + lane;
        f32x4 v[16], w[16]; float s = 0.f, t = 0.f;
#pragma unroll
        for (int j = 0; j < 16; ++j) { v[j] = xr[64 * j]; w[j] = xr[DM / 4 + 64 * j]; }
#pragma unroll
        for (int j = 0; j < 16; ++j) { s += (v[j].x * v[j].x + v[j].y * v[j].y) + (v[j].z * v[j].z + v[j].w * v[j].w); t += (w[j].x * w[j].x + w[j].y * w[j].y) + (w[j].z * w[j].z + w[j].w * w[j].w); }
#pragma unroll
        for (int o = 1; o < 64; o <<= 1) { s += __shfl_xor(s, o); t += __shfl_xor(t, o); }
        if (lane == 0) { ss[m] = (unsigned long long)(s * pg8::SS_FIX); ss[m + 1] = (unsigned long long)(t * pg8::SS_FIX); }
        GAS v2u* o8 = (GAS v2u*)(xb + (size_t)m * DM) + lane; GAS v2u* l8 = (GAS v2u*)(xlo + (size_t)m * DM) + lane;
#pragma unroll
        for (int j = 0; j < 16; ++j) { v2u o, q, ol, ql; o.x = pk2(v[j].x, v[j].y); o.y = pk2(v[j].z, v[j].w); o8[64 * j] = o; q.x = pk2(w[j].x, w[j].y); q.y = pk2(w[j].z, w[j].w); o8[DM / 4 + 64 * j] = q;
            ol.x = pk2(v[j].x - bf_lo(o.x), v[j].y - bf_hi(o.x)); ol.y = pk2(v[j].z - bf_lo(o.y), v[j].w - bf_hi(o.y)); l8[64 * j] = ol;
            ql.x = pk2(w[j].x - bf_lo(q.x), w[j].y - bf_hi(q.x)); ql.y = pk2(w[j].z - bf_lo(q.y), w[j].w - bf_hi(q.y)); l8[DM / 4 + 64 * j] = ql; }
    }
}
constexpr int P0_T0 = (DM / 64) * (MLA_IN / 64), P0_T1 = (QL / 64) * (NQ / 64), P0_T2 = (KVL / 64) * (NKV / 64), P0_T3 = (DM / 64) * (DM / 64), P0_T4 = (DM / 64) * (SB_IN / 64), P0_T5 = P0_T3;
constexpr int P1_CHUNK = 8;
constexpr int FQ_KV0 = P0_T1 + P0_T2, FQ_OM0 = FQ_KV0 + P0_T3, FQ_IS0 = FQ_OM0 + P0_T4, FQ_OS0 = FQ_IS0 + P0_T5, FQ_IM1 = FQ_OS0 + P0_T0, FQ_KV1 = FQ_IM1 + P0_T1 + P0_T2, FQ_OM1 = FQ_KV1 + P0_T3,
              FQ_IS1 = FQ_OM1 + P0_T4, FQ_OS1 = FQ_IS1 + P0_T5, FQ_ITEMS = FQ_OS1;
struct P1Fill {
    const float* const* in; unsigned char* ws; gu32* q; LAS float* scr; int cbase, cpos;
    __device__ __forceinline__ bool item(int lane, int limit = FQ_ITEMS) {
        if (cpos >= P1_CHUNK) { unsigned v = 0; if (lane == 0) v = __hip_atomic_fetch_add(q, (unsigned)P1_CHUNK, __ATOMIC_RELAXED, __HIP_MEMORY_SCOPE_AGENT); cbase = __builtin_amdgcn_readfirstlane((int)v); cpos = 0; }
        int r = cbase + cpos;
        if (r >= limit) return false;
        ++cpos;
        LAUNDER_V(lane);
        int z_; asm volatile("s_mov_b32 %0, 0" : "=s"(z_));
        const float* const* in = this->in + z_; unsigned char* ws = this->ws + z_;
        const int j = r >= FQ_OS0 ? 1 : 0; if (j) r -= FQ_OS0; else r += P0_T0;
        unsigned char* wl = ws + WS_W + (size_t)j * W_LAYER;
        const float* W; bf16* WT; const float* kg = nullptr; int K, N, nscale = 0; float scale = 1.f;
        if (r < P0_T0) { W = in[2] + (size_t)j * DM * MLA_IN; K = DM; N = MLA_IN; WT = (bf16*)(wl + W_IN_MLA); kg = in[1] + (size_t)j * DM; }
        else if ((r -= P0_T0) < P0_T1) { W = in[4] + (size_t)j * QL * NQ; K = QL; N = NQ; WT = (bf16*)(wl + W_QB); kg = in[3] + (size_t)j * QL; }
        else if ((r -= P0_T1) < P0_T2) { W = in[6] + (size_t)j * KVL * NKV; K = KVL; N = NKV; WT = (bf16*)(wl + W_KVB); kg = in[5] + (size_t)j * KVL; }
        else if ((r -= P0_T2) < P0_T3) { W = in[9] + (size_t)j * DM * DM; K = DM; N = DM; WT = (bf16*)(wl + W_OUT_MLA); }
        else if ((r -= P0_T3) < P0_T4) { W = in[11] + (size_t)j * DM * SB_IN; K = DM; N = SB_IN; WT = (bf16*)(wl + W_IN_SB); kg = in[10] + (size_t)j * DM; nscale = DM; scale = Q_SCALE_SB; }
        else { r -= P0_T4; W = in[12] + (size_t)j * DM * DM; K = DM; N = DM; WT = (bf16*)(wl + W_OUT_SB); }
        f32x4 v[16]; p0_item_load(W, N, r, lane, v); p0_item_store(v, K, N, WT, scr, r, lane, nscale, scale, kg);
        return true;
    }
};
__device__ __forceinline__ void xcd_barrier_fill(const XcdBarrier& b, P1Fill& F, int wave, int lane) {
    asm volatile("s_waitcnt vmcnt(0)" ::: "memory");
    if (threadIdx.x == 0) b.st[2] = 0u;
    __syncthreads();
    if (wave == 0) {
        if (threadIdx.x == 0) {
            unsigned* bar = b.bar;
            __builtin_amdgcn_s_waitcnt(0);
            unsigned nloc = b.st[0], nx = b.st[1];
            if (nloc == 0u) { xcd_barrier_complete(bar, b.x, nloc, nx); b.st[0] = nloc; b.st[1] = nx; }
            const unsigned old = xb_add(&bar[XB_XSUB(b.x)], 1u);
            const unsigned gen = old / nloc;
            if (old + 1u == (gen + 1u) * nloc) {
                __builtin_amdgcn_fence(__ATOMIC_RELEASE, "agent");
                asm volatile("s_waitcnt vmcnt(0)" ::: "memory");
                const unsigned og = xb_add(&bar[XB_TOP], 1u);
                const unsigned tg = og / nx;
                if (og + 1u == (tg + 1u) * nx) xb_add(&bar[XB_TOPGEN], 1u);
                else { b.st[2] = 1u; XB_SPIN(xb_ld(&bar[XB_TOPGEN]) == tg, bar); }
                __builtin_amdgcn_fence(__ATOMIC_ACQUIRE, "agent");
                xb_add(&bar[XB_XGEN(b.x)], 1u);
                asm volatile("s_waitcnt vmcnt(0)" ::: "memory");
            } else {
                b.st[2] = 1u;
                XB_SPIN(xb_ld(&bar[XB_XGEN(b.x)]) == gen, bar);
                __builtin_amdgcn_fence(__ATOMIC_ACQUIRE, "agent");
                asm volatile("s_waitcnt vmcnt(0)" ::: "memory");
            }
            b.st[2] = 2u;
        }
    } else {
        while (b.st[2] == 0u) __builtin_amdgcn_s_sleep(1);
        while (b.st[2] == 1u) { if (!F.item(lane)) { while (b.st[2] == 1u) __builtin_amdgcn_s_sleep(2); break; } }
    }
    __syncthreads();
}

__device__ __forceinline__ void kpe_rows(const bf16* proj, const float* gk, const float* ropec, const float* ropes, bf16* kper, float* sspe, int gw, int NGW, int lane) {
    LAUNDER_V(lane);
    const int tk = lane >> 3, c = lane & 7;
    float g[8];
#pragma unroll
    for (int e = 0; e < 8; ++e) g[e] = gk[128 + 8 * c + e];
    for (int m0 = 8 * gw; m0 < M; m0 += 8 * NGW) { const int m = m0 + tk, pos = m & (SEQ - 1);
        float f[8], x[8], pr[8], o[8]; unpack8(*(const GAS v4u*)(proj + (size_t)m * MLA_INP + C_KPE + 8 * c), f);
        float ss = 0.f;
#pragma unroll
        for (int e = 0; e < 8; ++e) { ss += f[e] * f[e]; x[e] = f[e] * g[e]; }
        ss += __shfl_xor(ss, 1); ss += __shfl_xor(ss, 2); ss += __shfl_xor(ss, 4);
        if (c == 0) sspe[m] = ss;
#pragma unroll
        for (int e = 0; e < 8; ++e) pr[e] = __shfl_xor(x[e], 4);
        const float* cs = ropec + pos * 32 + (c & 3) * 8; const float* sn = ropes + pos * 32 + (c & 3) * 8;
#pragma unroll
        for (int e = 0; e < 8; ++e) o[e] = (c < 4) ? (x[e] * cs[e] - pr[e] * sn[e]) : (pr[e] * sn[e] + x[e] * cs[e]);
        *(GAS v4u*)(kper + (size_t)m * 64 + 8 * c) = pack8(o); }
}


namespace fa {
typedef short bf16x8 __attribute__((ext_vector_type(8)));
typedef short s16x4 __attribute__((ext_vector_type(4)));
typedef float f32x16 __attribute__((ext_vector_type(16)));
typedef float f32x2 __attribute__((ext_vector_type(2)));
#define FA_SBAR() __builtin_amdgcn_sched_barrier(0)
#ifndef FA_PV_DEFER
#define FA_PV_DEFER 1
#endif
#ifndef FA_PP2_LAG
#define FA_PP2_LAG 0
#endif
#ifndef FA_PP2
#define FA_PP2 0
#endif
#ifndef FA_PP
#define FA_PP 0
#endif
constexpr int SHM_V = 16384;
__device__ __forceinline__ int v_st(int k, int c) { const int kk = (k & ~0xC) | ((k & 4) << 1) | ((k & 8) >> 1); return ((kk >> 3) * 4 + (c >> 5)) * 512 + ((kk & 7) * 32 + (c & 31)) * 2; }
__device__ __forceinline__ int v_rd_base(int lane) { return ((lane & 3) << 3) | (((lane >> 2) & 3) << 6) | (((lane >> 4) & 1) << 5) | (((lane >> 5) & 1) << 8); }
__device__ __forceinline__ unsigned cvtpk(float lo, float hi) { unsigned r; asm volatile("v_cvt_pk_bf16_f32 %0, %1, %2" : "=v"(r) : "v"(lo), "v"(hi)); return r; }
__device__ __forceinline__ bf16x8 pack8p(const f32x16& p, int b) { v4u w = {cvtpk(p[b + 0], p[b + 1]), cvtpk(p[b + 2], p[b + 3]), cvtpk(p[b + 4], p[b + 5]), cvtpk(p[b + 6], p[b + 7])}; return __builtin_bit_cast(bf16x8, w); }
__device__ __forceinline__ float ex2(float x) { return __builtin_amdgcn_exp2f(x); }
__device__ __forceinline__ float lg2(float x) { return __builtin_amdgcn_logf(x); }

struct AttnP { const bf16* Q; int qpitch, qhs; const bf16* K; int kpitch, khs; const bf16* V; int vpitch, vhs; const bf16* Gt; int gpitch; bf16* O;
               const bf16* KR; const float* sskp; const float* sspe; const float* gq; const float* gk; const float* rc; const float* rs; };
template <int MODE>
__device__ __forceinline__ void attn_phase(LAS unsigned char* lds, const AttnP& P, int G, int vcu, LAS unsigned* ecnt, unsigned& tacc) {
#if PROBE_SEG
    unsigned t_prev = 0;
#define FA_STAMP_ON(k) (PROBE_SEG == 9 || (k) == 0 || (k) == PROBE_SEG || ((k) == PROBE_SEG - 1 && PROBE_SEG >= 2 && PROBE_SEG <= 4))
#define FA_STAMP(k) do { if (PROBE_MODE == MODE && FA_STAMP_ON(k)) { asm volatile("" ::: "memory"); const unsigned t_now = (unsigned)__builtin_amdgcn_s_memtime(); asm volatile("s_waitcnt lgkmcnt(0)" ::: "memory"); if (PROBE_SEG == (k) || (PROBE_SEG == 9 && (k) != 0)) tacc += t_now - t_prev; t_prev = t_now; } } while (0)
#else
#define FA_STAMP(k) do { } while (0)
#endif
    const bf16* Qp = P.Q; const int qpitch = P.qpitch, qhs = P.qhs; const bf16* Kp = P.K; const int kpitch = P.kpitch, khs = P.khs; const bf16* Vp = P.V; const int vpitch = P.vpitch, vhs = P.vhs;
    const bf16* Gp = P.Gt; const int gpitch = P.gpitch; bf16* Op = P.O;
    constexpr int DQK = MODE == 0 ? 192 : 128, ND = DQK / 16, KPITCH = DQK * 2, SHM_K = 64 * KPITCH, KP = SHM_K / 8192, VOFF = 2 * SHM_K, NVB = (MODE == 0 && (FA_PP2 || FA_PV_DEFER)) ? 3 : 2, RKOFF = VOFF + NVB * SHM_V, QROFF = RKOFF + 8192, NDR = (PROBE_SEG && MODE == 0) ? 7 : 8, GTOFF = 131072 + 1024  ;
    int tid_l = threadIdx.x; asm volatile("" : "+v"(tid_l));
    const int tid = tid_l, wid = __builtin_amdgcn_readfirstlane(tid >> 6), lane = tid & 63;
#define FA_QRBASE ((MODE == 0 && (FA_PP2 || FA_PV_DEFER) && wid >= 6) ? 133120 + (wid - 6) * 4096 : QROFF + wid * (NDR < 8 ? 5120 : 4096))
#define FA_LANE_ADDRS(ln) const int r32 = (ln) & 31, hi = (ln) >> 5; const int kswz = MODE == 0 ? (((r32 >> 1) & 7) << 4) : ((r32 & 15) << 4); const int krow = r32 * KPITCH; \
        const int vb0 = (int)(uintptr_t)lds + VOFF + v_rd_base(ln); LAS unsigned char* qrl = lds + FA_QRBASE + (ln) * 16;
    const float NEG_INF = -__builtin_inff();
    constexpr float SB_CUT = -160.f;
    int un = 0;
    if (MODE == 1) { if (tid < 64) ecnt[tid] = 0u; asm volatile("s_waitcnt lgkmcnt(0)\n\ts_barrier" ::: "memory"); }

#define FA_DMA_OFFS(koff, krope, voff) unsigned koff[KP], voff[2]; bool krope[KP]; { int ln_ = lane; asm volatile("" : "+v"(ln_)); \
            _Pragma("unroll") for (int i_ = 0; i_ < KP; ++i_) { const int L = (wid * KP + i_) * 1024 + ln_ * 16, v = L / KPITCH, sb = L % KPITCH; \
                const int swz = MODE == 0 ? (((v >> 1) & 7) << 4) : ((v & 15) << 4), cb = sb ^ swz, vi = v & 31, dim = cb >> 1; \
                const int key = (v & 32) + (vi & 3) + 4 * (vi >> 3) + 16 * ((vi >> 2) & 1);                     \
                krope[i_] = MODE == 0 && dim >= 128; koff[i_] = krope[i_] ? (unsigned)(key * 64 + dim - 128) : (unsigned)(key * kpitch + dim); } \
            _Pragma("unroll") for (int i_ = 0; i_ < 2; ++i_) { const int L = (wid * 2 + i_) * 1024 + ln_ * 16, sub = L >> 9, within = L & 511, kk = (sub >> 2) * 8 + (within >> 6); \
                const int u_ = (kk & ~0xC) | ((kk & 4) << 1) | ((kk & 8) >> 1);                                    \
                const int key = (u_ & ~0x18) | ((u_ & 8) << 1) | ((u_ & 16) >> 1);                                  \
                voff[i_] = (unsigned)(key * vpitch + (sub & 3) * 32 + ((within & 63) >> 4) * 8); } }
#define FA_DMA_GO(koff, krope, voff, Kh_, Vh_, KRh_, j, KB) do { const bf16* kb_ = (Kh_) + (size_t)(j) * 64 * kpitch; const bf16* vb_ = (Vh_) + (size_t)(j) * 64 * vpitch; const bf16* kr_ = MODE == 0 ? (KRh_) + (size_t)(j) * 64 * 64 : nullptr; \
            _Pragma("unroll") for (int i_ = 0; i_ < KP; ++i_) __builtin_amdgcn_global_load_lds((const unsigned*)(((MODE == 0 && krope[i_]) ? kr_ : kb_) + koff[i_]), (LAS unsigned*)(lds + (KB) * SHM_K + (wid * KP + i_) * 1024), 16, 0, 0); \
            _Pragma("unroll") for (int i_ = 0; i_ < 2; ++i_) __builtin_amdgcn_global_load_lds((const unsigned*)(vb_ + voff[i_]), (LAS unsigned*)(lds + VOFF + (KB) * SHM_V + (wid * 2 + i_) * 1024), 16, 0, 0); } while (0)
#define FA_WAITBAR() asm volatile("s_waitcnt vmcnt(0) lgkmcnt(0)\n\ts_barrier" ::: "memory")
#define FA_TRRD(dst, off) asm volatile("ds_read_b64_tr_b16 %0, %1 offset:%2" : "=&v"(dst) : "v"(vb0), "i"(off) : "memory")
#define FA_PV_D0(d0, VB) do { s16x4 l0, l1, l2, l3, h0, h1, h2, h3; constexpr int b_ = (VB) * SHM_V + (d0) * 512; \
            FA_TRRD(l0, b_); FA_TRRD(h0, b_ + 2048); FA_TRRD(l1, b_ + 4096); FA_TRRD(h1, b_ + 6144); FA_TRRD(l2, b_ + 8192); FA_TRRD(h2, b_ + 10240); FA_TRRD(l3, b_ + 12288); FA_TRRD(h3, b_ + 14336); \
            asm volatile("s_waitcnt lgkmcnt(0)" ::: "memory"); FA_SBAR(); \
            o[d0] = __builtin_amdgcn_mfma_f32_32x32x16_bf16((bf16x8){l0[0], l0[1], l0[2], l0[3], h0[0], h0[1], h0[2], h0[3]}, pa0, o[d0], 0, 0, 0); \
            o[d0] = __builtin_amdgcn_mfma_f32_32x32x16_bf16((bf16x8){l1[0], l1[1], l1[2], l1[3], h1[0], h1[1], h1[2], h1[3]}, pa1, o[d0], 0, 0, 0); \
            o[d0] = __builtin_amdgcn_mfma_f32_32x32x16_bf16((bf16x8){l2[0], l2[1], l2[2], l2[3], h2[0], h2[1], h2[2], h2[3]}, pa2, o[d0], 0, 0, 0); \
            o[d0] = __builtin_amdgcn_mfma_f32_32x32x16_bf16((bf16x8){l3[0], l3[1], l3[2], l3[3], h3[0], h3[1], h3[2], h3[3]}, pa3, o[d0], 0, 0, 0); } while (0)
#define FA_STEP(t, KB) do { const int j = MODE == 0 ? (t) : NT - 1 - (t); int ln_s = lane; asm volatile("" : "+v"(ln_s)); FA_LANE_ADDRS(ln_s) \
            FA_STAMP(0); \
            if ((t) + 1 < NT) { const int jn = MODE == 0 ? (t) + 1 : NT - 2 - (t); FA_DMA_GO(sko, skr, svo, Kh, Vh, KRh, jn, (KB) ^ 1); } \
            if (j <= jmax && !(MODE == 1 && wdone)) { \
                f32x16 p0 = f32x16{}, p1 = f32x16{}; \
                _Pragma("unroll") for (int d0 = 0; d0 < ND; ++d0) { const int cb = d0 * 32 + hi * 16; const LAS unsigned char* a = lds + (KB) * SHM_K + krow + (cb ^ kswz); \
                    const bf16x8 k0 = *(const LAS bf16x8*)a, k1 = *(const LAS bf16x8*)(a + 32 * KPITCH); \
                    const bf16x8 qf = d0 < NDR ? qr[d0 < NDR ? d0 : 0] : *(const LAS bf16x8*)(qrl + (d0 == 7 ? 4 : d0 - 8) * 1024); \
                    p0 = __builtin_amdgcn_mfma_f32_32x32x16_bf16(k0, qf, p0, 0, 0, 0); p1 = __builtin_amdgcn_mfma_f32_32x32x16_bf16(k1, qf, p1, 0, 0, 0); } \
                const int kb = j * 64, dq = qlo + r32 - kb - 16 * hi; \
                if (PROBE_SEG) { asm volatile("" : "+v"(p0), "+v"(p1)); FA_STAMP(1); }     \
                if (MODE == 0) { \
                    { const LAS float* rkw = (const LAS float*)(lds + RKOFF) + kb; \
                      _Pragma("unroll") for (int g_ = 0; g_ < 4; ++g_) { const f32x4 ra = *(const LAS f32x4*)(rkw + 16 * hi + 4 * g_), rb = *(const LAS f32x4*)(rkw + 32 + 16 * hi + 4 * g_); \
                          p0[4 * g_] *= ra.x; p0[4 * g_ + 1] *= ra.y; p0[4 * g_ + 2] *= ra.z; p0[4 * g_ + 3] *= ra.w; p1[4 * g_] *= rb.x; p1[4 * g_ + 1] *= rb.y; p1[4 * g_ + 2] *= rb.z; p1[4 * g_ + 3] *= rb.w; } } \
                    if (kb + 63 > qlo) { _Pragma("unroll") for (int r = 0; r < 16; ++r) { if (r > dq) p0[r] = NEG_INF; if (r + 32 > dq) p1[r] = NEG_INF; } } \
                    float pmax = p0[0]; _Pragma("unroll") for (int r = 1; r < 16; ++r) pmax = fmaxf(pmax, p0[r]); _Pragma("unroll") for (int r = 0; r < 16; ++r) pmax = fmaxf(pmax, p1[r]); \
                    { auto rr = __builtin_amdgcn_permlane32_swap(__float_as_uint(pmax), __float_as_uint(pmax), false, false); pmax = fmaxf(__uint_as_float(rr[0]), __uint_as_float(rr[1])); } \
                    if (!__all(pmax - m_reg <= 11.5f)) { const float mn = fmaxf(m_reg, pmax), alpha = ex2(m_reg - mn); m_reg = mn; l_reg *= alpha; \
                        _Pragma("unroll") for (int d0 = 0; d0 < 4; ++d0) _Pragma("unroll") for (int r = 0; r < 16; ++r) o[d0][r] *= alpha; } \
                    float ps = 0.f; \
                    _Pragma("unroll") for (int r = 0; r < 16; r += 2) { const f32x2 a0 = (f32x2){p0[r], p0[r + 1]} - (f32x2){m_reg, m_reg}, a1 = (f32x2){p1[r], p1[r + 1]} - (f32x2){m_reg, m_reg}; \
                        p0[r] = ex2(a0.x); p0[r + 1] = ex2(a0.y); p1[r] = ex2(a1.x); p1[r + 1] = ex2(a1.y); ps += (p0[r] + p1[r]) + (p0[r + 1] + p1[r + 1]); } \
                    l_reg += ps; \
                } else { \
                    f32x16 e0, e1;     \
                    _Pragma("unroll") for (int r = 0; r < 16; r += 2) { const f32x2 t0 = {p0[r], p0[r + 1]}, t1 = {p1[r], p1[r + 1]}; \
                        const f32x2 x0 = (f32x2){ex2(-fabsf(t0.x)), ex2(-fabsf(t0.y))} + (f32x2){1.f, 1.f}, x1 = (f32x2){ex2(-fabsf(t1.x)), ex2(-fabsf(t1.y))} + (f32x2){1.f, 1.f}; \
                        const f32x2 b0 = (f32x2){fminf(t0.x, 0.f), fminf(t0.y, 0.f)} - (f32x2){lg2(x0.x), lg2(x0.y)}, b1 = (f32x2){fminf(t1.x, 0.f), fminf(t1.y, 0.f)} - (f32x2){lg2(x1.x), lg2(x1.y)}; \
                        const f32x2 d0 = b0 - t0, d1 = b1 - t1; \
                        p0[r] = b0.x; p0[r + 1] = b0.y; e0[r] = d0.x; e0[r + 1] = d0.y; p1[r] = b1.x; p1[r + 1] = b1.y; e1[r] = d1.x; e1[r + 1] = d1.y; } \
                    if (kb + 63 >= qlo) { _Pragma("unroll") for (int r = 0; r < 16; ++r) { if (r >= dq) { p0[r] = NEG_INF; e0[r] = 0.f; } if (r + 32 >= dq) { p1[r] = NEG_INF; e1[r] = 0.f; } } } \
                    float s0 = 0.f, s1 = 0.f; \
                    _Pragma("unroll") for (int r = 15; r >= 0; --r) { const float x0 = e0[r], x1 = e1[r]; e0[r] = s0; e1[r] = s1; s0 += x0; s1 += x1; } \
                    const auto r1 = __builtin_amdgcn_permlane32_swap(__float_as_uint(s0), __float_as_uint(s1), false, false); \
                    const auto r2 = __builtin_amdgcn_permlane32_swap(__float_as_uint(s1), __float_as_uint(s0), false, false); \
                    const float ps0 = __uint_as_float(hi ? r2[0] : r1[1]), ps1 = __uint_as_float(hi ? r1[0] : r2[1]); \
                    const float off1 = carry + (hi ? 0.f : ps1), off0 = carry + s1 + ps1 + (hi ? 0.f : ps0); \
                    carry += (s0 + s1) + (ps0 + ps1); \
                    _Pragma("unroll") for (int r = 0; r < 16; r += 2) { const f32x2 a0 = (f32x2){p0[r], p0[r + 1]} + ((f32x2){e0[r], e0[r + 1]} + (f32x2){off0, off0}), a1 = (f32x2){p1[r], p1[r + 1]} + ((f32x2){e1[r], e1[r + 1]} + (f32x2){off1, off1}); \
                        p0[r] = ex2(a0.x); p0[r + 1] = ex2(a0.y); p1[r] = ex2(a1.x); p1[r + 1] = ex2(a1.y); } \
                } \
                const bf16x8 pa0 = pack8p(p0, 0), pa1 = pack8p(p0, 8), pa2 = pack8p(p1, 0), pa3 = pack8p(p1, 8); \
                FA_STAMP(2); \
                FA_PV_D0(0, KB); FA_PV_D0(1, KB); FA_PV_D0(2, KB); FA_PV_D0(3, KB); \
                FA_STAMP(3); \
                if (MODE == 1) { if (__all(carry < SB_CUT)) wdone = true; } \
            } \
            if (MODE == 1 && wdone && lane == 0) __hip_atomic_fetch_add(ebank + (t), 1u, __ATOMIC_RELAXED, __HIP_MEMORY_SCOPE_WORKGROUP); \
            FA_WAITBAR(); FA_STAMP(4); \
            if (MODE == 1) stop = *(volatile LAS unsigned*)(ebank + (t)) == 8u; } while (0)


#define FA_DMA_K(koff, krope, Kh_, KRh_, j, KB) do { const bf16* kb_ = (Kh_) + (size_t)(j) * 64 * kpitch; const bf16* kr_ = MODE == 0 ? (KRh_) + (size_t)(j) * 64 * 64 : nullptr; \
            _Pragma("unroll") for (int i_ = 0; i_ < KP; ++i_) __builtin_amdgcn_global_load_lds((const unsigned*)(((MODE == 0 && krope[i_]) ? kr_ : kb_) + koff[i_]), (LAS unsigned*)(lds + (KB) * SHM_K + (wid * KP + i_) * 1024), 16, 0, 0); } while (0)
#define FA_DMA_V(voff, Vh_, j, KB) do { const bf16* vb_ = (Vh_) + (size_t)(j) * 64 * vpitch; \
            _Pragma("unroll") for (int i_ = 0; i_ < 2; ++i_) __builtin_amdgcn_global_load_lds((const unsigned*)(vb_ + voff[i_]), (LAS unsigned*)(lds + VOFF + (KB) * SHM_V + (wid * 2 + i_) * 1024), 16, 0, 0); } while (0)
#define FA_SLOT_END(more_, na, nb) do { FA_SBAR(); if (more_) { if (!grpB) asm volatile("s_waitcnt vmcnt(" #na ") lgkmcnt(0)\n\ts_barrier" ::: "memory"); else asm volatile("s_waitcnt vmcnt(" #nb ") lgkmcnt(0)\n\ts_barrier" ::: "memory"); } \
            else asm volatile("s_waitcnt vmcnt(0) lgkmcnt(0)\n\ts_barrier" ::: "memory"); FA_SBAR(); } while (0)
#define FA_S1(t, KB) do { const int j = (t); int ln_s = lane; asm volatile("" : "+v"(ln_s)); FA_LANE_ADDRS(ln_s) \
            const bool more_ = (t) + 1 < NT; \
            if (more_) { if (!grpB) FA_DMA_K(sko, skr, Kh, KRh, (t) + 1, (KB) ^ 1); else FA_DMA_V(svo, Vh, (t) + 1, (KB) ^ 1); } \
            if (j <= jmax) { \
                p0 = f32x16{}; p1 = f32x16{}; \
                _Pragma("unroll") for (int d0 = 0; d0 < ND; ++d0) { const int cb = d0 * 32 + hi * 16; const LAS unsigned char* a = lds + (KB) * SHM_K + krow + (cb ^ kswz); \
                    const bf16x8 k0 = *(const LAS bf16x8*)a, k1 = *(const LAS bf16x8*)(a + 32 * KPITCH); \
                    const bf16x8 qf = d0 < NDR ? qr[d0 < NDR ? d0 : 0] : *(const LAS bf16x8*)(qrl + (d0 == 7 ? 4 : d0 - 8) * 1024); \
                    p0 = __builtin_amdgcn_mfma_f32_32x32x16_bf16(k0, qf, p0, 0, 0, 0); p1 = __builtin_amdgcn_mfma_f32_32x32x16_bf16(k1, qf, p1, 0, 0, 0); } \
                const int kb = j * 64, dq = qlo + r32 - kb - 16 * hi; \
                { const LAS float* rkw = (const LAS float*)(lds + RKOFF) + kb; \
                  _Pragma("unroll") for (int g_ = 0; g_ < 4; ++g_) { const f32x4 ra = *(const LAS f32x4*)(rkw + 16 * hi + 4 * g_), rb = *(const LAS f32x4*)(rkw + 32 + 16 * hi + 4 * g_); \
                      p0[4 * g_] *= ra.x; p0[4 * g_ + 1] *= ra.y; p0[4 * g_ + 2] *= ra.z; p0[4 * g_ + 3] *= ra.w; p1[4 * g_] *= rb.x; p1[4 * g_ + 1] *= rb.y; p1[4 * g_ + 2] *= rb.z; p1[4 * g_ + 3] *= rb.w; } } \
                if (kb + 63 > qlo) { _Pragma("unroll") for (int r = 0; r < 16; ++r) { if (r > dq) p0[r] = NEG_INF; if (r + 32 > dq) p1[r] = NEG_INF; } } \
                float pmax = p0[0]; _Pragma("unroll") for (int r = 1; r < 16; ++r) pmax = fmaxf(pmax, p0[r]); _Pragma("unroll") for (int r = 0; r < 16; ++r) pmax = fmaxf(pmax, p1[r]); \
                { auto rr = __builtin_amdgcn_permlane32_swap(__float_as_uint(pmax), __float_as_uint(pmax), false, false); pmax = fmaxf(__uint_as_float(rr[0]), __uint_as_float(rr[1])); } \
                if (!__all(pmax - m_reg <= 11.5f)) { const float mn = fmaxf(m_reg, pmax), alpha = ex2(m_reg - mn); m_reg = mn; l_reg *= alpha; \
                    _Pragma("unroll") for (int d0 = 0; d0 < 4; ++d0) _Pragma("unroll") for (int r = 0; r < 16; ++r) o[d0][r] *= alpha; } \
                (void)vb0; \
            } \
            FA_SLOT_END(more_, 3, 2); } while (0)
#define FA_S2(t, KB) do { const int j = (t); int ln_s = lane; asm volatile("" : "+v"(ln_s)); FA_LANE_ADDRS(ln_s) \
            const bool more_ = grpB ? (t) + 2 < NT : (t) + 1 < NT; \
            if (more_) { if (!grpB) FA_DMA_V(svo, Vh, (t) + 1, (KB) ^ 1); else FA_DMA_K(sko, skr, Kh, KRh, (t) + 2, (KB)); } \
            if (j <= jmax) { \
                float ps = 0.f; \
                _Pragma("unroll") for (int r = 0; r < 16; ++r) { p0[r] = ex2(p0[r] - m_reg); p1[r] = ex2(p1[r] - m_reg); ps += p0[r] + p1[r]; } \
                l_reg += ps; \
                const bf16x8 pa0 = pack8p(p0, 0), pa1 = pack8p(p0, 8), pa2 = pack8p(p1, 0), pa3 = pack8p(p1, 8); \
                FA_PV_D0(0, KB); FA_PV_D0(1, KB); FA_PV_D0(2, KB); FA_PV_D0(3, KB); \
                (void)krow; (void)kswz; (void)qrl; \
            } \
            FA_SLOT_END(more_, 2, 3); } while (0)

#define FA_QK2(t) do { const int j = (t); int ln_s = lane; asm volatile("" : "+v"(ln_s)); FA_LANE_ADDRS(ln_s) (void)vb0; \
            if (j <= jmax) { const LAS unsigned char* kt_ = lds + ((t) & 1) * SHM_K + krow; p0 = f32x16{}; p1 = f32x16{}; \
                _Pragma("unroll") for (int d0 = 0; d0 < ND; ++d0) { const int cb = d0 * 32 + hi * 16; const LAS unsigned char* a = kt_ + (cb ^ kswz); \
                    const bf16x8 k0 = *(const LAS bf16x8*)a, k1 = *(const LAS bf16x8*)(a + 32 * KPITCH); \
                    const bf16x8 qf = d0 < NDR ? qr[d0 < NDR ? d0 : 0] : *(const LAS bf16x8*)(qrl + (d0 == 7 ? 4 : d0 - 8) * 1024); \
                    p0 = __builtin_amdgcn_mfma_f32_32x32x16_bf16(k0, qf, p0, 0, 0, 0); p1 = __builtin_amdgcn_mfma_f32_32x32x16_bf16(k1, qf, p1, 0, 0, 0); } } } while (0)
#define FA_SMPV2(t, vs_) do { const int j = (t); int ln_s = lane; asm volatile("" : "+v"(ln_s)); \
            if (j <= jmax) { const int r32 = ln_s & 31, hi = ln_s >> 5; const int vb0 = (int)(uintptr_t)lds + VOFF + (vs_) * SHM_V + v_rd_base(ln_s); \
                const int kb = j * 64, dq = qlo + r32 - kb - 16 * hi; \
                { const LAS float* rkw = (const LAS float*)(lds + RKOFF) + kb; \
                  _Pragma("unroll") for (int g_ = 0; g_ < 4; ++g_) { const f32x4 ra = *(const LAS f32x4*)(rkw + 16 * hi + 4 * g_), rb = *(const LAS f32x4*)(rkw + 32 + 16 * hi + 4 * g_); \
                      p0[4 * g_] *= ra.x; p0[4 * g_ + 1] *= ra.y; p0[4 * g_ + 2] *= ra.z; p0[4 * g_ + 3] *= ra.w; p1[4 * g_] *= rb.x; p1[4 * g_ + 1] *= rb.y; p1[4 * g_ + 2] *= rb.z; p1[4 * g_ + 3] *= rb.w; } } \
                if (kb + 63 > qlo) { _Pragma("unroll") for (int r = 0; r < 16; ++r) { if (r > dq) p0[r] = NEG_INF; if (r + 32 > dq) p1[r] = NEG_INF; } } \
                float pmax = p0[0]; _Pragma("unroll") for (int r = 1; r < 16; ++r) pmax = fmaxf(pmax, p0[r]); _Pragma("unroll") for (int r = 0; r < 16; ++r) pmax = fmaxf(pmax, p1[r]); \
                { auto rr = __builtin_amdgcn_permlane32_swap(__float_as_uint(pmax), __float_as_uint(pmax), false, false); pmax = fmaxf(__uint_as_float(rr[0]), __uint_as_float(rr[1])); } \
                if (!__all(pmax - m_reg <= 11.5f)) { const float mn = fmaxf(m_reg, pmax), alpha = ex2(m_reg - mn); m_reg = mn; l_reg *= alpha; \
                    _Pragma("unroll") for (int d0 = 0; d0 < 4; ++d0) _Pragma("unroll") for (int r = 0; r < 16; ++r) o[d0][r] *= alpha; } \
                float ps = 0.f; \
                _Pragma("unroll") for (int r = 0; r < 16; r += 2) { const f32x2 a0 = (f32x2){p0[r], p0[r + 1]} - (f32x2){m_reg, m_reg}, a1 = (f32x2){p1[r], p1[r + 1]} - (f32x2){m_reg, m_reg}; \
                    p0[r] = ex2(a0.x); p0[r + 1] = ex2(a0.y); p1[r] = ex2(a1.x); p1[r + 1] = ex2(a1.y); ps += (p0[r] + p1[r]) + (p0[r + 1] + p1[r + 1]); } \
                l_reg += ps; \
                const bf16x8 pa0 = pack8p(p0, 0), pa1 = pack8p(p0, 8), pa2 = pack8p(p1, 0), pa3 = pack8p(p1, 8); \
                FA_PV_D0(0, 0); FA_PV_D0(1, 0); FA_PV_D0(2, 0); FA_PV_D0(3, 0); } } while (0)
#define FA_STEP2(t) do { \
            if ((t) + 1 < NT) { FA_DMA_K(sko, skr, Kh, KRh, (t) + 1, ((t) + 1) & 1); FA_DMA_V(svo, Vh, (t) + 1, vs1); } \
            if (grpB && (t) > 0) FA_SMPV2((t) - 1, vsp); \
            FA_QK2(t); \
            if (!grpB || (t) + 1 == NT) FA_SMPV2(t, vs0); \
            FA_WAITBAR(); vsp = vs0; vs0 = vs1; vs1 = vs1 == 2 ? 0 : vs1 + 1; } while (0)

#define FA_EXPSLOT(P, r) do { const f32x2 a_ = (f32x2){P[r], P[(r) + 1]} - (f32x2){m_reg, m_reg}; P[r] = ex2(a_.x); P[(r) + 1] = ex2(a_.y); ps += P[r] + P[(r) + 1]; } while (0)
#define FA_MF(d0, L, H, PA) o[d0] = __builtin_amdgcn_mfma_f32_32x32x16_bf16((bf16x8){L[0], L[1], L[2], L[3], H[0], H[1], H[2], H[3]}, PA, o[d0], 0, 0, 0)
#define FA_PV_D0I(d0, r0) do { s16x4 l0, l1, l2, l3, h0, h1, h2, h3; constexpr int b_ = (d0) * 512; \
            FA_TRRD(l0, b_); FA_TRRD(h0, b_ + 2048); FA_TRRD(l1, b_ + 4096); FA_TRRD(h1, b_ + 6144); FA_TRRD(l2, b_ + 8192); FA_TRRD(h2, b_ + 10240); FA_TRRD(l3, b_ + 12288); FA_TRRD(h3, b_ + 14336); \
            FA_EXPSLOT(p0, r0); asm volatile("s_waitcnt lgkmcnt(0)" ::: "memory"); FA_SBAR(); \
            FA_MF(d0, l0, h0, pa0); FA_SBAR(); FA_EXPSLOT(p1, r0); FA_SBAR(); \
            FA_MF(d0, l1, h1, pa1); FA_SBAR(); FA_EXPSLOT(p0, (r0) + 2); FA_SBAR(); \
            FA_MF(d0, l2, h2, pa2); FA_SBAR(); FA_EXPSLOT(p1, (r0) + 2); FA_SBAR(); \
            FA_MF(d0, l3, h3, pa3); FA_SBAR(); } while (0)
#define FA_SM3(t, dopv_, vs_) do { const int j = (t); int ln_s = lane; asm volatile("" : "+v"(ln_s)); const bool pv_ = (dopv_) && (t) - 1 <= jmax; \
            if (j <= jmax) { const int r32 = ln_s & 31, hi = ln_s >> 5; const int vb0 = (int)(uintptr_t)lds + VOFF + (vs_) * SHM_V + v_rd_base(ln_s); \
                const int kb = j * 64, dq = qlo + r32 - kb - 16 * hi; \
                { const LAS float* rkw = (const LAS float*)(lds + RKOFF) + kb; \
                  _Pragma("unroll") for (int g_ = 0; g_ < 4; ++g_) { const f32x4 ra = *(const LAS f32x4*)(rkw + 16 * hi + 4 * g_), rb = *(const LAS f32x4*)(rkw + 32 + 16 * hi + 4 * g_); \
                      p0[4 * g_] *= ra.x; p0[4 * g_ + 1] *= ra.y; p0[4 * g_ + 2] *= ra.z; p0[4 * g_ + 3] *= ra.w; p1[4 * g_] *= rb.x; p1[4 * g_ + 1] *= rb.y; p1[4 * g_ + 2] *= rb.z; p1[4 * g_ + 3] *= rb.w; } } \
                if (kb + 63 > qlo) { _Pragma("unroll") for (int r = 0; r < 16; ++r) { if (r > dq) p0[r] = NEG_INF; if (r + 32 > dq) p1[r] = NEG_INF; } } \
                float pmax = p0[0]; _Pragma("unroll") for (int r = 1; r < 16; ++r) pmax = fmaxf(pmax, p0[r]); _Pragma("unroll") for (int r = 0; r < 16; ++r) pmax = fmaxf(pmax, p1[r]); \
                { auto rr = __builtin_amdgcn_permlane32_swap(__float_as_uint(pmax), __float_as_uint(pmax), false, false); pmax = fmaxf(__uint_as_float(rr[0]), __uint_as_float(rr[1])); } \
                const bool resc_ = !__all(pmax - m_reg <= 11.5f); float alpha_ = 1.f; \
                if (resc_) { const float mn = fmaxf(m_reg, pmax); alpha_ = ex2(m_reg - mn); m_reg = mn; l_reg *= alpha_; } \
                float ps = 0.f; \
                if (pv_) { FA_PV_D0I(0, 0); FA_PV_D0I(1, 4); FA_PV_D0I(2, 8); FA_PV_D0I(3, 12); }     \
                else { _Pragma("unroll") for (int r = 0; r < 16; r += 2) { FA_EXPSLOT(p0, r); FA_EXPSLOT(p1, r); } } \
                if (resc_) { _Pragma("unroll") for (int d0 = 0; d0 < 4; ++d0) _Pragma("unroll") for (int r = 0; r < 16; ++r) o[d0][r] *= alpha_; } \
                l_reg += ps; \
                pa0 = pack8p(p0, 0); pa1 = pack8p(p0, 8); pa2 = pack8p(p1, 0); pa3 = pack8p(p1, 8); \
            } } while (0)
#define FA_PV3(t, vs_) do { int ln_s = lane; asm volatile("" : "+v"(ln_s)); \
            if ((t) <= jmax) { const int vb0 = (int)(uintptr_t)lds + VOFF + (vs_) * SHM_V + v_rd_base(ln_s); FA_PV_D0(0, 0); FA_PV_D0(1, 0); FA_PV_D0(2, 0); FA_PV_D0(3, 0); } } while (0)
#define FA_STEP3(t) do { \
            if ((t) + 1 < NT) { FA_DMA_K(sko, skr, Kh, KRh, (t) + 1, ((t) + 1) & 1); FA_DMA_V(svo, Vh, (t) + 1, vs1); } \
            FA_QK2(t); \
            FA_SM3(t, (t) > 0, vsp); \
            if ((t) == jmax + 1 || ((t) + 1 == NT && jmax + 1 == NT)) { const int vf_ = (t) > jmax ? vsp : vs0; FA_PV3(jmax, vf_); }     \
            FA_WAITBAR(); vsp = vs0; vs0 = vs1; vs1 = vs1 == 2 ? 0 : vs1 + 1; } while (0)

    const int nunits = vcu < 512 ? 2 * ((512 - vcu + G - 1) / G) : 0;
#define FA_UNIT(u_, b_, h_, qb_) do { const int it_ = vcu + G * ((u_) >> 1), bh_ = it_ >> 2, pp_ = it_ & 3; b_ = bh_ >> 5; h_ = bh_ & 31; qb_ = ((u_) & 1) ? pp_ : 7 - pp_; } while (0)
    LAS float* gtl = (LAS float*)(lds + GTOFF);
    if (MODE == 0) { if (tid < QKD) gtl[tid] = tid < 128 ? P.gq[tid] * P.gk[tid] : P.gq[tid]; }
    bf16x8 qr[ND]; f32x16 o[4];
    float m_reg = -1e30f, l_reg = 0.f, carry = 0.f; bool wdone = false; LAS unsigned* ebank = ecnt;
    int b = 0, h = 0, qlo = 0, NT = 0, jmax = 0; const bf16* Kh = nullptr; const bf16* Vh = nullptr; const bf16* KRh = nullptr;
    for (int u = -1; u < nunits; ++u) {
        if (u >= 0) {
            bool stop = false;
            FA_DMA_OFFS(sko, skr, svo)
            if (MODE == 0 && FA_PV_DEFER) {
                f32x16 p0 = f32x16{}, p1 = f32x16{}; bf16x8 pa0 = bf16x8{}, pa1 = bf16x8{}, pa2 = bf16x8{}, pa3 = bf16x8{}; int vsp = 0, vs0 = 0, vs1 = 1;
                for (int t = 0; t < NT; ++t) FA_STEP3(t);
            } else if (MODE == 0 && FA_PP2) {
                const bool grpB = FA_PP2_LAG && wid >= 4; f32x16 p0 = f32x16{}, p1 = f32x16{}; int vsp = 0, vs0 = 0, vs1 = 1;
                for (int t = 0; t < NT; ++t) FA_STEP2(t);
            } else if (MODE == 0 && FA_PP) {
                const bool grpB = wid >= 4; f32x16 p0 = f32x16{}, p1 = f32x16{};
                if (grpB) { FA_DMA_K(sko, skr, Kh, KRh, 1, 1); asm volatile("s_barrier" ::: "memory"); }
                for (int t = 0; t < NT; t += 2) { FA_S1(t, 0); FA_S2(t, 0); FA_S1(t + 1, 1); FA_S2(t + 1, 1); }
                if (!grpB) asm volatile("s_barrier" ::: "memory");
            } else
            for (int t = 0; t < NT; t += 2) { FA_STEP(t, 0); if (MODE == 1 && stop) break; FA_STEP(t + 1, 1); if (MODE == 1 && stop) break; }
        }
        FA_STAMP(0);
        const bool has_next = u + 1 < nunits;
        int b2 = 0, h2 = 0, q2 = 0; if (has_next) FA_UNIT(u + 1, b2, h2, q2);
        const int qlo2 = q2 * 256 + wid * 32, NT2 = 4 * (q2 + 1);
        const bf16* Kh2 = Kp + (size_t)b2 * SEQ * kpitch + h2 * khs; const bf16* Vh2 = Vp + (size_t)b2 * SEQ * vpitch + h2 * vhs; const bf16* KRh2 = MODE == 0 ? P.KR + (size_t)b2 * SEQ * 64 : nullptr;
        int lane_e = lane; asm volatile("" : "+v"(lane_e));
        const int er = lane_e >> 3, ec = lane_e & 7;
        v2u gv[16];
        const bf16* grow = Gp + ((size_t)b * SEQ + qlo + er) * gpitch + h * 128 + 4 * ec;
#define FA_LOAD_G(half) do { if (MODE == 0 || (half) == 0) { _Pragma("unroll") for (int ps = 0; ps < (MODE == 1 ? 4 : 2); ++ps) _Pragma("unroll") for (int i = 0; i < 4; ++i) gv[(2 * (half) + ps) * 4 + i] = *(const GAS v2u*)(grow + (size_t)(8 * i) * gpitch + 32 * (2 * (half) + ps)); } asm volatile("" ::: "memory"); } while (0)
        FA_LOAD_G(0); FA_LOAD_G(1);
        f32x4 csv[8]; f32x4 skv[4]; float spv[4];
        { const size_t mr_ = (size_t)b2 * SEQ + qlo2 + (lane_e & 31);
#pragma unroll
            for (int d0 = 0; d0 < ND; ++d0) qr[d0] = *(const bf16x8*)(Qp + mr_ * qpitch + h2 * qhs + d0 * 16 + (lane_e >> 5) * 8);
        }
        asm volatile("" ::: "memory");
        if (has_next) { FA_DMA_OFFS(tko, tkr, tvo) FA_DMA_GO(tko, tkr, tvo, Kh2, Vh2, KRh2, MODE == 0 ? 0 : NT2 - 1, 0); }
        asm volatile("" ::: "memory");
#define FA_LOAD_CS() do { if (MODE == 0) { const int pos = qlo2 + (lane_e & 31); \
            _Pragma("unroll") for (int dd = 0; dd < 2; ++dd) { const int ri = dd * 16 + (lane_e >> 5) * 8; \
                csv[dd * 4 + 0] = *(const GAS f32x4*)(P.rc + pos * 32 + ri); csv[dd * 4 + 1] = *(const GAS f32x4*)(P.rc + pos * 32 + ri + 4); \
                csv[dd * 4 + 2] = *(const GAS f32x4*)(P.rs + pos * 32 + ri); csv[dd * 4 + 3] = *(const GAS f32x4*)(P.rs + pos * 32 + ri + 4); } } asm volatile("" ::: "memory"); } while (0)
#define FA_LOAD_SK() do { if (MODE == 0) { \
            _Pragma("unroll") for (int i = 0; i < 4; ++i) { const size_t kt_ = (size_t)b2 * SEQ + tid + 512 * i; skv[i] = *(const GAS f32x4*)(P.sskp + (kt_ * NH + h2) * 4); spv[i] = P.sspe[kt_]; } } asm volatile("" ::: "memory"); } while (0)
        if (u >= 0) {
            float inv = 1.f;
            if (MODE == 0) { auto rr = __builtin_amdgcn_permlane32_swap(__float_as_uint(l_reg), __float_as_uint(l_reg), false, false); inv = 1.f / (__uint_as_float(rr[0]) + __uint_as_float(rr[1])); }
            LAS unsigned char* stg = lds + (MODE == 0 ? (wid < 5 ? SHM_K + wid * 4608 : VOFF + SHM_V + (wid - 5) * 4608) : 65536 + wid * 4608);
            LAS unsigned char* stw = stg + (lane_e & 31) * 144 + (lane_e >> 5) * 16;
            const LAS unsigned char* strd = stg + er * 144 + ec * 16;
            bf16* orow = Op + ((size_t)b * SEQ + qlo + er) * DM + h * 128 + 4 * ec;
#define FA_EPI_PASS(ps) do { \
                _Pragma("unroll") for (int g4 = 0; g4 < 4; ++g4) *(LAS f32x4*)(stw + g4 * 32) = (f32x4){o[ps][g4 * 4 + 0] * inv, o[ps][g4 * 4 + 1] * inv, o[ps][g4 * 4 + 2] * inv, o[ps][g4 * 4 + 3] * inv}; \
                _Pragma("unroll") for (int i = 0; i < 4; ++i) { const f32x4 ov = *(const LAS f32x4*)(strd + (8 * i) * 144); const v2u gq_ = gv[(ps) * 4 + i]; \
                    const float g0 = bf_lo(gq_.x), g1 = bf_hi(gq_.x), g2 = bf_lo(gq_.y), g3 = bf_hi(gq_.y); \
                    const float y0 = ov.x * g0 * __builtin_amdgcn_rcpf(1.f + ex2(-1.4426950408889634f * g0)), y1 = ov.y * g1 * __builtin_amdgcn_rcpf(1.f + ex2(-1.4426950408889634f * g1)); \
                    const float y2 = ov.z * g2 * __builtin_amdgcn_rcpf(1.f + ex2(-1.4426950408889634f * g2)), y3 = ov.w * g3 * __builtin_amdgcn_rcpf(1.f + ex2(-1.4426950408889634f * g3)); \
                    v2u w; w.x = cvtpk(y0, y1); w.y = cvtpk(y2, y3); *(GAS v2u*)(orow + (size_t)(8 * i) * DM + 32 * (ps)) = w; } \
                asm volatile("" ::: "memory"); } while (0)
            FA_EPI_PASS(0); FA_LOAD_SK(); FA_LOAD_CS(); FA_EPI_PASS(1); FA_EPI_PASS(2); FA_EPI_PASS(3);
        } else { FA_LOAD_SK(); FA_LOAD_CS(); }
        asm volatile("" ::: "memory");
        if (has_next) {
            if (MODE == 0 && ((u + 1) & 1) == 0) {
                LAS float* rkl = (LAS float*)(lds + RKOFF);
#pragma unroll
                for (int i = 0; i < 4; ++i) rkl[tid + 512 * i] = 1.f / sqrtf((((skv[i].x + skv[i].y) + (skv[i].z + skv[i].w)) + spv[i]) * (1.f / QKD) + EPS); }
            asm volatile("" ::: "memory");
            if (MODE == 0) {
                if (u < 0) asm volatile("s_waitcnt lgkmcnt(0)\n\ts_barrier" ::: "memory");
                float ss = 0.f;
#pragma unroll
                for (int d0 = 0; d0 < ND; ++d0) { float f[8]; unpack8(__builtin_bit_cast(v4u, qr[d0]), f);
#pragma unroll
                    for (int e = 0; e < 8; ++e) ss += f[e] * f[e]; }
                { auto rr = __builtin_amdgcn_permlane32_swap(__float_as_uint(ss), __float_as_uint(ss), false, false); ss = __uint_as_float(rr[0]) + __uint_as_float(rr[1]); }
                const float rq = Q_SCALE_MLA / sqrtf(ss * (1.f / QKD) + EPS);
                const int hi_e = lane_e >> 5; LAS unsigned char* qrl = lds + FA_QRBASE + lane_e * 16;
#pragma unroll
                for (int d0 = 0; d0 < 8; ++d0) { float f[8]; unpack8(__builtin_bit_cast(v4u, qr[d0]), f); const int dd = d0 * 16 + hi_e * 8;
                    const f32x4 a0 = *(const LAS f32x4*)(gtl + dd), a1 = *(const LAS f32x4*)(gtl + dd + 4);
                    f[0] *= rq * a0.x; f[1] *= rq * a0.y; f[2] *= rq * a0.z; f[3] *= rq * a0.w; f[4] *= rq * a1.x; f[5] *= rq * a1.y; f[6] *= rq * a1.z; f[7] *= rq * a1.w;
                    qr[d0] = __builtin_bit_cast(bf16x8, pack8(f)); }
                if (NDR < 8) *(LAS bf16x8*)(qrl + 4 * 1024) = qr[7];
#pragma unroll
                for (int dd = 0; dd < 2; ++dd) { float x1[8], x2[8], o1[8], o2[8]; unpack8(__builtin_bit_cast(v4u, qr[8 + dd]), x1); unpack8(__builtin_bit_cast(v4u, qr[10 + dd]), x2);
                    const int ri = dd * 16 + hi_e * 8;
                    const f32x4 ga0 = *(const LAS f32x4*)(gtl + 128 + ri), ga1 = *(const LAS f32x4*)(gtl + 128 + ri + 4), gb0 = *(const LAS f32x4*)(gtl + 160 + ri), gb1 = *(const LAS f32x4*)(gtl + 160 + ri + 4);
                    const f32x4 c0 = csv[dd * 4 + 0], c1 = csv[dd * 4 + 1], s0 = csv[dd * 4 + 2], s1 = csv[dd * 4 + 3];
                    const float gA[8] = {ga0.x, ga0.y, ga0.z, ga0.w, ga1.x, ga1.y, ga1.z, ga1.w}, gB[8] = {gb0.x, gb0.y, gb0.z, gb0.w, gb1.x, gb1.y, gb1.z, gb1.w};
                    const float cs[8] = {c0.x, c0.y, c0.z, c0.w, c1.x, c1.y, c1.z, c1.w}, sn[8] = {s0.x, s0.y, s0.z, s0.w, s1.x, s1.y, s1.z, s1.w};
#pragma unroll
                    for (int e = 0; e < 8; ++e) { const float a = x1[e] * gA[e], bq = x2[e] * gB[e]; o1[e] = (a * cs[e] - bq * sn[e]) * rq; o2[e] = (a * sn[e] + bq * cs[e]) * rq; }
                    *(LAS bf16x8*)(qrl + dd * 1024) = __builtin_bit_cast(bf16x8, pack8(o1)); *(LAS bf16x8*)(qrl + (2 + dd) * 1024) = __builtin_bit_cast(bf16x8, pack8(o2)); }
            }
            b = b2; h = h2; qlo = qlo2; NT = NT2; jmax = (qlo2 + 31) >> 6; Kh = Kh2; Vh = Vh2; KRh = KRh2;
#pragma unroll
            for (int d0 = 0; d0 < 4; ++d0) o[d0] = f32x16{};
            m_reg = -1e30f; l_reg = 0.f; carry = 0.f; wdone = false; ebank = ecnt + (un & 1) * 32;
            FA_STAMP(6);
            if (u >= 0) asm volatile("s_waitcnt vmcnt(12) lgkmcnt(0)\n\ts_barrier" ::: "memory");
            else FA_WAITBAR();
            FA_STAMP(5);
            if (MODE == 1) { if (tid < 32) ecnt[((un + 1) & 1) * 32 + tid] = 0u; ++un; }
        }
    }
#undef FA_UNIT
#undef FA_LOAD_CS
#undef FA_LOAD_G
#undef FA_LOAD_SK
#undef FA_EPI_PASS
#undef FA_DMA_OFFS
#undef FA_DMA_GO
#undef FA_WAITBAR
#undef FA_TRRD
#undef FA_PV_D0
#undef FA_STEP
#undef FA_STEP2
#undef FA_STEP3
#undef FA_EXPSLOT
#undef FA_MF
#undef FA_PV_D0I
#undef FA_SM3
#undef FA_PV3
#undef FA_QK2
#undef FA_SMPV2
#undef FA_QRBASE
#undef FA_S1
#undef FA_S2
#undef FA_SLOT_END
#undef FA_DMA_K
#undef FA_DMA_V
#undef FA_STAMP
}
}
struct Args { const float* in[13]; float* out; unsigned char* ws; int ph_lo, ph_hi; };
__global__ void __launch_bounds__(NWAVES * 64, 2) hybrid_fwd(Args args) {
    extern __shared__ __attribute__((aligned(16))) unsigned char lds_raw[];
    LAS unsigned char* lds = (LAS unsigned char*)lds_raw;
    volatile LAS unsigned* MISC = (volatile LAS unsigned*)(lds + MISC_OFF);
    const int tid = threadIdx.x, lane = tid & 63, wave = __builtin_amdgcn_readfirstlane(tid >> 6);
    const int G = gridDim.x, bx = blockIdx.x;
    const int vcu = (G % 8 == 0) ? (bx % 8) * (G / 8) + bx / 8 : bx;
    const int gw = vcu * NWAVES + wave, NGW = G * NWAVES;
    unsigned char* ws = args.ws;
    gu32* ctl = (gu32*)(ws + WS_CTL);
    for (int u = tid; u < (LDS_BYTES - LDSCTL_OFF) / 4; u += NWAVES * 64) ((LAS unsigned*)(lds + LDSCTL_OFF))[u] = 0u;
    __syncthreads();
#if MK_ONE_LAUNCH
    XcdBarrier bar = xcd_barrier_post((unsigned*)(ctl + CW_BAR), MISC + 8);
#if PROBE_BAR
#define GRID_BAR(kk) do { const unsigned tb0_ = (unsigned)__builtin_amdgcn_s_memtime(); xcd_barrier(bar); if ((PROBE_BARMASK >> (kk)) & 1u) tacc += (unsigned)__builtin_amdgcn_s_memtime() - tb0_; } while (0)
#else
#define GRID_BAR(kk) xcd_barrier(bar)
#endif
#else
    (void)MISC; (void)ctl;
#define GRID_BAR(kk) do { } while (0)
#endif
    const int lo = args.ph_lo, hi = args.ph_hi;
    P1Fill fill{args.in, ws, ctl + CW_P0Q, (LAS float*)(lds + RING_OFF + wave * 16384), 0, P1_CHUNK};
    unsigned tacc = 0;
#define IN(k) (lo <= (k) && (k) < hi)
#define SEAM(k) do { if (IN(k) && IN((k) + 1)) GRID_BAR(k); } while (0)
#if MK_ONE_LAUNCH
#if PROBE_BAR
#define SEAM_FILL(k) do { if (IN(k) && IN((k) + 1)) { const unsigned tb0_ = (unsigned)__builtin_amdgcn_s_memtime(); xcd_barrier_fill(bar, fill, wave, lane); if (PROBE_BAR == 1 && ((PROBE_BARMASK >> (k)) & 1u)) tacc += (unsigned)__builtin_amdgcn_s_memtime() - tb0_; } } while (0)
#else
#define SEAM_FILL(k) do { if (IN(k) && IN((k) + 1)) { xcd_barrier_fill(bar, fill, wave, lane); if (PROBE_BAR2) { xcd_barrier(bar); } } } while (0)
#endif
#else
#define SEAM_FILL(k) SEAM(k)
#endif
#define DRAIN(k, limit) do { if (IN(k)) { const unsigned td0_ = PROBE_BAR == 2 ? (unsigned)__builtin_amdgcn_s_memtime() : 0u; __syncthreads(); while (fill.item(lane, (limit))) { } if (PROBE_BAR == 2 && ((PROBE_BARMASK >> (k)) & 1u)) tacc += (unsigned)__builtin_amdgcn_s_memtime() - td0_; } } while (0)
    const float* x_in = args.in[0]; float* out = args.out;
    float* ropec = (float*)(ws + WS_ROPE); float* ropes = ropec + SEQ * 32;
    bf16* XB = (bf16*)(ws + A_XN); bf16* XLO = (bf16*)(ws + A_XLO); bf16* PROJ = (bf16*)(ws + A_PROJ);
    bf16* QLAT = (bf16*)(ws + A_QN); bf16* KVLAT = (bf16*)(ws + A_KVN); bf16* QRAW = (bf16*)(ws + A_QRAW); bf16* KVRAW = (bf16*)(ws + A_KVRAW); bf16* OG = (bf16*)(ws + A_OG);
    bf16* KPER = (bf16*)(ws + A_KPER); float* SSPE = (float*)(ws + A_SSPE); float* SSKP = (float*)(ws + A_SSKP);
    unsigned long long* SSX = (unsigned long long*)(ws + WS_SS);
    unsigned long long* SSQ = SSX + 4 * M; unsigned long long* SSKV = SSX + 6 * M;

    if (IN(0)) {
        LAS float* scr = (LAS float*)(lds + RING_OFF + wave * 16384);
        x_to_bf16_rows(x_in, XB, XLO, SSX, gw, NGW, lane);
        p0_transpose(args.in[2], DM, MLA_IN, (bf16*)(ws + WS_W + W_IN_MLA), scr, gw, NGW, lane, args.in[1]);
        { GAS v4u* pad = (GAS v4u*)(ws + WS_W + W_IN_MLA + (size_t)MLA_IN * DM * 2);
          for (int i = vcu * 512 + tid; i < (MLA_INP - MLA_IN) * DM * 2 / 16; i += G * 512) pad[i] = (v4u){0u, 0u, 0u, 0u}; }
        { GAS v4u* pad1 = (GAS v4u*)(ws + WS_W + W_LAYER + W_IN_MLA + (size_t)MLA_IN * DM * 2);
          for (int i = vcu * 512 + tid; i < (MLA_INP - MLA_IN) * DM * 2 / 16; i += G * 512) pad1[i] = (v4u){0u, 0u, 0u, 0u}; }
        for (int i = vcu * 512 + tid; i < SEQ * 32; i += G * 512) { const int pos = i >> 5, p = i & 31;
            const float inv = 1.0f / powf(10000.0f, (float)(2 * p) / 64.0f), ang = (float)pos * inv; ropec[i] = cosf(ang); ropes[i] = sinf(ang); }
    }
    SEAM_FILL(0);

    for (int L = 0; L < 2; ++L) {
        const int pb = 1 + 7 * L;
        unsigned char* wl = ws + WS_W + (size_t)L * W_LAYER;
        if (IN(pb + 0)) { pg8::Gemm g{XB, (const bf16*)(wl + W_IN_MLA), M, MLA_INP, DM, DM}; pg8::StaticOrder S; S.init(M, MLA_INP, G, bx);
            PG8_LAS float* rst = (PG8_LAS float*)(lds + LDSCTL_OFF + 2048);
            pg8::rstd_table_fill(rst, SSX + (size_t)(2 * L) * M, 1.f / DM, S, tid); pg8::EpiBf16S<1> E{PROJ, MLA_INP, rst, SSQ + (size_t)L * M, SSKV + (size_t)L * M, QLAT, KVLAT, nullptr, 0.f};
            pg8::gemm_phase<pg8::EpiBf16S<1>, pg8::StaticOrder, PG8_ALIGN, PG8_SP2>(lds + RING_OFF, g, S, E); }
        DRAIN(pb + 0, L == 0 ? FQ_KV0 : FQ_KV1);
        SEAM_FILL(pb + 0);
        if (IN(pb + 1)) {
            kpe_rows(PROJ, args.in[8] + (size_t)L * QKD, ropec, ropes, KPER, SSPE, gw, NGW, lane);
            { pg8::Gemm g{QLAT, (const bf16*)(wl + W_QB), M, NQ, QL, QL}; pg8::StaticOrder S; S.init(M, NQ, G, bx);
              PG8_LAS float* rst = (PG8_LAS float*)(lds + LDSCTL_OFF + 2048);
              pg8::rstd_table_fill(rst, SSQ + (size_t)L * M, 1.f / QL, S, tid); pg8::EpiBf16S<0> E{QRAW, NQ, rst, nullptr, nullptr, nullptr, nullptr, nullptr, 0.f}; pg8::gemm_phase<pg8::EpiBf16S<0>, pg8::StaticOrder, PG8_ALIGN, PG8_SP2>(lds + RING_OFF, g, S, E, PROBE_SITE == 2 ? &tacc : nullptr); }
            { pg8::Gemm g{KVLAT, (const bf16*)(wl + W_KVB), M, NKV, KVL, KVL}; pg8::StaticOrder S; S.init(M, NKV, G, bx);
              PG8_LAS float* rst = (PG8_LAS float*)(lds + LDSCTL_OFF + 2048);
              pg8::rstd_table_fill(rst, SSKV + (size_t)L * M, 1.f / KVL, S, tid); pg8::EpiKV E{KVRAW, NKV, rst, SSKP, nullptr, 0.f}; pg8::gemm_phase<pg8::EpiKV, pg8::StaticOrder, PG8_ALIGN, PG8_SP2>(lds + RING_OFF, g, S, E, PROBE_SITE == 3 ? &tacc : nullptr); }
        }
        SEAM_FILL(pb + 1);
        if (IN(pb + 2)) { const fa::AttnP P{QRAW, NQ, QKD, KVRAW, NKV, 256, KVRAW + 128, NKV, 256, PROJ + C_GATE, MLA_INP, OG, KPER, SSKP, SSPE, args.in[7] + (size_t)L * QKD, args.in[8] + (size_t)L * QKD, ropec, ropes};
            fa::attn_phase<0>(lds, P, G, vcu, (LAS unsigned*)(lds + LDSCTL_OFF), tacc); }
        DRAIN(pb + 2, L == 0 ? FQ_OM0 : FQ_OM1);
        SEAM_FILL(pb + 2);
        if (IN(pb + 3)) { if (OUTPROJ_STAGGER && (bx & 4)) { const unsigned long long t0_ = __builtin_amdgcn_s_memtime(); while (__builtin_amdgcn_s_memtime() - t0_ < (unsigned long long)OUTPROJ_STAGGER) { if (!fill.item(lane)) break; } __syncthreads(); }     pg8::Gemm g{OG, (const bf16*)(wl + W_OUT_MLA), M, DM, DM, DM}; pg8::StaticOrder S; S.init(M, DM, G, bx);
            pg8::EpiResHL E{XB, XLO, DM, nullptr, SSX + (size_t)(2 * L + 1) * M}; pg8::gemm_phase<pg8::EpiResHL, pg8::StaticOrder, PG8_ALIGN, PG8_SP2>(lds + RING_OFF, g, S, E, PROBE_SITE == 4 ? &tacc : nullptr); }
        DRAIN(pb + 3, L == 0 ? FQ_IS0 : FQ_IS1);
        SEAM_FILL(pb + 3);
        if (IN(pb + 4)) { pg8::Gemm g{XB, (const bf16*)(wl + W_IN_SB), M, SB_IN, DM, DM}; pg8::StaticOrder S; S.init(M, SB_IN, G, bx);
            PG8_LAS float* rst = (PG8_LAS float*)(lds + LDSCTL_OFF + 2048);
            pg8::rstd_table_fill(rst, SSX + (size_t)(2 * L + 1) * M, 1.f / DM, S, tid); pg8::EpiBf16S<0> E{PROJ, SB_IN, rst, nullptr, nullptr, nullptr, nullptr, nullptr, 0.f}; pg8::gemm_phase<pg8::EpiBf16S<0>, pg8::StaticOrder, PG8_ALIGN, PG8_SP2>(lds + RING_OFF, g, S, E, PROBE_SITE == 8 ? &tacc : nullptr); }
        SEAM_FILL(pb + 4);
        if (IN(pb + 5)) { const fa::AttnP P{PROJ, SB_IN, 128, PROJ + C_SBK, SB_IN, 128, PROJ + C_SBV, SB_IN, 128, PROJ + C_SBG, SB_IN, OG, nullptr, nullptr, nullptr, nullptr, nullptr, nullptr, nullptr};
            fa::attn_phase<1>(lds, P, G, vcu, (LAS unsigned*)(lds + LDSCTL_OFF), tacc); }
        DRAIN(pb + 5, L == 0 ? FQ_OS0 : FQ_OS1);
        SEAM_FILL(pb + 5);
        if (IN(pb + 6)) { if (OUTPROJ_STAGGER && (bx & 4)) { const unsigned long long t0_ = __builtin_amdgcn_s_memtime(); while (__builtin_amdgcn_s_memtime() - t0_ < (unsigned long long)OUTPROJ_STAGGER) { if (!fill.item(lane)) break; } __syncthreads(); }     pg8::Gemm g{OG, (const bf16*)(wl + W_OUT_SB), M, DM, DM, DM}; pg8::StaticOrder S; S.init(M, DM, G, bx);
            pg8::EpiResHL E{XB, XLO, DM, (L == 0) ? (float*)nullptr : out, SSX + (size_t)2 * M}; pg8::gemm_phase<pg8::EpiResHL, pg8::StaticOrder, PG8_ALIGN, PG8_SP2>(lds + RING_OFF, g, S, E); }
        DRAIN(pb + 6, L == 0 ? FQ_IM1 : FQ_ITEMS);
        SEAM_FILL(pb + 6);
    }
#if PROBE_SEG || PROBE_GEMM || PROBE_BAR
    if (bx == PROBE_BLOCK && wave == 0) { const unsigned long long t0 = __builtin_amdgcn_s_memrealtime(), want = (unsigned long long)(tacc >> PROBE_SHIFT); while (__builtin_amdgcn_s_memrealtime() - t0 < want) __builtin_amdgcn_s_sleep(8); }
#endif
#undef IN
#undef SEAM
}

extern "C" void kernel_launch(void* const* d_in, const int* in_sizes, int n_in, void* d_out, int out_size, void* d_ws, size_t ws_size, hipStream_t stream) {
    static int grid = 0;
    if (grid == 0) {
        if (n_in != 13 || in_sizes[0] != M * DM || out_size != M * DM || ws_size < WS_END) { fprintf(stderr, "kernel_launch: unexpected shapes (n_in %d, in0 %d, out %d, ws %zu; need ws >= %zu); nothing launched\n", n_in, n_in > 0 ? in_sizes[0] : -1, out_size, ws_size, (size_t)WS_END); grid = -1; return; }
        int dev = 0, cus = 0, per_cu = 0;
        if (hipGetDevice(&dev) != hipSuccess || hipDeviceGetAttribute(&cus, hipDeviceAttributeMultiprocessorCount, dev) != hipSuccess) { fprintf(stderr, "kernel_launch: device query failed\n"); grid = -1; return; }
        if (hipFuncSetAttribute((const void*)hybrid_fwd, hipFuncAttributeMaxDynamicSharedMemorySize, LDS_BYTES) != hipSuccess) { fprintf(stderr, "kernel_launch: hipFuncSetAttribute failed\n"); grid = -1; return; }
        if (hipOccupancyMaxActiveBlocksPerMultiprocessor(&per_cu, (const void*)hybrid_fwd, NWAVES * 64, LDS_BYTES) != hipSuccess || per_cu < 1)
            fprintf(stderr, "kernel_launch: note: occupancy query reports %d workgroups per CU\n", per_cu);
        (void)hipGetLastError();
        grid = cus;
    }
    if (grid < 0) return;
    if (hipMemsetAsync((char*)d_ws + WS_CTL, 0, CTL_ZERO_BYTES, stream) != hipSuccess) { fprintf(stderr, "kernel_launch: memset failed\n"); return; }
    Args a{};
    for (int i = 0; i < 13; ++i) a.in[i] = (const float*)d_in[i];
    a.out = (float*)d_out; a.ws = (unsigned char*)d_ws;
#if MK_ONE_LAUNCH
    a.ph_lo = 0; a.ph_hi = N_PHASES;
    hipLaunchKernelGGL(hybrid_fwd, dim3(grid), dim3(NWAVES * 64), LDS_BYTES, stream, a);
#ifdef PROBE_PHASES
    { static const int probe_ph[] = {PROBE_PHASES};
      for (int r = 0; r < PROBE_NREP; ++r) for (int ph : probe_ph) { a.ph_lo = ph; a.ph_hi = ph + 1; hipLaunchKernelGGL(hybrid_fwd, dim3(grid), dim3(NWAVES * 64), LDS_BYTES, stream, a); } }
#endif
#else
    for (int ph = 0; ph < N_PHASES; ++ph) { a.ph_lo = ph; a.ph_hi = ph + 1; hipLaunchKernelGGL(hybrid_fwd, dim3(grid), dim3(NWAVES * 64), LDS_BYTES, stream, a); }
#endif
    const hipError_t le = hipPeekAtLastError();
    if (le != hipSuccess) fprintf(stderr, "kernel_launch: launch failed: %s\n", hipGetErrorName(le));
}
```

```cpp
#include <hip/hip_runtime.h>
#include <cstdio>
#include <cstdint>
#ifndef PROBE_GEMM
#define PROBE_GEMM 0
#endif
#ifndef PG8_POSTEPI
#define PG8_POSTEPI 0
#endif
namespace pg8 {
#define PG8_LAS __attribute__((address_space(3)))
typedef unsigned short bf16_t;
typedef short bf16x8 __attribute__((ext_vector_type(8)));
typedef float f32x4 __attribute__((ext_vector_type(4)));

#ifndef PG8_WT
#define PG8_WT 0
#endif
typedef unsigned u32x4 __attribute__((ext_vector_type(4)));
__device__ __forceinline__ void st16_wt(void* p, u32x4 v) {
#if PG8_WT
    asm volatile("global_store_dwordx4 %0, %1, off sc1\n\ts_nop 1" :: "v"(p), "v"(v));
#else
    *(u32x4*)p = v;
#endif
}
constexpr int BM = 256, BK = 64, HALF = 128, HTB = HALF * BK * 2  , STAGE_BYTES = 8 * HTB, NXCD = 8, WGM = 8;

__host__ __device__ __forceinline__ int lds_byte(int r, int c) { const int st = (r >> 4) * 2 + (c >> 5), rr = r & 15, cc = c & 31, ob = rr * 64 + cc * 2; return st * 1024 + (ob ^ (((ob >> 9) & 1) << 5)); }
__host__ __device__ __forceinline__ void stage_rc(int b, int& R, int& C) { const int st = b / 1024, sb = b % 1024, swz = sb ^ (((sb >> 9) & 1) << 5); R = (st >> 1) * 16 + swz / 64; C = (st & 1) * 32 + (swz % 64) / 2; }
__host__ __device__ __forceinline__ int perm32(int rho) { const int n = rho >> 4, i = rho & 15; return 8 * (i >> 2) + 4 * n + (i & 3); }

struct Unit { int pm, pn; };
struct Gemm { const bf16_t* A; const bf16_t* Bt; int M, N, K, lda; };

struct StaticOrder {
    int nM, nN, nwg, G, c;
    __host__ __device__ void init(int M, int N, int G_, int c_) { nM = M / BM; nN = N / BM; nwg = nM * nN; G = G_; c = c_; }
    __host__ __device__ bool next(int i, Unit& u) const {
        const long L = (long)i * G + c; if (L >= nwg) return false;
        int wgid = (int)L; { const int q = nwg / NXCD, r = nwg % NXCD, xcd = wgid % NXCD, off = wgid / NXCD; wgid = (xcd < r ? xcd * (q + 1) : r * (q + 1) + (xcd - r) * q) + off; }
        const int nig = WGM * nN, gid = wgid / nig, fm = gid * WGM, gsz = (nM - fm) < WGM ? (nM - fm) : WGM;
        u.pm = fm + ((wgid % nig) % gsz); u.pn = (wgid % nig) / gsz; return true;
    }
    __device__ __forceinline__ void a_ready(const Unit&) const {}
    __device__ __forceinline__ void done(const Unit&) const {}
};

__device__ __forceinline__ unsigned cvt_pk_bf16(float lo, float hi) { unsigned r; asm volatile("v_cvt_pk_bf16_f32 %0, %1, %2" : "=v"(r) : "v"(lo), "v"(hi)); return r; }
struct EpiBf16 {
    static constexpr bool PERM = true, AFTER_DRAIN = false; static constexpr bool HAS_TABLE = false; static constexpr int NST = 0;
    bf16_t* O; int ldc;
    __device__ __forceinline__ void operator()(const f32x4 (&acc)[2][2][4][2], const Unit& u, int wr, int wc, int fr, int fq, int ui) const {
        const int row0 = u.pm * BM + wr * 64 + fr; const int col0 = u.pn * BM + wc * 32 + 8 * fq;
#pragma unroll
        for (int ai = 0; ai < 2; ++ai)
#pragma unroll
            for (int m = 0; m < 4; ++m) { bf16_t* rowp = O + (size_t)(row0 + ai * HALF + m * 16) * ldc + col0;
#pragma unroll
                for (int bj = 0; bj < 2; ++bj) { const f32x4 v0 = acc[ai][bj][m][0], v1 = acc[ai][bj][m][1];
                    u32x4 w; w.x = cvt_pk_bf16(v0[0], v0[1]); w.y = cvt_pk_bf16(v0[2], v0[3]); w.z = cvt_pk_bf16(v1[0], v1[1]); w.w = cvt_pk_bf16(v1[2], v1[3]);
                    *(u32x4*)(rowp + bj * HALF) = w; } }
    }
};
struct EpiResF32 {
    static constexpr bool PERM = true, AFTER_DRAIN = false; static constexpr bool HAS_TABLE = false; static constexpr int NST = 0;
    const float* base; float* out; int ldc;
    __device__ __forceinline__ void operator()(const f32x4 (&acc)[2][2][4][2], const Unit& u, int wr, int wc, int fr, int fq, int ui) const {
        const int row0 = u.pm * BM + wr * 64 + fr; const int col0 = u.pn * BM + wc * 32 + 8 * fq;
#pragma unroll
        for (int ai = 0; ai < 2; ++ai)
#pragma unroll
            for (int m = 0; m < 4; ++m) { const size_t off = (size_t)(row0 + ai * HALF + m * 16) * ldc + col0;
#pragma unroll
                for (int bj = 0; bj < 2; ++bj) {
                    const f32x4 b0 = *(const f32x4*)(base + off + bj * HALF), b1 = *(const f32x4*)(base + off + bj * HALF + 4);
                    *(f32x4*)(out + off + bj * HALF) = b0 + acc[ai][bj][m][0]; *(f32x4*)(out + off + bj * HALF + 4) = b1 + acc[ai][bj][m][1]; } }
    }
};

constexpr float SS_FIX = 1048576.f, SS_UNFIX = 1.f / 1048576.f;
__device__ __forceinline__ float rstd_of(const unsigned long long* ss, int row, float inv_n) { return 1.f / sqrtf((float)ss[row] * (SS_UNFIX * inv_n) + 1e-6f); }
__device__ __forceinline__ void ss_add(unsigned long long* ss, int row, float part, int fq) {
    part += __shfl_xor(part, 16); part += __shfl_xor(part, 32);
    if (fq == 0) atomicAdd(ss + row, (unsigned long long)(part * SS_FIX));
}
__device__ __forceinline__ void rstd_table_fill(PG8_LAS float* rst, const unsigned long long* ss, float inv_n, const StaticOrder& S, int tid) {
    int tl = tid; asm volatile("" : "+v"(tl));
    const int half = __builtin_amdgcn_readfirstlane(tl >> 8), r = tl & (BM - 1);
    for (int i0 = 0; ; i0 += 8) {
        Unit u; unsigned long long raw[4]; bool ok[4];
#pragma unroll
        for (int k = 0; k < 4; ++k) { ok[k] = S.next(i0 + 2 * k + half, u); raw[k] = ok[k] ? ss[u.pm * BM + r] : 0ull; }
#pragma unroll
        for (int k = 0; k < 4; ++k) if (ok[k]) rst[(i0 + 2 * k + half) * BM + r] = 1.f / sqrtf((float)raw[k] * (SS_UNFIX * inv_n) + 1e-6f);
        if (!ok[3]) break;
    }
    asm volatile("s_waitcnt vmcnt(0) lgkmcnt(0)\n\ts_barrier" ::: "memory");
}
template <int SSMODE> struct EpiBf16S {
    static constexpr bool PERM = true, AFTER_DRAIN = false; static constexpr bool HAS_TABLE = true; static constexpr int NST = 16;
    bf16_t* O; int ldc; const PG8_LAS float* rst; unsigned long long* ss1; unsigned long long* ss2; bf16_t* O1; bf16_t* O2; const unsigned long long* ssin; float inv_n;
    __device__ __forceinline__ void operator()(const f32x4 (&acc)[2][2][4][2], const Unit& u, int wr, int wc, int fr, int fq, int ui) const {
        const int row0 = u.pm * BM + wr * 64 + fr; int col0 = u.pn * BM + wc * 32 + 8 * fq;
        bf16_t* Ob = O; int ld = ldc;
        if (SSMODE == 1) { if (u.pn < 4) { Ob = O1; ld = 1024; } else if (u.pn < 6) { Ob = O2; ld = 512; col0 -= 1024; } }
#pragma unroll
        for (int ai = 0; ai < 2; ++ai)
#pragma unroll
            for (int m = 0; m < 4; ++m) { const int row = row0 + ai * HALF + m * 16; const float rs = rst[ui * BM + (row - u.pm * BM)]; bf16_t* rowp = Ob + (size_t)row * ld + col0; float part = 0.f;
#pragma unroll
                for (int bj = 0; bj < 2; ++bj) { const f32x4 v0 = acc[ai][bj][m][0] * rs, v1 = acc[ai][bj][m][1] * rs;
                    if (SSMODE == 1) part += (v0[0] * v0[0] + v0[1] * v0[1]) + (v0[2] * v0[2] + v0[3] * v0[3]) + (v1[0] * v1[0] + v1[1] * v1[1]) + (v1[2] * v1[2] + v1[3] * v1[3]);
                    u32x4 w; w.x = cvt_pk_bf16(v0[0], v0[1]); w.y = cvt_pk_bf16(v0[2], v0[3]); w.z = cvt_pk_bf16(v1[0], v1[1]); w.w = cvt_pk_bf16(v1[2], v1[3]);
                    st16_wt(rowp + bj * HALF, w); }
                if (SSMODE == 1) { if (u.pn < 6) ss_add(u.pn < 4 ? ss1 : ss2, row, part, fq); } }
    }
};
struct EpiResHL {
    static constexpr bool PERM = true, AFTER_DRAIN = false; static constexpr bool HAS_TABLE = false; static constexpr int NST = 48;
    bf16_t* hi; bf16_t* lo; int ldc; float* outf; unsigned long long* ss;
    static __device__ __forceinline__ float blo_(unsigned w) { return __uint_as_float(w << 16); }
    static __device__ __forceinline__ float bhi_(unsigned w) { return __uint_as_float(w & 0xffff0000u); }
    __device__ __forceinline__ void operator()(f32x4 (&acc)[2][2][4][2], const Unit& u, int wr, int wc, int fr, int fq, int ui) const {
        const int row0 = u.pm * BM + wr * 64 + fr; const int col0 = u.pn * BM + wc * 32 + 8 * fq;
        u32x4 ph[2][2], pl[2][2];
#define ERX_LOAD(ai, mh) do { _Pragma("unroll") for (int m2 = 0; m2 < 2; ++m2) { const size_t off = (size_t)(row0 + (ai) * HALF + (2 * (mh) + m2) * 16) * ldc + col0; \
            _Pragma("unroll") for (int bj = 0; bj < 2; ++bj) { ph[m2][bj] = *(const u32x4*)(hi + off + bj * HALF); pl[m2][bj] = *(const u32x4*)(lo + off + bj * HALF); } } asm volatile("" ::: "memory"); } while (0)
#define ERX_SUM(ai, mh) do { _Pragma("unroll") for (int m2 = 0; m2 < 2; ++m2) _Pragma("unroll") for (int bj = 0; bj < 2; ++bj) { const u32x4 h_ = ph[m2][bj], l_ = pl[m2][bj]; \
            acc[ai][bj][2 * (mh) + m2][0] += (f32x4){blo_(h_.x) + blo_(l_.x), bhi_(h_.x) + bhi_(l_.x), blo_(h_.y) + blo_(l_.y), bhi_(h_.y) + bhi_(l_.y)}; \
            acc[ai][bj][2 * (mh) + m2][1] += (f32x4){blo_(h_.z) + blo_(l_.z), bhi_(h_.z) + bhi_(l_.z), blo_(h_.w) + blo_(l_.w), bhi_(h_.w) + bhi_(l_.w)}; \
            asm volatile("" : "+v"(acc[ai][bj][2 * (mh) + m2][0]), "+v"(acc[ai][bj][2 * (mh) + m2][1])); } } while (0)
#define ERX_STORE(ai, mh) do { _Pragma("unroll") for (int m2 = 0; m2 < 2; ++m2) { const int m = 2 * (mh) + m2; const int row = row0 + (ai) * HALF + m * 16; const size_t off = (size_t)row * ldc + col0; float part = 0.f; \
            _Pragma("unroll") for (int bj = 0; bj < 2; ++bj) { const f32x4 o0 = acc[ai][bj][m][0], o1 = acc[ai][bj][m][1]; \
                if (outf) { st16_wt(outf + off + bj * HALF, __builtin_bit_cast(u32x4, o0)); st16_wt(outf + off + bj * HALF + 4, __builtin_bit_cast(u32x4, o1)); } \
                else { part += (o0[0] * o0[0] + o0[1] * o0[1]) + (o0[2] * o0[2] + o0[3] * o0[3]) + (o1[0] * o1[0] + o1[1] * o1[1]) + (o1[2] * o1[2] + o1[3] * o1[3]); \
                    u32x4 w; w.x = cvt_pk_bf16(o0[0], o0[1]); w.y = cvt_pk_bf16(o0[2], o0[3]); w.z = cvt_pk_bf16(o1[0], o1[1]); w.w = cvt_pk_bf16(o1[2], o1[3]); \
                    u32x4 r; r.x = cvt_pk_bf16(o0[0] - blo_(w.x), o0[1] - bhi_(w.x)); r.y = cvt_pk_bf16(o0[2] - blo_(w.y), o0[3] - bhi_(w.y)); r.z = cvt_pk_bf16(o1[0] - blo_(w.z), o1[1] - bhi_(w.z)); r.w = cvt_pk_bf16(o1[2] - blo_(w.w), o1[3] - bhi_(w.w)); \
                    st16_wt(hi + off + bj * HALF, w); st16_wt(lo + off + bj * HALF, r); } } \
            if (!outf) ss_add(ss, row, part, fq); } asm volatile("" ::: "memory"); } while (0)
        ERX_LOAD(0, 0); ERX_SUM(0, 0); ERX_LOAD(0, 1); ERX_STORE(0, 0); ERX_SUM(0, 1); ERX_LOAD(1, 0); ERX_STORE(0, 1); ERX_SUM(1, 0); ERX_LOAD(1, 1); ERX_STORE(1, 0); ERX_SUM(1, 1); ERX_STORE(1, 1);
#undef ERX_LOAD
#undef ERX_SUM
#undef ERX_STORE
    }
};
struct EpiKV {
    static constexpr bool PERM = true, AFTER_DRAIN = false; static constexpr bool HAS_TABLE = true; static constexpr int NST = 16;
    bf16_t* O; int ldc; const PG8_LAS float* rst; float* sskp; const unsigned long long* ssin; float inv_n;
    __device__ __forceinline__ void operator()(const f32x4 (&acc)[2][2][4][2], const Unit& u, int wr, int wc, int fr, int fq, int ui) const {
        const int row0 = u.pm * BM + wr * 64 + fr; const int col0 = u.pn * BM + wc * 32 + 8 * fq;
#pragma unroll
        for (int ai = 0; ai < 2; ++ai)
#pragma unroll
            for (int m = 0; m < 4; ++m) { const int row = row0 + ai * HALF + m * 16; const float rs = rst[ui * BM + (row - u.pm * BM)]; bf16_t* rowp = O + (size_t)row * ldc + col0; float part = 0.f;
#pragma unroll
                for (int bj = 0; bj < 2; ++bj) { const f32x4 v0 = acc[ai][bj][m][0] * rs, v1 = acc[ai][bj][m][1] * rs;
                    if (bj == 0) part = (v0[0] * v0[0] + v0[1] * v0[1]) + (v0[2] * v0[2] + v0[3] * v0[3]) + (v1[0] * v1[0] + v1[1] * v1[1]) + (v1[2] * v1[2] + v1[3] * v1[3]);
                    u32x4 w; w.x = cvt_pk_bf16(v0[0], v0[1]); w.y = cvt_pk_bf16(v0[2], v0[3]); w.z = cvt_pk_bf16(v1[0], v1[1]); w.w = cvt_pk_bf16(v1[2], v1[3]);
                    st16_wt(rowp + bj * HALF, w); }
                part += __shfl_xor(part, 16); part += __shfl_xor(part, 32);
                if (fq == 0) sskp[((size_t)row * 32 + u.pn) * 4 + wc] = part; }
    }
};

template <class Epi, class Sched, bool ALIGN_EPI = false, bool SP2 = false>
__device__ __forceinline__ void gemm_phase(PG8_LAS unsigned char* lds, const Gemm g, const Sched& S, const Epi& E, unsigned* tp = nullptr) {
#if PROBE_GEMM
    const unsigned tg0 = (unsigned)__builtin_amdgcn_s_memtime(); unsigned tgk = 0;
#endif
    int tid_l = threadIdx.x; asm volatile("" : "+v"(tid_l));
    const int tid = tid_l, wid = __builtin_amdgcn_readfirstlane(tid >> 6), lane = tid & 63, wr = wid >> 2, wc = wid & 3, fr = lane & 15, fq = lane >> 4;
    const int K = g.K, nt = K / BK;
    unsigned voffA[2], voffB[2];
#pragma unroll
    for (int i = 0; i < 2; ++i) { int R, C; stage_rc(tid * 16 + i * 8192, R, C); const int Rb = Epi::PERM ? ((R & ~31) + perm32(R & 31)) : R;
        voffA[i] = (unsigned)(R * g.lda + C) * 2u; voffB[i] = (unsigned)(Rb * K + C) * 2u; }
    const size_t kstep = (size_t)(BK * 2);
    const size_t hstep = (size_t)HALF * K * 2;
    const size_t tstep = 2 * hstep;
    const size_t hstepA = (size_t)HALF * g.lda * 2, tstepA = 2 * hstepA;
    const unsigned ldsw = (unsigned)wid * 1024u;
    const int aoff = lds_byte(wr * 64 + fr, fq * 8), boff = lds_byte(wc * 32 + fr, fq * 8);
#define PG8_SA(b, h) (((b) * 2 + (h)) * HTB)
#define PG8_SB(b, h) ((4 + (b) * 2 + (h)) * HTB)
#define PG8_STAGE(bufoff, gbase, voff) do { _Pragma("unroll") for (int _i = 0; _i < 2; ++_i) \
        __builtin_amdgcn_global_load_lds((const unsigned*)((const char*)(gbase) + (voff)[_i]), (PG8_LAS unsigned*)(lds + (bufoff) + ldsw + _i * 8192), 16, 0, 0); } while (0)
#define PG8_LDA(dst, b, h) do { _Pragma("unroll") for (int m = 0; m < 4; ++m) _Pragma("unroll") for (int k = 0; k < 2; ++k) dst[m][k] = *(const PG8_LAS bf16x8*)(lds + PG8_SA(b, h) + aoff + m * 2048 + k * 1024); } while (0)
#define PG8_LDB(dst, b, h) do { _Pragma("unroll") for (int n = 0; n < 2; ++n) _Pragma("unroll") for (int k = 0; k < 2; ++k) dst[n][k] = *(const PG8_LAS bf16x8*)(lds + PG8_SB(b, h) + boff + n * 2048 + k * 1024); } while (0)
#define PG8_MMA(ai, bj, At, Bt) do { __builtin_amdgcn_s_setprio(1); _Pragma("unroll") for (int m = 0; m < 4; ++m) _Pragma("unroll") for (int n = 0; n < 2; ++n) _Pragma("unroll") for (int k = 0; k < 2; ++k) \
        acc[ai][bj][m][n] = __builtin_amdgcn_mfma_f32_16x16x32_bf16(Bt[n][k], At[m][k], acc[ai][bj][m][n], 0, 0, 0); __builtin_amdgcn_s_setprio(0); } while (0)
#define PG8_WAIT_V(n) asm volatile("s_waitcnt vmcnt(" #n ")" ::: "memory")
#define PG8_WAIT_L(n) asm volatile("s_waitcnt lgkmcnt(" #n ")" ::: "memory")
#define PG8_WAIT_VP(post_) asm volatile("s_waitcnt vmcnt(%1)\n\ts_cmp_lg_u32 %0, 0\n\ts_cbranch_scc1 .Lpg8post%=\n\ts_waitcnt vmcnt(8)\n.Lpg8post%=:" :: "s"(post_), "n"(8 + Epi::NST) : "memory", "scc")
#define PG8_BAR __builtin_amdgcn_s_barrier()
#define PG8_SCHED __builtin_amdgcn_sched_barrier(0)
    Unit cur, nxt; int ui = 0;
    if (!S.next(0, cur)) return;
    f32x4 acc[2][2][4][2];
#pragma unroll
    for (int a = 0; a < 2; ++a)
#pragma unroll
        for (int b = 0; b < 2; ++b)
#pragma unroll
            for (int m = 0; m < 4; ++m)
#pragma unroll
                for (int n = 0; n < 2; ++n) acc[a][b][m][n] = (f32x4){0.f, 0.f, 0.f, 0.f};
    bf16x8 At[4][2], B0[2][2], B1[2][2];
    const char* cA = (const char*)g.A + (size_t)cur.pm * tstepA; const char* cB = (const char*)g.Bt + (size_t)cur.pn * tstep;
    S.a_ready(cur);
    if constexpr (SP2) {
        PG8_STAGE(PG8_SB(0, 0), cB, voffB); PG8_STAGE(PG8_SB(0, 1), cB + hstep, voffB); PG8_STAGE(PG8_SA(0, 0), cA, voffA); PG8_STAGE(PG8_SA(0, 1), cA + hstepA, voffA);
        if (wr == 1) PG8_BAR;
        PG8_WAIT_V(2); PG8_BAR;
        PG8_STAGE(PG8_SB(1, 0), cB + kstep, voffB); PG8_STAGE(PG8_SA(1, 0), cA + kstep, voffA); PG8_STAGE(PG8_SB(1, 1), cB + hstep + kstep, voffB);
        PG8_WAIT_V(6); PG8_BAR;
        if (PG8_POSTEPI) PG8_STAGE(PG8_SA(1, 1), cA + kstep + hstepA, voffA);
    } else {
        PG8_STAGE(PG8_SB(0, 0), cB, voffB); PG8_STAGE(PG8_SA(0, 0), cA, voffA); PG8_STAGE(PG8_SB(0, 1), cB + hstep, voffB); PG8_STAGE(PG8_SA(0, 1), cA + hstepA, voffA);
        if (wr == 1) PG8_BAR;
        PG8_WAIT_V(4); PG8_BAR;
        PG8_STAGE(PG8_SB(1, 0), cB + kstep, voffB); PG8_STAGE(PG8_SA(1, 0), cA + kstep, voffA); PG8_STAGE(PG8_SB(1, 1), cB + hstep + kstep, voffB);
        PG8_WAIT_V(6); PG8_BAR;
    }
    for (;;) {
        const bool has_next = S.next(ui + 1, nxt);
        const char* nA = has_next ? (const char*)g.A + (size_t)nxt.pm * tstepA : cA; const char* nB = has_next ? (const char*)g.Bt + (size_t)nxt.pn * tstep : cB;
#if PROBE_GEMM
        const unsigned tk0 = (unsigned)__builtin_amdgcn_s_memtime();
#endif
        for (int t = 0; t < nt; t += 2) {
            const bool last = (t == nt - 2);
            const char* a1 = cA + (size_t)(t + 1) * kstep;
            const char* a2 = last ? nA : cA + (size_t)(t + 2) * kstep; const char* b2 = last ? nB : cB + (size_t)(t + 2) * kstep;
            const char* a3 = a2 + kstep; const char* b3 = b2 + kstep;
            if (last && has_next) S.a_ready(nxt);
            if constexpr (SP2) {
            const int post = __builtin_amdgcn_readfirstlane((PG8_POSTEPI && t == 0 && ui > 0) ? 1 : 0);
            PG8_LDB(B0, 0, 0); PG8_LDB(B1, 0, 1); PG8_SCHED; PG8_LDA(At, 0, 0); if (!PG8_POSTEPI) PG8_STAGE(PG8_SA(1, 1), a1 + hstepA, voffA);
            PG8_WAIT_VP(post); PG8_WAIT_L(0); PG8_BAR; PG8_MMA(0, 0, At, B0); PG8_MMA(0, 1, At, B1); PG8_BAR; PG8_SCHED;
            PG8_LDA(At, 0, 1); PG8_STAGE(PG8_SB(0, 0), b2, voffB); PG8_STAGE(PG8_SB(0, 1), b2 + hstep, voffB); PG8_STAGE(PG8_SA(0, 0), a2, voffA);
            PG8_WAIT_VP(post); PG8_WAIT_L(0); PG8_BAR; PG8_MMA(1, 0, At, B0); PG8_MMA(1, 1, At, B1); PG8_BAR; PG8_SCHED;
            PG8_LDB(B0, 1, 0); PG8_LDB(B1, 1, 1); PG8_SCHED; PG8_LDA(At, 1, 0); PG8_STAGE(PG8_SA(0, 1), a2 + hstepA, voffA);
            PG8_WAIT_VP(post); PG8_WAIT_L(0); PG8_BAR; PG8_MMA(0, 0, At, B0); PG8_MMA(0, 1, At, B1); PG8_BAR; PG8_SCHED;
            PG8_LDA(At, 1, 1); PG8_STAGE(PG8_SB(1, 0), b3, voffB); PG8_STAGE(PG8_SB(1, 1), b3 + hstep, voffB); PG8_STAGE(PG8_SA(1, 0), a3, voffA);
            PG8_WAIT_V(8); PG8_WAIT_L(0); PG8_BAR; PG8_MMA(1, 0, At, B0); PG8_MMA(1, 1, At, B1); PG8_BAR; PG8_SCHED;
            if (PG8_POSTEPI) PG8_STAGE(PG8_SA(1, 1), a3 + hstepA, voffA);
            } else {
            PG8_LDB(B0, 0, 0); PG8_SCHED; PG8_LDA(At, 0, 0); PG8_STAGE(PG8_SA(1, 1), a1 + hstepA, voffA);
            PG8_WAIT_L(8); PG8_BAR; PG8_WAIT_L(0); PG8_MMA(0, 0, At, B0); PG8_BAR; PG8_SCHED;
            PG8_LDB(B1, 0, 1); PG8_STAGE(PG8_SB(0, 0), b2, voffB);
            PG8_BAR; PG8_WAIT_L(0); PG8_MMA(0, 1, At, B1); PG8_BAR;
            PG8_LDA(At, 0, 1); PG8_STAGE(PG8_SA(0, 0), a2, voffA);
            PG8_BAR; PG8_WAIT_L(0); PG8_MMA(1, 0, At, B0); PG8_BAR; PG8_SCHED;
            PG8_STAGE(PG8_SB(0, 1), b2 + hstep, voffB);
            PG8_WAIT_V(6); PG8_BAR; PG8_MMA(1, 1, At, B1); PG8_BAR;
            PG8_LDB(B0, 1, 0); PG8_SCHED; PG8_LDA(At, 1, 0); PG8_STAGE(PG8_SA(0, 1), a2 + hstepA, voffA);
            PG8_WAIT_L(8); PG8_BAR; PG8_WAIT_L(0); PG8_MMA(0, 0, At, B0); PG8_BAR; PG8_SCHED;
            PG8_LDB(B1, 1, 1); PG8_STAGE(PG8_SB(1, 0), b3, voffB);
            PG8_BAR; PG8_WAIT_L(0); PG8_MMA(0, 1, At, B1); PG8_BAR;
            PG8_LDA(At, 1, 1); PG8_STAGE(PG8_SA(1, 0), a3, voffA);
            PG8_BAR; PG8_WAIT_L(0); PG8_MMA(1, 0, At, B0); PG8_BAR; PG8_SCHED;
            PG8_STAGE(PG8_SB(1, 1), b3 + hstep, voffB);
            PG8_WAIT_V(6); PG8_BAR; PG8_MMA(1, 1, At, B1); PG8_BAR;
            }
        }
#if PROBE_GEMM
        tgk += (unsigned)__builtin_amdgcn_s_memtime() - tk0;
#endif
        if constexpr (ALIGN_EPI) { if (wr == 0) PG8_BAR; }
        if constexpr (!Epi::AFTER_DRAIN) { E(acc, cur, wr, wc, fr, fq, ui); S.done(cur); }
        if (!has_next) break;
#pragma unroll
        for (int a = 0; a < 2; ++a)
#pragma unroll
            for (int b = 0; b < 2; ++b)
#pragma unroll
                for (int m = 0; m < 4; ++m)
#pragma unroll
                    for (int n = 0; n < 2; ++n) acc[a][b][m][n] = (f32x4){0.f, 0.f, 0.f, 0.f};
        cur = nxt; cA = nA; cB = nB; ++ui;
        if constexpr (ALIGN_EPI) { if (wr == 1) PG8_BAR; }
    }
    PG8_WAIT_V(0);
    if constexpr (!ALIGN_EPI) { if (wr == 0) PG8_BAR; }
    PG8_BAR;
    if constexpr (Epi::AFTER_DRAIN) { E.fused(acc, cur, wr, wc, fr, fq, lds, wid, lane); S.done(cur); }
#if PROBE_GEMM
    if (tp) *tp += (PROBE_GEMM == 1) ? tgk : ((unsigned)__builtin_amdgcn_s_memtime() - tg0);
#endif
#undef PG8_SA
#undef PG8_SB
#undef PG8_STAGE
#undef PG8_LDA
#undef PG8_LDB
#undef PG8_MMA
#undef PG8_WAIT_V
#undef PG8_WAIT_L
#undef PG8_WAIT_VP
#undef PG8_BAR
#undef PG8_SCHED
}
}
#ifndef PG8_SP2
#define PG8_SP2 true
#endif
#ifndef PG8_ALIGN
#define PG8_ALIGN true
#endif

constexpr int NWAVES = 8;
#ifndef MK_ONE_LAUNCH
#define MK_ONE_LAUNCH 1
#endif

#define PROBE_NREP 2
#define PROBE_SEG 0
#define PROBE_BAR 0
#define PROBE_BLOCK 0
#define PROBE_BAR2 0
#define PROBE_BARMASK 0x7fffu
#define PROBE_SITE 8
#define PROBE_MODE 0
#define PROBE_SHIFT 0
constexpr int M = 8192, DM = 4096, SEQ = 2048, NH = 32;
constexpr int MLA_IN = 5696, MLA_INP = 5888, QL = 1024, KVL = 512, QKD = 192, NQ = NH * QKD, NKV = NH * 256;
constexpr int C_KVLAT = 1024, C_KPE = 1536, C_GATE = 1600;
constexpr int SB_IN = 16384, C_SBK = 4096, C_SBV = 8192, C_SBG = 12288;
constexpr float EPS = 1e-6f;
constexpr float Q_SCALE_MLA = 0.07216878364870323f * 1.4426950408889634f;
constexpr float Q_SCALE_SB = 0.08838834764831845f * 1.4426950408889634f;
constexpr int N_PHASES = 15;
#ifndef OUTPROJ_STAGGER
#define OUTPROJ_STAGGER 0
#endif

constexpr size_t MiB = 1u << 20;
constexpr size_t WS_CTL = 0, CTL_ZERO_BYTES = 1 * MiB;
constexpr size_t WS_ROPE = 1 * MiB;
constexpr size_t WS_W = 2 * MiB, W_LAYER = 258 * MiB;
constexpr size_t W_IN_MLA = 0, W_QB = 46 * MiB, W_KVB = 58 * MiB, W_OUT_MLA = 66 * MiB, W_IN_SB = 98 * MiB, W_OUT_SB = 226 * MiB;
constexpr size_t WS_ACT = WS_W + 2 * W_LAYER;
constexpr size_t A_XN = WS_ACT, A_PROJ = WS_ACT + 64 * MiB, A_QN = WS_ACT + 320 * MiB, A_KVN = WS_ACT + 336 * MiB, A_QRAW = WS_ACT + 344 * MiB,
                 A_KVRAW = WS_ACT + 440 * MiB, A_KPER = WS_ACT + 568 * MiB  , A_SSPE = WS_ACT + 570 * MiB  , A_SSKP = WS_ACT + 572 * MiB  , A_XLO = WS_ACT + 600 * MiB  , A_OG = WS_ACT + 760 * MiB, WS_END = WS_ACT + 824 * MiB;
constexpr int CW_TMO = 0, CW_P0Q = 2048  , CW_BAR = 4096;
constexpr size_t WS_SS = 64 * 1024, SS_BYTES = 64 * 1024;

constexpr int RING_OFF = 0, RING_BYTES = 131072;
constexpr int LDSCTL_OFF = RING_BYTES, MISC_OFF = LDSCTL_OFF + 320;
constexpr int LDS_BYTES = 147456;

#define GAS __attribute__((address_space(1)))
#define LAS __attribute__((address_space(3)))
typedef unsigned short bf16;
typedef unsigned v4u __attribute__((ext_vector_type(4)));
typedef unsigned v2u __attribute__((ext_vector_type(2)));
typedef float f32x4 __attribute__((ext_vector_type(4)));
typedef GAS unsigned gu32;
#define RLX_AGENT __ATOMIC_RELAXED, __HIP_MEMORY_SCOPE_AGENT
#define LDS_WAIT() asm volatile("s_waitcnt lgkmcnt(0)" ::: "memory")
__device__ __forceinline__ float bf_lo(unsigned w) { return __uint_as_float(w << 16); }
__device__ __forceinline__ float bf_hi(unsigned w) { return __uint_as_float(w & 0xffff0000u); }
__device__ __forceinline__ unsigned pk2(float lo, float hi) { return pg8::cvt_pk_bf16(lo, hi); }
__device__ __forceinline__ void unpack8(v4u w, float (&f)[8]) { f[0] = bf_lo(w.x); f[1] = bf_hi(w.x); f[2] = bf_lo(w.y); f[3] = bf_hi(w.y); f[4] = bf_lo(w.z); f[5] = bf_hi(w.z); f[6] = bf_lo(w.w); f[7] = bf_hi(w.w); }
__device__ __forceinline__ v4u pack8(const float (&f)[8]) { v4u w; w.x = pk2(f[0], f[1]); w.y = pk2(f[2], f[3]); w.z = pk2(f[4], f[5]); w.w = pk2(f[6], f[7]); return w; }

#define XB_TMO      128
#define XB_XCNT(j)  (256  + 64 * (j))
#define XB_XSUB(j)  (1280 + 64 * (j))
#define XB_XGEN(j)  (2304 + 64 * (j))
#define XB_TOP      3328
#define XB_TOPGEN   3392
#define XCD_BAR_WORDS 3456
#define XB_SPIN_CAP (1u << 18)

__device__ __forceinline__ unsigned xb_ld(unsigned* p)              { return __hip_atomic_load(p, __ATOMIC_RELAXED, __HIP_MEMORY_SCOPE_AGENT); }
__device__ __forceinline__ unsigned xb_add(unsigned* p, unsigned v) { return __hip_atomic_fetch_add(p, v, __ATOMIC_RELAXED, __HIP_MEMORY_SCOPE_AGENT); }
__device__ __forceinline__ unsigned xb_xcc_id() { return (unsigned)__builtin_amdgcn_s_getreg((3 << 11) | 20) & 0xFu; }
#define XB_SPIN(cond, bar) do { unsigned _sp = 0; while (cond) { __builtin_amdgcn_s_sleep(1); \
    if ((++_sp & 255u) == 0u) { if (xb_ld(&(bar)[XB_TMO])) break; if (_sp > XB_SPIN_CAP) { atomicAdd(&(bar)[XB_TMO], 1u); break; } } } } while (0)

struct XcdBarrier {
    unsigned* bar; unsigned x;
    volatile LAS unsigned* st;
};

__device__ __forceinline__ XcdBarrier xcd_barrier_post(unsigned* bar, volatile LAS unsigned* st) {
    XcdBarrier b; b.bar = bar; b.x = xb_xcc_id(); b.st = st;
    if (threadIdx.x == 0) (void)xb_add(&bar[XB_XCNT(b.x)], 1u);
    return b;
}
__device__ __forceinline__ void xcd_barrier_complete(unsigned* bar, unsigned x, unsigned& nloc, unsigned& nx) {
    const unsigned G = gridDim.x * gridDim.y * gridDim.z;
    unsigned sum, cnt, mine, sp = 0u;
    for (;;) {
        sum = 0u; cnt = 0u; mine = 0u;
#pragma unroll
        for (unsigned j = 0; j < 16; ++j) { const unsigned c = xb_ld(&bar[XB_XCNT(j)]); sum += c; cnt += (c > 0u) ? 1u : 0u; mine = (j == x) ? c : mine; }
        if (sum == G) break;
        __builtin_amdgcn_s_sleep(1);
        if ((++sp & 255u) == 0u) { if (xb_ld(&bar[XB_TMO])) break; if (sp > XB_SPIN_CAP) { atomicAdd(&bar[XB_TMO], 1u); break; } }
    }
    nloc = mine > 0u ? mine : 1u; nx = cnt > 0u ? cnt : 1u;
}

__device__ __forceinline__ void xcd_barrier(const XcdBarrier& b) {
    asm volatile("s_waitcnt vmcnt(0)" ::: "memory");
    __syncthreads();
    if (threadIdx.x == 0) {
        unsigned* bar = b.bar;
        __builtin_amdgcn_s_waitcnt(0);
        unsigned nloc = b.st[0], nx = b.st[1];
        if (nloc == 0u) { xcd_barrier_complete(bar, b.x, nloc, nx); b.st[0] = nloc; b.st[1] = nx; }
        const unsigned old = xb_add(&bar[XB_XSUB(b.x)], 1u);
        const unsigned gen = old / nloc;
        if (old + 1u == (gen + 1u) * nloc) {
            __builtin_amdgcn_fence(__ATOMIC_RELEASE, "agent");
            asm volatile("s_waitcnt vmcnt(0)" ::: "memory");
            const unsigned og = xb_add(&bar[XB_TOP], 1u);
            const unsigned tg = og / nx;
            if (og + 1u == (tg + 1u) * nx) xb_add(&bar[XB_TOPGEN], 1u);
            else XB_SPIN(xb_ld(&bar[XB_TOPGEN]) == tg, bar);
            __builtin_amdgcn_fence(__ATOMIC_ACQUIRE, "agent");
            xb_add(&bar[XB_XGEN(b.x)], 1u);
            asm volatile("s_waitcnt vmcnt(0)" ::: "memory");
        } else {
            XB_SPIN(xb_ld(&bar[XB_XGEN(b.x)]) == gen, bar);
            __builtin_amdgcn_fence(__ATOMIC_ACQUIRE, "agent");
            asm volatile("s_waitcnt vmcnt(0)" ::: "memory");
        }
    }
    __syncthreads();
}

#define LAUNDER_V(x) asm volatile("" : "+v"(x))
__device__ __forceinline__ float wave_sum(float v) {
#pragma unroll
    for (int o = 1; o < 64; o <<= 1) v += __shfl_xor(v, o);
    return v;
}
__device__ __forceinline__ void p0_item_load(const float* W, int N, int item, int lane, f32x4 (&v)[16]) {
    const int nblk = N / 64, kb = item / nblk, nb = item % nblk, k0 = 64 * kb, n0 = 64 * nb, rr = lane >> 4, c4 = (lane & 15) * 4;
#pragma unroll
    for (int i = 0; i < 16; ++i) v[i] = *(const GAS f32x4*)(W + (size_t)(k0 + 4 * i + rr) * N + n0 + c4);
}
__device__ __forceinline__ void p0_item_store(const f32x4 (&v)[16], int K, int N, bf16* WT, LAS float* scr, int item, int lane, int nscale, float scale, const float* kg) {
    const int nblk = N / 64, kb = item / nblk, nb = item % nblk, k0 = 64 * kb, n0 = 64 * nb;
    const int rr = lane >> 4, c4 = (lane & 15) * 4;
#pragma unroll
    for (int i = 0; i < 16; ++i) { const int k = 4 * i + rr; *(LAS f32x4*)(scr + k * 64 + (c4 ^ ((k >> 3) * 4))) = v[i]; }
    LDS_WAIT(); asm volatile("" ::: "memory");
    const int c = lane & 7, nl = lane >> 3;
    f32x4 ga = (f32x4){1.f, 1.f, 1.f, 1.f}, gb = ga;
    if (kg) { ga = *(const GAS f32x4*)(kg + k0 + 8 * c); gb = *(const GAS f32x4*)(kg + k0 + 8 * c + 4); }
#pragma unroll
    for (int j = 0; j < 8; ++j) { const int n = nl + 8 * j; const LAS float* s = scr + (8 * c) * 64 + (n ^ (4 * c));
        const float sc = (n0 + n) < nscale ? scale : 1.f;
        v4u o; o.x = pk2(s[0 * 64] * (sc * ga.x), s[1 * 64] * (sc * ga.y)); o.y = pk2(s[2 * 64] * (sc * ga.z), s[3 * 64] * (sc * ga.w)); o.z = pk2(s[4 * 64] * (sc * gb.x), s[5 * 64] * (sc * gb.y)); o.w = pk2(s[6 * 64] * (sc * gb.z), s[7 * 64] * (sc * gb.w));
        *(GAS v4u*)(WT + (size_t)(n0 + n) * K + k0 + 8 * c) = o; }
    LDS_WAIT(); asm volatile("" ::: "memory");
}
__device__ __forceinline__ void p0_transpose(const float* W, int K, int N, bf16* WT, LAS float* scr, int gw, int NGW, int lane, const float* kg = nullptr, int nscale = 0, float scale = 1.f) {
    LAUNDER_V(lane);
    const int items = (K / 64) * (N / 64);
    f32x4 va[16], vb[16];
    int it = gw;
    if (it < items) p0_item_load(W, N, it, lane, va);
    for (; it < items; it += 2 * NGW) {
        const int it1 = it + NGW, it2 = it + 2 * NGW;
        if (it1 < items) p0_item_load(W, N, it1, lane, vb);
        p0_item_store(va, K, N, WT, scr, it, lane, nscale, scale, kg);
        if (it1 < items) { if (it2 < items) p0_item_load(W, N, it2, lane, va); p0_item_store(vb, K, N, WT, scr, it1, lane, nscale, scale, kg); }
    }
}
__device__ __forceinline__ void x_to_bf16_rows(const float* x, bf16* xb, bf16* xlo, unsigned long long* ss, int gw, int NGW, int lane) {
    LAUNDER_V(lane);
    for (int m = 2 * gw; m < M; m += 2 * NGW) {
        const GAS f32x4* xr = (const GAS f32x4*)(x + (size_t)m * DM) + lane;
        f32x4 v[16], w[16]; float s = 0.f, t = 0.f;
#pragma unroll
        for (int j = 0; j < 16; ++j) { v[j] = xr[64 * j]; w[j] = xr[DM / 4 + 64 * j]; }
#pragma unroll
        for (int j = 0; j < 16; ++j) { s += (v[j].x * v[j].x + v[j].y * v[j].y) + (v[j].z * v[j].z + v[j].w * v[j].w); t += (w[j].x * w[j].x + w[j].y * w[j].y) + (w[j].z * w[j].z + w[j].w * w[j].w); }
#pragma unroll
        for (int o = 1; o < 64; o <<= 1) { s += __shfl_xor(s, o); t += __shfl_xor(t, o); }
        if (lane == 0) { ss[m] = (unsigned long long)(s * pg8::SS_FIX); ss[m + 1] = (unsigned long long)(t * pg8::SS_FIX); }
        GAS v2u* o8 = (GAS v2u*)(xb + (size_t)m * DM) + lane; GAS v2u* l8 = (GAS v2u*)(xlo + (size_t)m * DM) + lane;
#pragma unroll
        for (int j = 0; j < 16; ++j) { v2u o, q, ol, ql; o.x = pk2(v[j].x, v[j].y); o.y = pk2(v[j].z, v[j].w); o8[64 * j] = o; q.x = pk2(w[j].x, w[j].y); q.y = pk2(w[j].z, w[j].w); o8[DM / 4 + 64 * j] = q;
            ol.x = pk2(v[j].x - bf_lo(o.x), v[j].y - bf_hi(o.x)); ol.y = pk2(v[j].z - bf_lo(o.y), v[j].w - bf_hi(o.y)); l8[64 * j] = ol;
            ql.x = pk2(w[j].x - bf_lo(q.x), w[j].y - bf_hi(q.x)); ql.y = pk2(w[j].z - bf_lo(q.y), w[j].w - bf_hi(q.y)); l8[DM / 4 + 64 * j] = ql; }
    }
}
constexpr int P0_T0 = (DM / 64) * (MLA_IN / 64), P0_T1 = (QL / 64) * (NQ / 64), P0_T2 = (KVL / 64) * (NKV / 64), P0_T3 = (DM / 64) * (DM / 64), P0_T4 = (DM / 64) * (SB_IN / 64), P0_T5 = P0_T3;
constexpr int P1_CHUNK = 8;
constexpr int FQ_KV0 = P0_T1 + P0_T2, FQ_OM0 = FQ_KV0 + P0_T3, FQ_IS0 = FQ_OM0 + P0_T4, FQ_OS0 = FQ_IS0 + P0_T5, FQ_IM1 = FQ_OS0 + P0_T0, FQ_KV1 = FQ_IM1 + P0_T1 + P0_T2, FQ_OM1 = FQ_KV1 + P0_T3,
              FQ_IS1 = FQ_OM1 + P0_T4, FQ_OS1 = FQ_IS1 + P0_T5, FQ_ITEMS = FQ_OS1;
struct P1Fill {
    const float* const* in; unsigned char* ws; gu32* q; LAS float* scr; int cbase, cpos;
    __device__ __forceinline__ bool item(int lane, int limit = FQ_ITEMS) {
        if (cpos >= P1_CHUNK) { unsigned v = 0; if (lane == 0) v = __hip_atomic_fetch_add(q, (unsigned)P1_CHUNK, __ATOMIC_RELAXED, __HIP_MEMORY_SCOPE_AGENT); cbase = __builtin_amdgcn_readfirstlane((int)v); cpos = 0; }
        int r = cbase + cpos;
        if (r >= limit) return false;
        ++cpos;
        LAUNDER_V(lane);
        int z_; asm volatile("s_mov_b32 %0, 0" : "=s"(z_));
        const float* const* in = this->in + z_; unsigned char* ws = this->ws + z_;
        const int j = r >= FQ_OS0 ? 1 : 0; if (j) r -= FQ_OS0; else r += P0_T0;
        unsigned char* wl = ws + WS_W + (size_t)j * W_LAYER;
        const float* W; bf16* WT; const float* kg = nullptr; int K, N, nscale = 0; float scale = 1.f;
        if (r < P0_T0) { W = in[2] + (size_t)j * DM * MLA_IN; K = DM; N = MLA_IN; WT = (bf16*)(wl + W_IN_MLA); kg = in[1] + (size_t)j * DM; }
        else if ((r -= P0_T0) < P0_T1) { W = in[4] + (size_t)j * QL * NQ; K = QL; N = NQ; WT = (bf16*)(wl + W_QB); kg = in[3] + (size_t)j * QL; }
        else if ((r -= P0_T1) < P0_T2) { W = in[6] + (size_t)j * KVL * NKV; K = KVL; N = NKV; WT = (bf16*)(wl + W_KVB); kg = in[5] + (size_t)j * KVL; }
        else if ((r -= P0_T2) < P0_T3) { W = in[9] + (size_t)j * DM * DM; K = DM; N = DM; WT = (bf16*)(wl + W_OUT_MLA); }
        else if ((r -= P0_T3) < P0_T4) { W = in[11] + (size_t)j * DM * SB_IN; K = DM; N = SB_IN; WT = (bf16*)(wl + W_IN_SB); kg = in[10] + (size_t)j * DM; nscale = DM; scale = Q_SCALE_SB; }
        else { r -= P0_T4; W = in[12] + (size_t)j * DM * DM; K = DM; N = DM; WT = (bf16*)(wl + W_OUT_SB); }
        f32x4 v[16]; p0_item_load(W, N, r, lane, v); p0_item_store(v, K, N, WT, scr, r, lane, nscale, scale, kg);
        return true;
    }
};
__device__ __forceinline__ void xcd_barrier_fill(const XcdBarrier& b, P1Fill& F, int wave, int lane) {
    asm volatile("s_waitcnt vmcnt(0)" ::: "memory");
    if (threadIdx.x == 0) b.st[2] = 0u;
    __syncthreads();
    if (wave == 0) {
        if (threadIdx.x == 0) {
            unsigned* bar = b.bar;
            __builtin_amdgcn_s_waitcnt(0);
            unsigned nloc = b.st[0], nx = b.st[1];
            if (nloc == 0u) { xcd_barrier_complete(bar, b.x, nloc, nx); b.st[0] = nloc; b.st[1] = nx; }
            const unsigned old = xb_add(&bar[XB_XSUB(b.x)], 1u);
            const unsigned gen = old / nloc;
            if (old + 1u == (gen + 1u) * nloc) {
                __builtin_amdgcn_fence(__ATOMIC_RELEASE, "agent");
                asm volatile("s_waitcnt vmcnt(0)" ::: "memory");
                const unsigned og = xb_add(&bar[XB_TOP], 1u);
                const unsigned tg = og / nx;
                if (og + 1u == (tg + 1u) * nx) xb_add(&bar[XB_TOPGEN], 1u);
                else { b.st[2] = 1u; XB_SPIN(xb_ld(&bar[XB_TOPGEN]) == tg, bar); }
                __builtin_amdgcn_fence(__ATOMIC_ACQUIRE, "agent");
                xb_add(&bar[XB_XGEN(b.x)], 1u);
                asm volatile("s_waitcnt vmcnt(0)" ::: "memory");
            } else {
                b.st[2] = 1u;
                XB_SPIN(xb_ld(&bar[XB_XGEN(b.x)]) == gen, bar);
                __builtin_amdgcn_fence(__ATOMIC_ACQUIRE, "agent");
                asm volatile("s_waitcnt vmcnt(0)" ::: "memory");
            }
            b.st[2] = 2u;
        }
    } else {
        while (b.st[2] == 0u) __builtin_amdgcn_s_sleep(1);
        while (b.st[2] == 1u) { if (!F.item(lane)) { while (b.st[2] == 1u) __builtin_amdgcn_s_sleep(2); break; } }
    }
    __syncthreads();
}

__device__ __forceinline__ void kpe_rows(const bf16* proj, const float* gk, const float* ropec, const float* ropes, bf16* kper, float* sspe, int gw, int NGW, int lane) {
    LAUNDER_V(lane);
    const int tk = lane >> 3, c = lane & 7;
    float g[8];
#pragma unroll
    for (int e = 0; e < 8; ++e) g[e] = gk[128 + 8 * c + e];
    for (int m0 = 8 * gw; m0 < M; m0 += 8 * NGW) { const int m = m0 + tk, pos = m & (SEQ - 1);
        float f[8], x[8], pr[8], o[8]; unpack8(*(const GAS v4u*)(proj + (size_t)m * MLA_INP + C_KPE + 8 * c), f);
        float ss = 0.f;
#pragma unroll
        for (int e = 0; e < 8; ++e) { ss += f[e] * f[e]; x[e] = f[e] * g[e]; }
        ss += __shfl_xor(ss, 1); ss += __shfl_xor(ss, 2); ss += __shfl_xor(ss, 4);
        if (c == 0) sspe[m] = ss;
#pragma unroll
        for (int e = 0; e < 8; ++e) pr[e] = __shfl_xor(x[e], 4);
        const float* cs = ropec + pos * 32 + (c & 3) * 8; const float* sn = ropes + pos * 32 + (c & 3) * 8;
#pragma unroll
        for (int e = 0; e < 8; ++e) o[e] = (c < 4) ? (x[e] * cs[e] - pr[e] * sn[e]) : (pr[e] * sn[e] + x[e] * cs[e]);
        *(GAS v4u*)(kper + (size_t)m * 64 + 8 * c) = pack8(o); }
}


namespace fa {
typedef short bf16x8 __attribute__((ext_vector_type(8)));
typedef short s16x4 __attribute__((ext_vector_type(4)));
typedef float f32x16 __attribute__((ext_vector_type(16)));
typedef float f32x2 __attribute__((ext_vector_type(2)));
#define FA_SBAR() __builtin_amdgcn_sched_barrier(0)
#ifndef FA_NDR
#define FA_NDR 12
#endif
#ifndef FA_PV_DEFER
#define FA_PV_DEFER 0
#endif
#ifndef FA_PP2_LAG
#define FA_PP2_LAG 0
#endif
#ifndef FA_PP2
#define FA_PP2 0
#endif
#ifndef FA_PP
#define FA_PP 0
#endif
constexpr int SHM_V = 16384;
__device__ __forceinline__ int v_st(int k, int c) { const int kk = (k & ~0xC) | ((k & 4) << 1) | ((k & 8) >> 1); return ((kk >> 3) * 4 + (c >> 5)) * 512 + ((kk & 7) * 32 + (c & 31)) * 2; }
__device__ __forceinline__ int v_rd_base(int lane) { return ((lane & 3) << 3) | (((lane >> 2) & 3) << 6) | (((lane >> 4) & 1) << 5) | (((lane >> 5) & 1) << 8); }
__device__ __forceinline__ unsigned cvtpk(float lo, float hi) { unsigned r; asm volatile("v_cvt_pk_bf16_f32 %0, %1, %2" : "=v"(r) : "v"(lo), "v"(hi)); return r; }
__device__ __forceinline__ bf16x8 pack8p(const f32x16& p, int b) { v4u w = {cvtpk(p[b + 0], p[b + 1]), cvtpk(p[b + 2], p[b + 3]), cvtpk(p[b + 4], p[b + 5]), cvtpk(p[b + 6], p[b + 7])}; return __builtin_bit_cast(bf16x8, w); }
__device__ __forceinline__ float ex2(float x) { return __builtin_amdgcn_exp2f(x); }
__device__ __forceinline__ float lg2(float x) { return __builtin_amdgcn_logf(x); }

struct AttnP { const bf16* Q; int qpitch, qhs; const bf16* K; int kpitch, khs; const bf16* V; int vpitch, vhs; const bf16* Gt; int gpitch; bf16* O;
               const bf16* KR; const float* sskp; const float* sspe; const float* gq; const float* gk; const float* rc; const float* rs; };
template <int MODE>
__device__ __forceinline__ void attn_phase(LAS unsigned char* lds, const AttnP& P, int G, int vcu, LAS unsigned* ecnt, unsigned& tacc) {
#if PROBE_SEG
    unsigned t_prev = 0;
#define FA_STAMP_ON(k) (PROBE_SEG == 9 || (k) == 0 || (k) == PROBE_SEG || ((k) == PROBE_SEG - 1 && PROBE_SEG >= 2 && PROBE_SEG <= 4))
#define FA_STAMP(k) do { if (PROBE_MODE == MODE && FA_STAMP_ON(k)) { asm volatile("" ::: "memory"); const unsigned t_now = (unsigned)__builtin_amdgcn_s_memtime(); asm volatile("s_waitcnt lgkmcnt(0)" ::: "memory"); if (PROBE_SEG == (k) || (PROBE_SEG == 9 && (k) != 0)) tacc += t_now - t_prev; t_prev = t_now; } } while (0)
#else
#define FA_STAMP(k) do { } while (0)
#endif
    const bf16* Qp = P.Q; const int qpitch = P.qpitch, qhs = P.qhs; const bf16* Kp = P.K; const int kpitch = P.kpitch, khs = P.khs; const bf16* Vp = P.V; const int vpitch = P.vpitch, vhs = P.vhs;
    const bf16* Gp = P.Gt; const int gpitch = P.gpitch; bf16* Op = P.O;
    constexpr int DQK = MODE == 0 ? 192 : 128, ND = DQK / 16, KPITCH = DQK * 2, SHM_K = 64 * KPITCH, KP = SHM_K / 8192, VOFF = 2 * SHM_K, NVB = (MODE == 0 && (FA_PP2 || FA_PV_DEFER)) ? 3 : 2, RKOFF = VOFF + NVB * SHM_V, QROFF = RKOFF + 8192, NDR = (PROBE_SEG && MODE == 0) ? 7 : (MODE == 0 ? FA_NDR : 8), GTOFF = 131072 + 1024  ;
    int tid_l = threadIdx.x; asm volatile("" : "+v"(tid_l));
    const int tid = tid_l, wid = __builtin_amdgcn_readfirstlane(tid >> 6), lane = tid & 63;
#define FA_QRBASE ((MODE == 0 && (FA_PP2 || FA_PV_DEFER) && wid >= 6) ? 133120 + (wid - 6) * 4096 : QROFF + wid * (NDR < 8 ? 5120 : 4096))
#define FA_LANE_ADDRS(ln) const int r32 = (ln) & 31, hi = (ln) >> 5; const int kswz = MODE == 0 ? (((r32 >> 1) & 7) << 4) : ((r32 & 15) << 4); const int krow = r32 * KPITCH; \
        const int vb0 = (int)(uintptr_t)lds + VOFF + v_rd_base(ln); LAS unsigned char* qrl = lds + FA_QRBASE + (ln) * 16;
    const float NEG_INF = -__builtin_inff();
    constexpr float SB_CUT = -160.f;
    int un = 0;
    if (MODE == 1) { if (tid < 64) ecnt[tid] = 0u; asm volatile("s_waitcnt lgkmcnt(0)\n\ts_barrier" ::: "memory"); }

#define FA_DMA_OFFS(koff, krope, voff) unsigned koff[KP], voff[2]; bool krope[KP]; { int ln_ = lane; asm volatile("" : "+v"(ln_)); \
            _Pragma("unroll") for (int i_ = 0; i_ < KP; ++i_) { const int L = (wid * KP + i_) * 1024 + ln_ * 16, v = L / KPITCH, sb = L % KPITCH; \
                const int swz = MODE == 0 ? (((v >> 1) & 7) << 4) : ((v & 15) << 4), cb = sb ^ swz, vi = v & 31, dim = cb >> 1; \
                const int key = (v & 32) + (vi & 3) + 4 * (vi >> 3) + 16 * ((vi >> 2) & 1);                     \
                krope[i_] = MODE == 0 && dim >= 128; koff[i_] = krope[i_] ? (unsigned)(key * 64 + dim - 128) : (unsigned)(key * kpitch + dim); } \
            _Pragma("unroll") for (int i_ = 0; i_ < 2; ++i_) { const int L = (wid * 2 + i_) * 1024 + ln_ * 16, sub = L >> 9, within = L & 511, kk = (sub >> 2) * 8 + (within >> 6); \
                const int u_ = (kk & ~0xC) | ((kk & 4) << 1) | ((kk & 8) >> 1);                                    \
                const int key = (u_ & ~0x18) | ((u_ & 8) << 1) | ((u_ & 16) >> 1);                                  \
                voff[i_] = (unsigned)(key * vpitch + (sub & 3) * 32 + ((within & 63) >> 4) * 8); } }
#define FA_DMA_GO(koff, krope, voff, Kh_, Vh_, KRh_, j, KB) do { const bf16* kb_ = (Kh_) + (size_t)(j) * 64 * kpitch; const bf16* vb_ = (Vh_) + (size_t)(j) * 64 * vpitch; const bf16* kr_ = MODE == 0 ? (KRh_) + (size_t)(j) * 64 * 64 : nullptr; \
            _Pragma("unroll") for (int i_ = 0; i_ < KP; ++i_) __builtin_amdgcn_global_load_lds((const unsigned*)(((MODE == 0 && krope[i_]) ? kr_ : kb_) + koff[i_]), (LAS unsigned*)(lds + (KB) * SHM_K + (wid * KP + i_) * 1024), 16, 0, 0); \
            _Pragma("unroll") for (int i_ = 0; i_ < 2; ++i_) __builtin_amdgcn_global_load_lds((const unsigned*)(vb_ + voff[i_]), (LAS unsigned*)(lds + VOFF + (KB) * SHM_V + (wid * 2 + i_) * 1024), 16, 0, 0); } while (0)
#define FA_WAITBAR() asm volatile("s_waitcnt vmcnt(0) lgkmcnt(0)\n\ts_barrier" ::: "memory")
#define FA_TRRD(dst, off) asm volatile("ds_read_b64_tr_b16 %0, %1 offset:%2" : "=&v"(dst) : "v"(vb0), "i"(off) : "memory")
#define FA_PV_D0(d0, VB) do { s16x4 l0, l1, l2, l3, h0, h1, h2, h3; constexpr int b_ = (VB) * SHM_V + (d0) * 512; \
            FA_TRRD(l0, b_); FA_TRRD(h0, b_ + 2048); FA_TRRD(l1, b_ + 4096); FA_TRRD(h1, b_ + 6144); FA_TRRD(l2, b_ + 8192); FA_TRRD(h2, b_ + 10240); FA_TRRD(l3, b_ + 12288); FA_TRRD(h3, b_ + 14336); \
            asm volatile("s_waitcnt lgkmcnt(0)" ::: "memory"); FA_SBAR(); \
            o[d0] = __builtin_amdgcn_mfma_f32_32x32x16_bf16((bf16x8){l0[0], l0[1], l0[2], l0[3], h0[0], h0[1], h0[2], h0[3]}, pa0, o[d0], 0, 0, 0); \
            o[d0] = __builtin_amdgcn_mfma_f32_32x32x16_bf16((bf16x8){l1[0], l1[1], l1[2], l1[3], h1[0], h1[1], h1[2], h1[3]}, pa1, o[d0], 0, 0, 0); \
            o[d0] = __builtin_amdgcn_mfma_f32_32x32x16_bf16((bf16x8){l2[0], l2[1], l2[2], l2[3], h2[0], h2[1], h2[2], h2[3]}, pa2, o[d0], 0, 0, 0); \
            o[d0] = __builtin_amdgcn_mfma_f32_32x32x16_bf16((bf16x8){l3[0], l3[1], l3[2], l3[3], h3[0], h3[1], h3[2], h3[3]}, pa3, o[d0], 0, 0, 0); } while (0)
#define FA_STEP(t, KB) do { const int j = MODE == 0 ? (t) : NT - 1 - (t); int ln_s = lane; asm volatile("" : "+v"(ln_s)); FA_LANE_ADDRS(ln_s) \
            FA_STAMP(0); \
            if ((t) + 1 < NT) { const int jn = MODE == 0 ? (t) + 1 : NT - 2 - (t); FA_DMA_GO(sko, skr, svo, Kh, Vh, KRh, jn, (KB) ^ 1); } \
            if (j <= jmax && !(MODE == 1 && wdone)) { \
                f32x16 p0 = f32x16{}, p1 = f32x16{}; \
                _Pragma("unroll") for (int d0 = 0; d0 < ND; ++d0) { const int cb = d0 * 32 + hi * 16; const LAS unsigned char* a = lds + (KB) * SHM_K + krow + (cb ^ kswz); \
                    const bf16x8 k0 = *(const LAS bf16x8*)a, k1 = *(const LAS bf16x8*)(a + 32 * KPITCH); \
                    const bf16x8 qf = d0 < NDR ? qr[d0 < NDR ? d0 : 0] : *(const LAS bf16x8*)(qrl + (d0 == 7 ? 4 : d0 - 8) * 1024); \
                    p0 = __builtin_amdgcn_mfma_f32_32x32x16_bf16(k0, qf, p0, 0, 0, 0); p1 = __builtin_amdgcn_mfma_f32_32x32x16_bf16(k1, qf, p1, 0, 0, 0); } \
                const int kb = j * 64, dq = qlo + r32 - kb - 16 * hi; \
                if (PROBE_SEG) { asm volatile("" : "+v"(p0), "+v"(p1)); FA_STAMP(1); }     \
                if (MODE == 0) { \
                    { const LAS float* rkw = (const LAS float*)(lds + RKOFF) + kb; \
                      _Pragma("unroll") for (int g_ = 0; g_ < 4; ++g_) { const f32x4 ra = *(const LAS f32x4*)(rkw + 16 * hi + 4 * g_), rb = *(const LAS f32x4*)(rkw + 32 + 16 * hi + 4 * g_); \
                          p0[4 * g_] *= ra.x; p0[4 * g_ + 1] *= ra.y; p0[4 * g_ + 2] *= ra.z; p0[4 * g_ + 3] *= ra.w; p1[4 * g_] *= rb.x; p1[4 * g_ + 1] *= rb.y; p1[4 * g_ + 2] *= rb.z; p1[4 * g_ + 3] *= rb.w; } } \
                    if (kb + 63 > qlo) { _Pragma("unroll") for (int r = 0; r < 16; ++r) { if (r > dq) p0[r] = NEG_INF; if (r + 32 > dq) p1[r] = NEG_INF; } } \
                    float pmax = p0[0]; _Pragma("unroll") for (int r = 1; r < 16; ++r) pmax = fmaxf(pmax, p0[r]); _Pragma("unroll") for (int r = 0; r < 16; ++r) pmax = fmaxf(pmax, p1[r]); \
                    { auto rr = __builtin_amdgcn_permlane32_swap(__float_as_uint(pmax), __float_as_uint(pmax), false, false); pmax = fmaxf(__uint_as_float(rr[0]), __uint_as_float(rr[1])); } \
                    if (!__all(pmax - m_reg <= 11.5f)) { const float mn = fmaxf(m_reg, pmax), alpha = ex2(m_reg - mn); m_reg = mn; l_reg *= alpha; \
                        _Pragma("unroll") for (int d0 = 0; d0 < 4; ++d0) _Pragma("unroll") for (int r = 0; r < 16; ++r) o[d0][r] *= alpha; } \
                    float ps = 0.f; \
                    _Pragma("unroll") for (int r = 0; r < 16; r += 2) { const f32x2 a0 = (f32x2){p0[r], p0[r + 1]} - (f32x2){m_reg, m_reg}, a1 = (f32x2){p1[r], p1[r + 1]} - (f32x2){m_reg, m_reg}; \
                        p0[r] = ex2(a0.x); p0[r + 1] = ex2(a0.y); p1[r] = ex2(a1.x); p1[r + 1] = ex2(a1.y); ps += (p0[r] + p1[r]) + (p0[r + 1] + p1[r + 1]); } \
                    l_reg += ps; \
                } else { \
                    f32x16 e0, e1;     \
                    _Pragma("unroll") for (int r = 0; r < 16; r += 2) { const f32x2 t0 = {p0[r], p0[r + 1]}, t1 = {p1[r], p1[r + 1]}; \
                        const f32x2 x0 = (f32x2){ex2(-fabsf(t0.x)), ex2(-fabsf(t0.y))} + (f32x2){1.f, 1.f}, x1 = (f32x2){ex2(-fabsf(t1.x)), ex2(-fabsf(t1.y))} + (f32x2){1.f, 1.f}; \
                        const f32x2 b0 = (f32x2){fminf(t0.x, 0.f), fminf(t0.y, 0.f)} - (f32x2){lg2(x0.x), lg2(x0.y)}, b1 = (f32x2){fminf(t1.x, 0.f), fminf(t1.y, 0.f)} - (f32x2){lg2(x1.x), lg2(x1.y)}; \
                        const f32x2 d0 = b0 - t0, d1 = b1 - t1; \
                        p0[r] = b0.x; p0[r + 1] = b0.y; e0[r] = d0.x; e0[r + 1] = d0.y; p1[r] = b1.x; p1[r + 1] = b1.y; e1[r] = d1.x; e1[r + 1] = d1.y; } \
                    if (kb + 63 >= qlo) { _Pragma("unroll") for (int r = 0; r < 16; ++r) { if (r >= dq) { p0[r] = NEG_INF; e0[r] = 0.f; } if (r + 32 >= dq) { p1[r] = NEG_INF; e1[r] = 0.f; } } } \
                    float s0 = 0.f, s1 = 0.f; \
                    _Pragma("unroll") for (int r = 15; r >= 0; --r) { const float x0 = e0[r], x1 = e1[r]; e0[r] = s0; e1[r] = s1; s0 += x0; s1 += x1; } \
                    const auto r1 = __builtin_amdgcn_permlane32_swap(__float_as_uint(s0), __float_as_uint(s1), false, false); \
                    const auto r2 = __builtin_amdgcn_permlane32_swap(__float_as_uint(s1), __float_as_uint(s0), false, false); \
                    const float ps0 = __uint_as_float(hi ? r2[0] : r1[1]), ps1 = __uint_as_float(hi ? r1[0] : r2[1]); \
                    const float off1 = carry + (hi ? 0.f : ps1), off0 = carry + s1 + ps1 + (hi ? 0.f : ps0); \
                    carry += (s0 + s1) + (ps0 + ps1); \
                    _Pragma("unroll") for (int r = 0; r < 16; r += 2) { const f32x2 a0 = (f32x2){p0[r], p0[r + 1]} + ((f32x2){e0[r], e0[r + 1]} + (f32x2){off0, off0}), a1 = (f32x2){p1[r], p1[r + 1]} + ((f32x2){e1[r], e1[r + 1]} + (f32x2){off1, off1}); \
                        p0[r] = ex2(a0.x); p0[r + 1] = ex2(a0.y); p1[r] = ex2(a1.x); p1[r + 1] = ex2(a1.y); } \
                } \
                const bf16x8 pa0 = pack8p(p0, 0), pa1 = pack8p(p0, 8), pa2 = pack8p(p1, 0), pa3 = pack8p(p1, 8); \
                FA_STAMP(2); \
                FA_PV_D0(0, KB); FA_PV_D0(1, KB); FA_PV_D0(2, KB); FA_PV_D0(3, KB); \
                FA_STAMP(3); \
                if (MODE == 1) { if (__all(carry < SB_CUT)) wdone = true; } \
            } \
            if (MODE == 1 && wdone && lane == 0) __hip_atomic_fetch_add(ebank + (t), 1u, __ATOMIC_RELAXED, __HIP_MEMORY_SCOPE_WORKGROUP); \
            FA_WAITBAR(); FA_STAMP(4); \
            if (MODE == 1) stop = *(volatile LAS unsigned*)(ebank + (t)) == 8u; } while (0)


#define FA_DMA_K(koff, krope, Kh_, KRh_, j, KB) do { const bf16* kb_ = (Kh_) + (size_t)(j) * 64 * kpitch; const bf16* kr_ = MODE == 0 ? (KRh_) + (size_t)(j) * 64 * 64 : nullptr; \
            _Pragma("unroll") for (int i_ = 0; i_ < KP; ++i_) __builtin_amdgcn_global_load_lds((const unsigned*)(((MODE == 0 && krope[i_]) ? kr_ : kb_) + koff[i_]), (LAS unsigned*)(lds + (KB) * SHM_K + (wid * KP + i_) * 1024), 16, 0, 0); } while (0)
#define FA_DMA_V(voff, Vh_, j, KB) do { const bf16* vb_ = (Vh_) + (size_t)(j) * 64 * vpitch; \
            _Pragma("unroll") for (int i_ = 0; i_ < 2; ++i_) __builtin_amdgcn_global_load_lds((const unsigned*)(vb_ + voff[i_]), (LAS unsigned*)(lds + VOFF + (KB) * SHM_V + (wid * 2 + i_) * 1024), 16, 0, 0); } while (0)
#define FA_SLOT_END(more_, na, nb) do { FA_SBAR(); if (more_) { if (!grpB) asm volatile("s_waitcnt vmcnt(" #na ") lgkmcnt(0)\n\ts_barrier" ::: "memory"); else asm volatile("s_waitcnt vmcnt(" #nb ") lgkmcnt(0)\n\ts_barrier" ::: "memory"); } \
            else asm volatile("s_waitcnt vmcnt(0) lgkmcnt(0)\n\ts_barrier" ::: "memory"); FA_SBAR(); } while (0)
#define FA_S1(t, KB) do { const int j = (t); int ln_s = lane; asm volatile("" : "+v"(ln_s)); FA_LANE_ADDRS(ln_s) \
            const bool more_ = (t) + 1 < NT; \
            if (more_) { if (!grpB) FA_DMA_K(sko, skr, Kh, KRh, (t) + 1, (KB) ^ 1); else FA_DMA_V(svo, Vh, (t) + 1, (KB) ^ 1); } \
            if (j <= jmax) { \
                p0 = f32x16{}; p1 = f32x16{}; \
                _Pragma("unroll") for (int d0 = 0; d0 < ND; ++d0) { const int cb = d0 * 32 + hi * 16; const LAS unsigned char* a = lds + (KB) * SHM_K + krow + (cb ^ kswz); \
                    const bf16x8 k0 = *(const LAS bf16x8*)a, k1 = *(const LAS bf16x8*)(a + 32 * KPITCH); \
                    const bf16x8 qf = d0 < NDR ? qr[d0 < NDR ? d0 : 0] : *(const LAS bf16x8*)(qrl + (d0 == 7 ? 4 : d0 - 8) * 1024); \
                    p0 = __builtin_amdgcn_mfma_f32_32x32x16_bf16(k0, qf, p0, 0, 0, 0); p1 = __builtin_amdgcn_mfma_f32_32x32x16_bf16(k1, qf, p1, 0, 0, 0); } \
                const int kb = j * 64, dq = qlo + r32 - kb - 16 * hi; \
                { const LAS float* rkw = (const LAS float*)(lds + RKOFF) + kb; \
                  _Pragma("unroll") for (int g_ = 0; g_ < 4; ++g_) { const f32x4 ra = *(const LAS f32x4*)(rkw + 16 * hi + 4 * g_), rb = *(const LAS f32x4*)(rkw + 32 + 16 * hi + 4 * g_); \
                      p0[4 * g_] *= ra.x; p0[4 * g_ + 1] *= ra.y; p0[4 * g_ + 2] *= ra.z; p0[4 * g_ + 3] *= ra.w; p1[4 * g_] *= rb.x; p1[4 * g_ + 1] *= rb.y; p1[4 * g_ + 2] *= rb.z; p1[4 * g_ + 3] *= rb.w; } } \
                if (kb + 63 > qlo) { _Pragma("unroll") for (int r = 0; r < 16; ++r) { if (r > dq) p0[r] = NEG_INF; if (r + 32 > dq) p1[r] = NEG_INF; } } \
                float pmax = p0[0]; _Pragma("unroll") for (int r = 1; r < 16; ++r) pmax = fmaxf(pmax, p0[r]); _Pragma("unroll") for (int r = 0; r < 16; ++r) pmax = fmaxf(pmax, p1[r]); \
                { auto rr = __builtin_amdgcn_permlane32_swap(__float_as_uint(pmax), __float_as_uint(pmax), false, false); pmax = fmaxf(__uint_as_float(rr[0]), __uint_as_float(rr[1])); } \
                if (!__all(pmax - m_reg <= 11.5f)) { const float mn = fmaxf(m_reg, pmax), alpha = ex2(m_reg - mn); m_reg = mn; l_reg *= alpha; \
                    _Pragma("unroll") for (int d0 = 0; d0 < 4; ++d0) _Pragma("unroll") for (int r = 0; r < 16; ++r) o[d0][r] *= alpha; } \
                (void)vb0; \
            } \
            FA_SLOT_END(more_, 3, 2); } while (0)
#define FA_S2(t, KB) do { const int j = (t); int ln_s = lane; asm volatile("" : "+v"(ln_s)); FA_LANE_ADDRS(ln_s) \
            const bool more_ = grpB ? (t) + 2 < NT : (t) + 1 < NT; \
            if (more_) { if (!grpB) FA_DMA_V(svo, Vh, (t) + 1, (KB) ^ 1); else FA_DMA_K(sko, skr, Kh, KRh, (t) + 2, (KB)); } \
            if (j <= jmax) { \
                float ps = 0.f; \
                _Pragma("unroll") for (int r = 0; r < 16; ++r) { p0[r] = ex2(p0[r] - m_reg); p1[r] = ex2(p1[r] - m_reg); ps += p0[r] + p1[r]; } \
                l_reg += ps; \
                const bf16x8 pa0 = pack8p(p0, 0), pa1 = pack8p(p0, 8), pa2 = pack8p(p1, 0), pa3 = pack8p(p1, 8); \
                FA_PV_D0(0, KB); FA_PV_D0(1, KB); FA_PV_D0(2, KB); FA_PV_D0(3, KB); \
                (void)krow; (void)kswz; (void)qrl; \
            } \
            FA_SLOT_END(more_, 2, 3); } while (0)

#define FA_QK2(t) do { const int j = (t); int ln_s = lane; asm volatile("" : "+v"(ln_s)); FA_LANE_ADDRS(ln_s) (void)vb0; \
            if (j <= jmax) { const LAS unsigned char* kt_ = lds + ((t) & 1) * SHM_K + krow; p0 = f32x16{}; p1 = f32x16{}; \
                _Pragma("unroll") for (int d0 = 0; d0 < ND; ++d0) { const int cb = d0 * 32 + hi * 16; const LAS unsigned char* a = kt_ + (cb ^ kswz); \
                    const bf16x8 k0 = *(const LAS bf16x8*)a, k1 = *(const LAS bf16x8*)(a + 32 * KPITCH); \
                    const bf16x8 qf = d0 < NDR ? qr[d0 < NDR ? d0 : 0] : *(const LAS bf16x8*)(qrl + (d0 == 7 ? 4 : d0 - 8) * 1024); \
                    p0 = __builtin_amdgcn_mfma_f32_32x32x16_bf16(k0, qf, p0, 0, 0, 0); p1 = __builtin_amdgcn_mfma_f32_32x32x16_bf16(k1, qf, p1, 0, 0, 0); } } } while (0)
#define FA_SMPV2(t, vs_) do { const int j = (t); int ln_s = lane; asm volatile("" : "+v"(ln_s)); \
            if (j <= jmax) { const int r32 = ln_s & 31, hi = ln_s >> 5; const int vb0 = (int)(uintptr_t)lds + VOFF + (vs_) * SHM_V + v_rd_base(ln_s); \
                const int kb = j * 64, dq = qlo + r32 - kb - 16 * hi; \
                { const LAS float* rkw = (const LAS float*)(lds + RKOFF) + kb; \
                  _Pragma("unroll") for (int g_ = 0; g_ < 4; ++g_) { const f32x4 ra = *(const LAS f32x4*)(rkw + 16 * hi + 4 * g_), rb = *(const LAS f32x4*)(rkw + 32 + 16 * hi + 4 * g_); \
                      p0[4 * g_] *= ra.x; p0[4 * g_ + 1] *= ra.y; p0[4 * g_ + 2] *= ra.z; p0[4 * g_ + 3] *= ra.w; p1[4 * g_] *= rb.x; p1[4 * g_ + 1] *= rb.y; p1[4 * g_ + 2] *= rb.z; p1[4 * g_ + 3] *= rb.w; } } \
                if (kb + 63 > qlo) { _Pragma("unroll") for (int r = 0; r < 16; ++r) { if (r > dq) p0[r] = NEG_INF; if (r + 32 > dq) p1[r] = NEG_INF; } } \
                float pmax = p0[0]; _Pragma("unroll") for (int r = 1; r < 16; ++r) pmax = fmaxf(pmax, p0[r]); _Pragma("unroll") for (int r = 0; r < 16; ++r) pmax = fmaxf(pmax, p1[r]); \
                { auto rr = __builtin_amdgcn_permlane32_swap(__float_as_uint(pmax), __float_as_uint(pmax), false, false); pmax = fmaxf(__uint_as_float(rr[0]), __uint_as_float(rr[1])); } \
                if (!__all(pmax - m_reg <= 11.5f)) { const float mn = fmaxf(m_reg, pmax), alpha = ex2(m_reg - mn); m_reg = mn; l_reg *= alpha; \
                    _Pragma("unroll") for (int d0 = 0; d0 < 4; ++d0) _Pragma("unroll") for (int r = 0; r < 16; ++r) o[d0][r] *= alpha; } \
                float ps = 0.f; \
                _Pragma("unroll") for (int r = 0; r < 16; r += 2) { const f32x2 a0 = (f32x2){p0[r], p0[r + 1]} - (f32x2){m_reg, m_reg}, a1 = (f32x2){p1[r], p1[r + 1]} - (f32x2){m_reg, m_reg}; \
                    p0[r] = ex2(a0.x); p0[r + 1] = ex2(a0.y); p1[r] = ex2(a1.x); p1[r + 1] = ex2(a1.y); ps += (p0[r] + p1[r]) + (p0[r + 1] + p1[r + 1]); } \
                l_reg += ps; \
                const bf16x8 pa0 = pack8p(p0, 0), pa1 = pack8p(p0, 8), pa2 = pack8p(p1, 0), pa3 = pack8p(p1, 8); \
                FA_PV_D0(0, 0); FA_PV_D0(1, 0); FA_PV_D0(2, 0); FA_PV_D0(3, 0); } } while (0)
#define FA_STEP2(t) do { \
            if ((t) + 1 < NT) { FA_DMA_K(sko, skr, Kh, KRh, (t) + 1, ((t) + 1) & 1); FA_DMA_V(svo, Vh, (t) + 1, vs1); } \
            if (grpB && (t) > 0) FA_SMPV2((t) - 1, vsp); \
            FA_QK2(t); \
            if (!grpB || (t) + 1 == NT) FA_SMPV2(t, vs0); \
            FA_WAITBAR(); vsp = vs0; vs0 = vs1; vs1 = vs1 == 2 ? 0 : vs1 + 1; } while (0)

#define FA_EXPSLOT(P, r) do { const f32x2 a_ = (f32x2){P[r], P[(r) + 1]} - (f32x2){m_reg, m_reg}; P[r] = ex2(a_.x); P[(r) + 1] = ex2(a_.y); ps += P[r] + P[(r) + 1]; } while (0)
#define FA_MF(d0, L, H, PA) o[d0] = __builtin_amdgcn_mfma_f32_32x32x16_bf16((bf16x8){L[0], L[1], L[2], L[3], H[0], H[1], H[2], H[3]}, PA, o[d0], 0, 0, 0)
#define FA_PV_D0I(d0, r0) do { s16x4 l0, l1, l2, l3, h0, h1, h2, h3; constexpr int b_ = (d0) * 512; \
            FA_TRRD(l0, b_); FA_TRRD(h0, b_ + 2048); FA_TRRD(l1, b_ + 4096); FA_TRRD(h1, b_ + 6144); FA_TRRD(l2, b_ + 8192); FA_TRRD(h2, b_ + 10240); FA_TRRD(l3, b_ + 12288); FA_TRRD(h3, b_ + 14336); \
            FA_EXPSLOT(p0, r0); asm volatile("s_waitcnt lgkmcnt(0)" ::: "memory"); FA_SBAR(); \
            FA_MF(d0, l0, h0, pa0); FA_SBAR(); FA_EXPSLOT(p1, r0); FA_SBAR(); \
            FA_MF(d0, l1, h1, pa1); FA_SBAR(); FA_EXPSLOT(p0, (r0) + 2); FA_SBAR(); \
            FA_MF(d0, l2, h2, pa2); FA_SBAR(); FA_EXPSLOT(p1, (r0) + 2); FA_SBAR(); \
            FA_MF(d0, l3, h3, pa3); FA_SBAR(); } while (0)
#define FA_SM3(t, dopv_, vs_) do { const int j = (t); int ln_s = lane; asm volatile("" : "+v"(ln_s)); const bool pv_ = (dopv_) && (t) - 1 <= jmax; \
            if (j <= jmax) { const int r32 = ln_s & 31, hi = ln_s >> 5; const int vb0 = (int)(uintptr_t)lds + VOFF + (vs_) * SHM_V + v_rd_base(ln_s); \
                const int kb = j * 64, dq = qlo + r32 - kb - 16 * hi; \
                { const LAS float* rkw = (const LAS float*)(lds + RKOFF) + kb; \
                  _Pragma("unroll") for (int g_ = 0; g_ < 4; ++g_) { const f32x4 ra = *(const LAS f32x4*)(rkw + 16 * hi + 4 * g_), rb = *(const LAS f32x4*)(rkw + 32 + 16 * hi + 4 * g_); \
                      p0[4 * g_] *= ra.x; p0[4 * g_ + 1] *= ra.y; p0[4 * g_ + 2] *= ra.z; p0[4 * g_ + 3] *= ra.w; p1[4 * g_] *= rb.x; p1[4 * g_ + 1] *= rb.y; p1[4 * g_ + 2] *= rb.z; p1[4 * g_ + 3] *= rb.w; } } \
                if (kb + 63 > qlo) { _Pragma("unroll") for (int r = 0; r < 16; ++r) { if (r > dq) p0[r] = NEG_INF; if (r + 32 > dq) p1[r] = NEG_INF; } } \
                float pmax = p0[0]; _Pragma("unroll") for (int r = 1; r < 16; ++r) pmax = fmaxf(pmax, p0[r]); _Pragma("unroll") for (int r = 0; r < 16; ++r) pmax = fmaxf(pmax, p1[r]); \
                { auto rr = __builtin_amdgcn_permlane32_swap(__float_as_uint(pmax), __float_as_uint(pmax), false, false); pmax = fmaxf(__uint_as_float(rr[0]), __uint_as_float(rr[1])); } \
                const bool resc_ = !__all(pmax - m_reg <= 11.5f); float alpha_ = 1.f; \
                if (resc_) { const float mn = fmaxf(m_reg, pmax); alpha_ = ex2(m_reg - mn); m_reg = mn; l_reg *= alpha_; } \
                float ps = 0.f; \
                if (pv_) { FA_PV_D0I(0, 0); FA_PV_D0I(1, 4); FA_PV_D0I(2, 8); FA_PV_D0I(3, 12); }     \
                else { _Pragma("unroll") for (int r = 0; r < 16; r += 2) { FA_EXPSLOT(p0, r); FA_EXPSLOT(p1, r); } } \
                if (resc_) { _Pragma("unroll") for (int d0 = 0; d0 < 4; ++d0) _Pragma("unroll") for (int r = 0; r < 16; ++r) o[d0][r] *= alpha_; } \
                l_reg += ps; \
                pa0 = pack8p(p0, 0); pa1 = pack8p(p0, 8); pa2 = pack8p(p1, 0); pa3 = pack8p(p1, 8); \
            } } while (0)
#define FA_PV3(t, vs_) do { int ln_s = lane; asm volatile("" : "+v"(ln_s)); \
            if ((t) <= jmax) { const int vb0 = (int)(uintptr_t)lds + VOFF + (vs_) * SHM_V + v_rd_base(ln_s); FA_PV_D0(0, 0); FA_PV_D0(1, 0); FA_PV_D0(2, 0); FA_PV_D0(3, 0); } } while (0)
#define FA_STEP3(t) do { \
            if ((t) + 1 < NT) { FA_DMA_K(sko, skr, Kh, KRh, (t) + 1, ((t) + 1) & 1); FA_DMA_V(svo, Vh, (t) + 1, vs1); } \
            FA_QK2(t); \
            FA_SM3(t, (t) > 0, vsp); \
            if ((t) == jmax + 1 || ((t) + 1 == NT && jmax + 1 == NT)) { const int vf_ = (t) > jmax ? vsp : vs0; FA_PV3(jmax, vf_); }     \
            FA_WAITBAR(); vsp = vs0; vs0 = vs1; vs1 = vs1 == 2 ? 0 : vs1 + 1; } while (0)

    const int nunits = vcu < 512 ? 2 * ((512 - vcu + G - 1) / G) : 0;
#define FA_UNIT(u_, b_, h_, qb_) do { const int it_ = vcu + G * ((u_) >> 1), bh_ = it_ >> 2, pp_ = it_ & 3; b_ = bh_ >> 5; h_ = bh_ & 31; qb_ = ((u_) & 1) ? pp_ : 7 - pp_; } while (0)
    LAS float* gtl = (LAS float*)(lds + GTOFF);
    if (MODE == 0) { if (tid < QKD) gtl[tid] = tid < 128 ? P.gq[tid] * P.gk[tid] : P.gq[tid]; }
    bf16x8 qr[ND]; f32x16 o[4];
    float m_reg = -1e30f, l_reg = 0.f, carry = 0.f; bool wdone = false; LAS unsigned* ebank = ecnt;
    int b = 0, h = 0, qlo = 0, NT = 0, jmax = 0; const bf16* Kh = nullptr; const bf16* Vh = nullptr; const bf16* KRh = nullptr;
    for (int u = -1; u < nunits; ++u) {
        if (u >= 0) {
            bool stop = false;
            FA_DMA_OFFS(sko, skr, svo)
            if (MODE == 0 && FA_PV_DEFER) {
                f32x16 p0 = f32x16{}, p1 = f32x16{}; bf16x8 pa0 = bf16x8{}, pa1 = bf16x8{}, pa2 = bf16x8{}, pa3 = bf16x8{}; int vsp = 0, vs0 = 0, vs1 = 1;
                for (int t = 0; t < NT; ++t) FA_STEP3(t);
            } else if (MODE == 0 && FA_PP2) {
                const bool grpB = FA_PP2_LAG && wid >= 4; f32x16 p0 = f32x16{}, p1 = f32x16{}; int vsp = 0, vs0 = 0, vs1 = 1;
                for (int t = 0; t < NT; ++t) FA_STEP2(t);
            } else if (MODE == 0 && FA_PP) {
                const bool grpB = wid >= 4; f32x16 p0 = f32x16{}, p1 = f32x16{};
                if (grpB) { FA_DMA_K(sko, skr, Kh, KRh, 1, 1); asm volatile("s_barrier" ::: "memory"); }
                for (int t = 0; t < NT; t += 2) { FA_S1(t, 0); FA_S2(t, 0); FA_S1(t + 1, 1); FA_S2(t + 1, 1); }
                if (!grpB) asm volatile("s_barrier" ::: "memory");
            } else
            for (int t = 0; t < NT; t += 2) { FA_STEP(t, 0); if (MODE == 1 && stop) break; FA_STEP(t + 1, 1); if (MODE == 1 && stop) break; }
        }
        FA_STAMP(0);
        const bool has_next = u + 1 < nunits;
        int b2 = 0, h2 = 0, q2 = 0; if (has_next) FA_UNIT(u + 1, b2, h2, q2);
        const int qlo2 = q2 * 256 + wid * 32, NT2 = 4 * (q2 + 1);
        const bf16* Kh2 = Kp + (size_t)b2 * SEQ * kpitch + h2 * khs; const bf16* Vh2 = Vp + (size_t)b2 * SEQ * vpitch + h2 * vhs; const bf16* KRh2 = MODE == 0 ? P.KR + (size_t)b2 * SEQ * 64 : nullptr;
        int lane_e = lane; asm volatile("" : "+v"(lane_e));
        const int er = lane_e >> 3, ec = lane_e & 7;
        v2u gv[16];
        const bf16* grow = Gp + ((size_t)b * SEQ + qlo + er) * gpitch + h * 128 + 4 * ec;
#define FA_LOAD_G(half) do { if (MODE == 0 || (half) == 0) { _Pragma("unroll") for (int ps = 0; ps < (MODE == 1 ? 4 : 2); ++ps) _Pragma("unroll") for (int i = 0; i < 4; ++i) gv[(2 * (half) + ps) * 4 + i] = *(const GAS v2u*)(grow + (size_t)(8 * i) * gpitch + 32 * (2 * (half) + ps)); } asm volatile("" ::: "memory"); } while (0)
        FA_LOAD_G(0); FA_LOAD_G(1);
        f32x4 csv[8]; f32x4 skv[4]; float spv[4];
        { const size_t mr_ = (size_t)b2 * SEQ + qlo2 + (lane_e & 31);
#pragma unroll
            for (int d0 = 0; d0 < ND; ++d0) qr[d0] = *(const bf16x8*)(Qp + mr_ * qpitch + h2 * qhs + d0 * 16 + (lane_e >> 5) * 8);
        }
        asm volatile("" ::: "memory");
        if (has_next) { FA_DMA_OFFS(tko, tkr, tvo) FA_DMA_GO(tko, tkr, tvo, Kh2, Vh2, KRh2, MODE == 0 ? 0 : NT2 - 1, 0); }
        asm volatile("" ::: "memory");
#define FA_LOAD_CS() do { if (MODE == 0) { const int pos = qlo2 + (lane_e & 31); \
            _Pragma("unroll") for (int dd = 0; dd < 2; ++dd) { const int ri = dd * 16 + (lane_e >> 5) * 8; \
                csv[dd * 4 + 0] = *(const GAS f32x4*)(P.rc + pos * 32 + ri); csv[dd * 4 + 1] = *(const GAS f32x4*)(P.rc + pos * 32 + ri + 4); \
                csv[dd * 4 + 2] = *(const GAS f32x4*)(P.rs + pos * 32 + ri); csv[dd * 4 + 3] = *(const GAS f32x4*)(P.rs + pos * 32 + ri + 4); } } asm volatile("" ::: "memory"); } while (0)
#define FA_LOAD_SK() do { if (MODE == 0) { \
            _Pragma("unroll") for (int i = 0; i < 4; ++i) { const size_t kt_ = (size_t)b2 * SEQ + tid + 512 * i; skv[i] = *(const GAS f32x4*)(P.sskp + (kt_ * NH + h2) * 4); spv[i] = P.sspe[kt_]; } } asm volatile("" ::: "memory"); } while (0)
        if (u >= 0) {
            float inv = 1.f;
            if (MODE == 0) { auto rr = __builtin_amdgcn_permlane32_swap(__float_as_uint(l_reg), __float_as_uint(l_reg), false, false); inv = 1.f / (__uint_as_float(rr[0]) + __uint_as_float(rr[1])); }
            LAS unsigned char* stg = lds + (MODE == 0 ? (wid < 5 ? SHM_K + wid * 4608 : VOFF + SHM_V + (wid - 5) * 4608) : 65536 + wid * 4608);
            LAS unsigned char* stw = stg + (lane_e & 31) * 144 + (lane_e >> 5) * 16;
            const LAS unsigned char* strd = stg + er * 144 + ec * 16;
            bf16* orow = Op + ((size_t)b * SEQ + qlo + er) * DM + h * 128 + 4 * ec;
#define FA_EPI_PASS(ps) do { \
                _Pragma("unroll") for (int g4 = 0; g4 < 4; ++g4) *(LAS f32x4*)(stw + g4 * 32) = (f32x4){o[ps][g4 * 4 + 0] * inv, o[ps][g4 * 4 + 1] * inv, o[ps][g4 * 4 + 2] * inv, o[ps][g4 * 4 + 3] * inv}; \
                _Pragma("unroll") for (int i = 0; i < 4; ++i) { const f32x4 ov = *(const LAS f32x4*)(strd + (8 * i) * 144); const v2u gq_ = gv[(ps) * 4 + i]; \
                    const float g0 = bf_lo(gq_.x), g1 = bf_hi(gq_.x), g2 = bf_lo(gq_.y), g3 = bf_hi(gq_.y); \
                    const float y0 = ov.x * g0 * __builtin_amdgcn_rcpf(1.f + ex2(-1.4426950408889634f * g0)), y1 = ov.y * g1 * __builtin_amdgcn_rcpf(1.f + ex2(-1.4426950408889634f * g1)); \
                    const float y2 = ov.z * g2 * __builtin_amdgcn_rcpf(1.f + ex2(-1.4426950408889634f * g2)), y3 = ov.w * g3 * __builtin_amdgcn_rcpf(1.f + ex2(-1.4426950408889634f * g3)); \
                    v2u w; w.x = cvtpk(y0, y1); w.y = cvtpk(y2, y3); *(GAS v2u*)(orow + (size_t)(8 * i) * DM + 32 * (ps)) = w; } \
                asm volatile("" ::: "memory"); } while (0)
            FA_EPI_PASS(0); FA_LOAD_SK(); FA_LOAD_CS(); FA_EPI_PASS(1); FA_EPI_PASS(2); FA_EPI_PASS(3);
        } else { FA_LOAD_SK(); FA_LOAD_CS(); }
        asm volatile("" ::: "memory");
        if (has_next) {
            if (MODE == 0 && ((u + 1) & 1) == 0) {
                LAS float* rkl = (LAS float*)(lds + RKOFF);
#pragma unroll
                for (int i = 0; i < 4; ++i) rkl[tid + 512 * i] = 1.f / sqrtf((((skv[i].x + skv[i].y) + (skv[i].z + skv[i].w)) + spv[i]) * (1.f / QKD) + EPS); }
            asm volatile("" ::: "memory");
            if (MODE == 0) {
                if (u < 0) asm volatile("s_waitcnt lgkmcnt(0)\n\ts_barrier" ::: "memory");
                float ss = 0.f;
#pragma unroll
                for (int d0 = 0; d0 < ND; ++d0) { float f[8]; unpack8(__builtin_bit_cast(v4u, qr[d0]), f);
#pragma unroll
                    for (int e = 0; e < 8; ++e) ss += f[e] * f[e]; }
                { auto rr = __builtin_amdgcn_permlane32_swap(__float_as_uint(ss), __float_as_uint(ss), false, false); ss = __uint_as_float(rr[0]) + __uint_as_float(rr[1]); }
                const float rq = Q_SCALE_MLA / sqrtf(ss * (1.f / QKD) + EPS);
                const int hi_e = lane_e >> 5; LAS unsigned char* qrl = lds + FA_QRBASE + lane_e * 16;
#pragma unroll
                for (int d0 = 0; d0 < 8; ++d0) { float f[8]; unpack8(__builtin_bit_cast(v4u, qr[d0]), f); const int dd = d0 * 16 + hi_e * 8;
                    const f32x4 a0 = *(const LAS f32x4*)(gtl + dd), a1 = *(const LAS f32x4*)(gtl + dd + 4);
                    f[0] *= rq * a0.x; f[1] *= rq * a0.y; f[2] *= rq * a0.z; f[3] *= rq * a0.w; f[4] *= rq * a1.x; f[5] *= rq * a1.y; f[6] *= rq * a1.z; f[7] *= rq * a1.w;
                    qr[d0] = __builtin_bit_cast(bf16x8, pack8(f)); }
                if (NDR < 8) *(LAS bf16x8*)(qrl + 4 * 1024) = qr[7];
#pragma unroll
                for (int dd = 0; dd < 2; ++dd) { float x1[8], x2[8], o1[8], o2[8]; unpack8(__builtin_bit_cast(v4u, qr[8 + dd]), x1); unpack8(__builtin_bit_cast(v4u, qr[10 + dd]), x2);
                    const int ri = dd * 16 + hi_e * 8;
                    const f32x4 ga0 = *(const LAS f32x4*)(gtl + 128 + ri), ga1 = *(const LAS f32x4*)(gtl + 128 + ri + 4), gb0 = *(const LAS f32x4*)(gtl + 160 + ri), gb1 = *(const LAS f32x4*)(gtl + 160 + ri + 4);
                    const f32x4 c0 = csv[dd * 4 + 0], c1 = csv[dd * 4 + 1], s0 = csv[dd * 4 + 2], s1 = csv[dd * 4 + 3];
                    const float gA[8] = {ga0.x, ga0.y, ga0.z, ga0.w, ga1.x, ga1.y, ga1.z, ga1.w}, gB[8] = {gb0.x, gb0.y, gb0.z, gb0.w, gb1.x, gb1.y, gb1.z, gb1.w};
                    const float cs[8] = {c0.x, c0.y, c0.z, c0.w, c1.x, c1.y, c1.z, c1.w}, sn[8] = {s0.x, s0.y, s0.z, s0.w, s1.x, s1.y, s1.z, s1.w};
#pragma unroll
                    for (int e = 0; e < 8; ++e) { const float a = x1[e] * gA[e], bq = x2[e] * gB[e]; o1[e] = (a * cs[e] - bq * sn[e]) * rq; o2[e] = (a * sn[e] + bq * cs[e]) * rq; }
                    if (NDR >= 12) { qr[8 + dd] = __builtin_bit_cast(bf16x8, pack8(o1)); qr[10 + dd] = __builtin_bit_cast(bf16x8, pack8(o2)); } else { *(LAS bf16x8*)(qrl + dd * 1024) = __builtin_bit_cast(bf16x8, pack8(o1)); *(LAS bf16x8*)(qrl + (2 + dd) * 1024) = __builtin_bit_cast(bf16x8, pack8(o2)); } }
            }
            b = b2; h = h2; qlo = qlo2; NT = NT2; jmax = (qlo2 + 31) >> 6; Kh = Kh2; Vh = Vh2; KRh = KRh2;
#pragma unroll
            for (int d0 = 0; d0 < 4; ++d0) o[d0] = f32x16{};
            m_reg = -1e30f; l_reg = 0.f; carry = 0.f; wdone = false; ebank = ecnt + (un & 1) * 32;
            FA_STAMP(6);
            if (u >= 0) asm volatile("s_waitcnt vmcnt(12) lgkmcnt(0)\n\ts_barrier" ::: "memory");
            else FA_WAITBAR();
            FA_STAMP(5);
            if (MODE == 1) { if (tid < 32) ecnt[((un + 1) & 1) * 32 + tid] = 0u; ++un; }
        }
    }
#undef FA_UNIT
#undef FA_LOAD_CS
#undef FA_LOAD_G
#undef FA_LOAD_SK
#undef FA_EPI_PASS
#undef FA_DMA_OFFS
#undef FA_DMA_GO
#undef FA_WAITBAR
#undef FA_TRRD
#undef FA_PV_D0
#undef FA_STEP
#undef FA_STEP2
#undef FA_STEP3
#undef FA_EXPSLOT
#undef FA_MF
#undef FA_PV_D0I
#undef FA_SM3
#undef FA_PV3
#undef FA_QK2
#undef FA_SMPV2
#undef FA_QRBASE
#undef FA_S1
#undef FA_S2
#undef FA_SLOT_END
#undef FA_DMA_K
#undef FA_DMA_V
#undef FA_STAMP
}
}
struct Args { const float* in[13]; float* out; unsigned char* ws; int ph_lo, ph_hi; };
__global__ void __launch_bounds__(NWAVES * 64, 2) hybrid_fwd(Args args) {
    extern __shared__ __attribute__((aligned(16))) unsigned char lds_raw[];
    LAS unsigned char* lds = (LAS unsigned char*)lds_raw;
    volatile LAS unsigned* MISC = (volatile LAS unsigned*)(lds + MISC_OFF);
    const int tid = threadIdx.x, lane = tid & 63, wave = __builtin_amdgcn_readfirstlane(tid >> 6);
    const int G = gridDim.x, bx = blockIdx.x;
    const int vcu = (G % 8 == 0) ? (bx % 8) * (G / 8) + bx / 8 : bx;
    const int gw = vcu * NWAVES + wave, NGW = G * NWAVES;
    unsigned char* ws = args.ws;
    gu32* ctl = (gu32*)(ws + WS_CTL);
    for (int u = tid; u < (LDS_BYTES - LDSCTL_OFF) / 4; u += NWAVES * 64) ((LAS unsigned*)(lds + LDSCTL_OFF))[u] = 0u;
    __syncthreads();
#if MK_ONE_LAUNCH
    XcdBarrier bar = xcd_barrier_post((unsigned*)(ctl + CW_BAR), MISC + 8);
#if PROBE_BAR
#define GRID_BAR(kk) do { const unsigned tb0_ = (unsigned)__builtin_amdgcn_s_memtime(); xcd_barrier(bar); if ((PROBE_BARMASK >> (kk)) & 1u) tacc += (unsigned)__builtin_amdgcn_s_memtime() - tb0_; } while (0)
#else
#define GRID_BAR(kk) xcd_barrier(bar)
#endif
#else
    (void)MISC; (void)ctl;
#define GRID_BAR(kk) do { } while (0)
#endif
    const int lo = args.ph_lo, hi = args.ph_hi;
    P1Fill fill{args.in, ws, ctl + CW_P0Q, (LAS float*)(lds + RING_OFF + wave * 16384), 0, P1_CHUNK};
    unsigned tacc = 0;
#define IN(k) (lo <= (k) && (k) < hi)
#define SEAM(k) do { if (IN(k) && IN((k) + 1)) GRID_BAR(k); } while (0)
#if MK_ONE_LAUNCH
#if PROBE_BAR
#define SEAM_FILL(k) do { if (IN(k) && IN((k) + 1)) { const unsigned tb0_ = (unsigned)__builtin_amdgcn_s_memtime(); xcd_barrier_fill(bar, fill, wave, lane); if (PROBE_BAR == 1 && ((PROBE_BARMASK >> (k)) & 1u)) tacc += (unsigned)__builtin_amdgcn_s_memtime() - tb0_; } } while (0)
#else
#define SEAM_FILL(k) do { if (IN(k) && IN((k) + 1)) { xcd_barrier_fill(bar, fill, wave, lane); if (PROBE_BAR2) { xcd_barrier(bar); } } } while (0)
#endif
#else
#define SEAM_FILL(k) SEAM(k)
#endif
#define DRAIN(k, limit) do { if (IN(k)) { const unsigned td0_ = PROBE_BAR == 2 ? (unsigned)__builtin_amdgcn_s_memtime() : 0u; __syncthreads(); while (fill.item(lane, (limit))) { } if (PROBE_BAR == 2 && ((PROBE_BARMASK >> (k)) & 1u)) tacc += (unsigned)__builtin_amdgcn_s_memtime() - td0_; } } while (0)
    const float* x_in = args.in[0]; float* out = args.out;
    float* ropec = (float*)(ws + WS_ROPE); float* ropes = ropec + SEQ * 32;
    bf16* XB = (bf16*)(ws + A_XN); bf16* XLO = (bf16*)(ws + A_XLO); bf16* PROJ = (bf16*)(ws + A_PROJ);
    bf16* QLAT = (bf16*)(ws + A_QN); bf16* KVLAT = (bf16*)(ws + A_KVN); bf16* QRAW = (bf16*)(ws + A_QRAW); bf16* KVRAW = (bf16*)(ws + A_KVRAW); bf16* OG = (bf16*)(ws + A_OG);
    bf16* KPER = (bf16*)(ws + A_KPER); float* SSPE = (float*)(ws + A_SSPE); float* SSKP = (float*)(ws + A_SSKP);
    unsigned long long* SSX = (unsigned long long*)(ws + WS_SS);
    unsigned long long* SSQ = SSX + 4 * M; unsigned long long* SSKV = SSX + 6 * M;

    if (IN(0)) {
        LAS float* scr = (LAS float*)(lds + RING_OFF + wave * 16384);
        x_to_bf16_rows(x_in, XB, XLO, SSX, gw, NGW, lane);
        p0_transpose(args.in[2], DM, MLA_IN, (bf16*)(ws + WS_W + W_IN_MLA), scr, gw, NGW, lane, args.in[1]);
        { GAS v4u* pad = (GAS v4u*)(ws + WS_W + W_IN_MLA + (size_t)MLA_IN * DM * 2);
          for (int i = vcu * 512 + tid; i < (MLA_INP - MLA_IN) * DM * 2 / 16; i += G * 512) pad[i] = (v4u){0u, 0u, 0u, 0u}; }
        { GAS v4u* pad1 = (GAS v4u*)(ws + WS_W + W_LAYER + W_IN_MLA + (size_t)MLA_IN * DM * 2);
          for (int i = vcu * 512 + tid; i < (MLA_INP - MLA_IN) * DM * 2 / 16; i += G * 512) pad1[i] = (v4u){0u, 0u, 0u, 0u}; }
        for (int i = vcu * 512 + tid; i < SEQ * 32; i += G * 512) { const int pos = i >> 5, p = i & 31;
            const float inv = 1.0f / powf(10000.0f, (float)(2 * p) / 64.0f), ang = (float)pos * inv; ropec[i] = cosf(ang); ropes[i] = sinf(ang); }
    }
    SEAM_FILL(0);

    for (int L = 0; L < 2; ++L) {
        const int pb = 1 + 7 * L;
        unsigned char* wl = ws + WS_W + (size_t)L * W_LAYER;
        if (IN(pb + 0)) { pg8::Gemm g{XB, (const bf16*)(wl + W_IN_MLA), M, MLA_INP, DM, DM}; pg8::StaticOrder S; S.init(M, MLA_INP, G, bx);
            PG8_LAS float* rst = (PG8_LAS float*)(lds + LDSCTL_OFF + 2048);
            pg8::rstd_table_fill(rst, SSX + (size_t)(2 * L) * M, 1.f / DM, S, tid); pg8::EpiBf16S<1> E{PROJ, MLA_INP, rst, SSQ + (size_t)L * M, SSKV + (size_t)L * M, QLAT, KVLAT, nullptr, 0.f};
            pg8::gemm_phase<pg8::EpiBf16S<1>, pg8::StaticOrder, PG8_ALIGN, PG8_SP2>(lds + RING_OFF, g, S, E); }
        DRAIN(pb + 0, L == 0 ? FQ_KV0 : FQ_KV1);
        SEAM_FILL(pb + 0);
        if (IN(pb + 1)) {
            kpe_rows(PROJ, args.in[8] + (size_t)L * QKD, ropec, ropes, KPER, SSPE, gw, NGW, lane);
            { pg8::Gemm g{QLAT, (const bf16*)(wl + W_QB), M, NQ, QL, QL}; pg8::StaticOrder S; S.init(M, NQ, G, bx);
              PG8_LAS float* rst = (PG8_LAS float*)(lds + LDSCTL_OFF + 2048);
              pg8::rstd_table_fill(rst, SSQ + (size_t)L * M, 1.f / QL, S, tid); pg8::EpiBf16S<0> E{QRAW, NQ, rst, nullptr, nullptr, nullptr, nullptr, nullptr, 0.f}; pg8::gemm_phase<pg8::EpiBf16S<0>, pg8::StaticOrder, PG8_ALIGN, PG8_SP2>(lds + RING_OFF, g, S, E, PROBE_SITE == 2 ? &tacc : nullptr); }
            { pg8::Gemm g{KVLAT, (const bf16*)(wl + W_KVB), M, NKV, KVL, KVL}; pg8::StaticOrder S; S.init(M, NKV, G, bx);
              PG8_LAS float* rst = (PG8_LAS float*)(lds + LDSCTL_OFF + 2048);
              pg8::rstd_table_fill(rst, SSKV + (size_t)L * M, 1.f / KVL, S, tid); pg8::EpiKV E{KVRAW, NKV, rst, SSKP, nullptr, 0.f}; pg8::gemm_phase<pg8::EpiKV, pg8::StaticOrder, PG8_ALIGN, PG8_SP2>(lds + RING_OFF, g, S, E, PROBE_SITE == 3 ? &tacc : nullptr); }
        }
        SEAM_FILL(pb + 1);
        if (IN(pb + 2)) { const fa::AttnP P{QRAW, NQ, QKD, KVRAW, NKV, 256, KVRAW + 128, NKV, 256, PROJ + C_GATE, MLA_INP, OG, KPER, SSKP, SSPE, args.in[7] + (size_t)L * QKD, args.in[8] + (size_t)L * QKD, ropec, ropes};
            fa::attn_phase<0>(lds, P, G, vcu, (LAS unsigned*)(lds + LDSCTL_OFF), tacc); }
        DRAIN(pb + 2, L == 0 ? FQ_OM0 : FQ_OM1);
        SEAM_FILL(pb + 2);
        if (IN(pb + 3)) { if (OUTPROJ_STAGGER && (bx & 4)) { const unsigned long long t0_ = __builtin_amdgcn_s_memtime(); while (__builtin_amdgcn_s_memtime() - t0_ < (unsigned long long)OUTPROJ_STAGGER) { if (!fill.item(lane)) break; } __syncthreads(); }     pg8::Gemm g{OG, (const bf16*)(wl + W_OUT_MLA), M, DM, DM, DM}; pg8::StaticOrder S; S.init(M, DM, G, bx);
            pg8::EpiResHL E{XB, XLO, DM, nullptr, SSX + (size_t)(2 * L + 1) * M}; pg8::gemm_phase<pg8::EpiResHL, pg8::StaticOrder, PG8_ALIGN, PG8_SP2>(lds + RING_OFF, g, S, E, PROBE_SITE == 4 ? &tacc : nullptr); }
        DRAIN(pb + 3, L == 0 ? FQ_IS0 : FQ_IS1);
        SEAM_FILL(pb + 3);
        if (IN(pb + 4)) { pg8::Gemm g{XB, (const bf16*)(wl + W_IN_SB), M, SB_IN, DM, DM}; pg8::StaticOrder S; S.init(M, SB_IN, G, bx);
            PG8_LAS float* rst = (PG8_LAS float*)(lds + LDSCTL_OFF + 2048);
            pg8::rstd_table_fill(rst, SSX + (size_t)(2 * L + 1) * M, 1.f / DM, S, tid); pg8::EpiBf16S<0> E{PROJ, SB_IN, rst, nullptr, nullptr, nullptr, nullptr, nullptr, 0.f}; pg8::gemm_phase<pg8::EpiBf16S<0>, pg8::StaticOrder, PG8_ALIGN, PG8_SP2>(lds + RING_OFF, g, S, E, PROBE_SITE == 8 ? &tacc : nullptr); }
        SEAM_FILL(pb + 4);
        if (IN(pb + 5)) { const fa::AttnP P{PROJ, SB_IN, 128, PROJ + C_SBK, SB_IN, 128, PROJ + C_SBV, SB_IN, 128, PROJ + C_SBG, SB_IN, OG, nullptr, nullptr, nullptr, nullptr, nullptr, nullptr, nullptr};
            fa::attn_phase<1>(lds, P, G, vcu, (LAS unsigned*)(lds + LDSCTL_OFF), tacc); }
        DRAIN(pb + 5, L == 0 ? FQ_OS0 : FQ_OS1);
        SEAM_FILL(pb + 5);
        if (IN(pb + 6)) { if (OUTPROJ_STAGGER && (bx & 4)) { const unsigned long long t0_ = __builtin_amdgcn_s_memtime(); while (__builtin_amdgcn_s_memtime() - t0_ < (unsigned long long)OUTPROJ_STAGGER) { if (!fill.item(lane)) break; } __syncthreads(); }     pg8::Gemm g{OG, (const bf16*)(wl + W_OUT_SB), M, DM, DM, DM}; pg8::StaticOrder S; S.init(M, DM, G, bx);
            pg8::EpiResHL E{XB, XLO, DM, (L == 0) ? (float*)nullptr : out, SSX + (size_t)2 * M}; pg8::gemm_phase<pg8::EpiResHL, pg8::StaticOrder, PG8_ALIGN, PG8_SP2>(lds + RING_OFF, g, S, E); }
        DRAIN(pb + 6, L == 0 ? FQ_IM1 : FQ_ITEMS);
        SEAM_FILL(pb + 6);
    }
#if PROBE_SEG || PROBE_GEMM || PROBE_BAR
    if (bx == PROBE_BLOCK && wave == 0) { const unsigned long long t0 = __builtin_amdgcn_s_memrealtime(), want = (unsigned long long)(tacc >> PROBE_SHIFT); while (__builtin_amdgcn_s_memrealtime() - t0 < want) __builtin_amdgcn_s_sleep(8); }
#endif
#undef IN
#undef SEAM
}

extern "C" void kernel_launch(void* const* d_in, const int* in_sizes, int n_in, void* d_out, int out_size, void* d_ws, size_t ws_size, hipStream_t stream) {
    static int grid = 0;
    if (grid == 0) {
        if (n_in != 13 || in_sizes[0] != M * DM || out_size != M * DM || ws_size < WS_END) { fprintf(stderr, "kernel_launch: unexpected shapes (n_in %d, in0 %d, out %d, ws %zu; need ws >= %zu); nothing launched\n", n_in, n_in > 0 ? in_sizes[0] : -1, out_size, ws_size, (size_t)WS_END); grid = -1; return; }
        int dev = 0, cus = 0, per_cu = 0;
        if (hipGetDevice(&dev) != hipSuccess || hipDeviceGetAttribute(&cus, hipDeviceAttributeMultiprocessorCount, dev) != hipSuccess) { fprintf(stderr, "kernel_launch: device query failed\n"); grid = -1; return; }
        if (hipFuncSetAttribute((const void*)hybrid_fwd, hipFuncAttributeMaxDynamicSharedMemorySize, LDS_BYTES) != hipSuccess) { fprintf(stderr, "kernel_launch: hipFuncSetAttribute failed\n"); grid = -1; return; }
        if (hipOccupancyMaxActiveBlocksPerMultiprocessor(&per_cu, (const void*)hybrid_fwd, NWAVES * 64, LDS_BYTES) != hipSuccess || per_cu < 1)
            fprintf(stderr, "kernel_launch: note: occupancy query reports %d workgroups per CU\n", per_cu);
        (void)hipGetLastError();
        grid = cus;
    }
    if (grid < 0) return;
    if (hipMemsetAsync((char*)d_ws + WS_CTL, 0, CTL_ZERO_BYTES, stream) != hipSuccess) { fprintf(stderr, "kernel_launch: memset failed\n"); return; }
    Args a{};
    for (int i = 0; i < 13; ++i) a.in[i] = (const float*)d_in[i];
    a.out = (float*)d_out; a.ws = (unsigned char*)d_ws;
#if MK_ONE_LAUNCH
    a.ph_lo = 0; a.ph_hi = N_PHASES;
    hipLaunchKernelGGL(hybrid_fwd, dim3(grid), dim3(NWAVES * 64), LDS_BYTES, stream, a);
#ifdef PROBE_PHASES
    { static const int probe_ph[] = {PROBE_PHASES};
      for (int r = 0; r < PROBE_NREP; ++r) for (int ph : probe_ph) { a.ph_lo = ph; a.ph_hi = ph + 1; hipLaunchKernelGGL(hybrid_fwd, dim3(grid), dim3(NWAVES * 64), LDS_BYTES, stream, a); } }
#endif
#else
    for (int ph = 0; ph < N_PHASES; ++ph) { a.ph_lo = ph; a.ph_hi = ph + 1; hipLaunchKernelGGL(hybrid_fwd, dim3(grid), dim3(NWAVES * 64), LDS_BYTES, stream, a); }
#endif
    const hipError_t le = hipPeekAtLastError();
    if (le != hipSuccess) fprintf(stderr, "kernel_launch: launch failed: %s\n", hipGetErrorName(le));
}
```

```cpp
#include <hip/hip_runtime.h>
#include <cstdio>
#include <cstdint>
#ifndef PROBE_GEMM
#define PROBE_GEMM 0
#endif
#ifndef PG8_POSTEPI
#define PG8_POSTEPI 0
#endif
namespace pg8 {
#define PG8_LAS __attribute__((address_space(3)))
typedef unsigned short bf16_t;
typedef short bf16x8 __attribute__((ext_vector_type(8)));
typedef float f32x4 __attribute__((ext_vector_type(4)));

#ifndef PG8_WT
#define PG8_WT 0
#endif
typedef unsigned u32x4 __attribute__((ext_vector_type(4)));
__device__ __forceinline__ void st16_wt(void* p, u32x4 v) {
#if PG8_WT
    asm volatile("global_store_dwordx4 %0, %1, off sc1\n\ts_nop 1" :: "v"(p), "v"(v));
#else
    *(u32x4*)p = v;
#endif
}
constexpr int BM = 256, BK = 64, HALF = 128, HTB = HALF * BK * 2  , STAGE_BYTES = 8 * HTB, NXCD = 8, WGM = 8;

__host__ __device__ __forceinline__ int lds_byte(int r, int c) { const int st = (r >> 4) * 2 + (c >> 5), rr = r & 15, cc = c & 31, ob = rr * 64 + cc * 2; return st * 1024 + (ob ^ (((ob >> 9) & 1) << 5)); }
__host__ __device__ __forceinline__ void stage_rc(int b, int& R, int& C) { const int st = b / 1024, sb = b % 1024, swz = sb ^ (((sb >> 9) & 1) << 5); R = (st >> 1) * 16 + swz / 64; C = (st & 1) * 32 + (swz % 64) / 2; }
__host__ __device__ __forceinline__ int perm32(int rho) { const int n = rho >> 4, i = rho & 15; return 8 * (i >> 2) + 4 * n + (i & 3); }

struct Unit { int pm, pn; };
struct Gemm { const bf16_t* A; const bf16_t* Bt; int M, N, K, lda; };

struct StaticOrder {
    int nM, nN, nwg, G, c;
    __host__ __device__ void init(int M, int N, int G_, int c_) { nM = M / BM; nN = N / BM; nwg = nM * nN; G = G_; c = c_; }
    __host__ __device__ bool next(int i, Unit& u) const {
        const long L = (long)i * G + c; if (L >= nwg) return false;
        int wgid = (int)L; { const int q = nwg / NXCD, r = nwg % NXCD, xcd = wgid % NXCD, off = wgid / NXCD; wgid = (xcd < r ? xcd * (q + 1) : r * (q + 1) + (xcd - r) * q) + off; }
        const int nig = WGM * nN, gid = wgid / nig, fm = gid * WGM, gsz = (nM - fm) < WGM ? (nM - fm) : WGM;
        u.pm = fm + ((wgid % nig) % gsz); u.pn = (wgid % nig) / gsz; return true;
    }
    __device__ __forceinline__ void a_ready(const Unit&) const {}
    __device__ __forceinline__ void done(const Unit&) const {}
};

__device__ __forceinline__ unsigned cvt_pk_bf16(float lo, float hi) { unsigned r; asm volatile("v_cvt_pk_bf16_f32 %0, %1, %2" : "=v"(r) : "v"(lo), "v"(hi)); return r; }
struct EpiBf16 {
    static constexpr bool PERM = true, AFTER_DRAIN = false; static constexpr bool HAS_TABLE = false; static constexpr int NST = 0;
    bf16_t* O; int ldc;
    __device__ __forceinline__ void operator()(const f32x4 (&acc)[2][2][4][2], const Unit& u, int wr, int wc, int fr, int fq, int ui) const {
        const int row0 = u.pm * BM + wr * 64 + fr; const int col0 = u.pn * BM + wc * 32 + 8 * fq;
#pragma unroll
        for (int ai = 0; ai < 2; ++ai)
#pragma unroll
            for (int m = 0; m < 4; ++m) { bf16_t* rowp = O + (size_t)(row0 + ai * HALF + m * 16) * ldc + col0;
#pragma unroll
                for (int bj = 0; bj < 2; ++bj) { const f32x4 v0 = acc[ai][bj][m][0], v1 = acc[ai][bj][m][1];
                    u32x4 w; w.x = cvt_pk_bf16(v0[0], v0[1]); w.y = cvt_pk_bf16(v0[2], v0[3]); w.z = cvt_pk_bf16(v1[0], v1[1]); w.w = cvt_pk_bf16(v1[2], v1[3]);
                    *(u32x4*)(rowp + bj * HALF) = w; } }
    }
};
struct EpiResF32 {
    static constexpr bool PERM = true, AFTER_DRAIN = false; static constexpr bool HAS_TABLE = false; static constexpr int NST = 0;
    const float* base; float* out; int ldc;
    __device__ __forceinline__ void operator()(const f32x4 (&acc)[2][2][4][2], const Unit& u, int wr, int wc, int fr, int fq, int ui) const {
        const int row0 = u.pm * BM + wr * 64 + fr; const int col0 = u.pn * BM + wc * 32 + 8 * fq;
#pragma unroll
        for (int ai = 0; ai < 2; ++ai)
#pragma unroll
            for (int m = 0; m < 4; ++m) { const size_t off = (size_t)(row0 + ai * HALF + m * 16) * ldc + col0;
#pragma unroll
                for (int bj = 0; bj < 2; ++bj) {
                    const f32x4 b0 = *(const f32x4*)(base + off + bj * HALF), b1 = *(const f32x4*)(base + off + bj * HALF + 4);
                    *(f32x4*)(out + off + bj * HALF) = b0 + acc[ai][bj][m][0]; *(f32x4*)(out + off + bj * HALF + 4) = b1 + acc[ai][bj][m][1]; } }
    }
};

constexpr float SS_FIX = 1048576.f, SS_UNFIX = 1.f / 1048576.f;
__device__ __forceinline__ float rstd_of(const unsigned long long* ss, int row, float inv_n) { return 1.f / sqrtf((float)ss[row] * (SS_UNFIX * inv_n) + 1e-6f); }
__device__ __forceinline__ void ss_add(unsigned long long* ss, int row, float part, int fq) {
    part += __shfl_xor(part, 16); part += __shfl_xor(part, 32);
    if (fq == 0) atomicAdd(ss + row, (unsigned long long)(part * SS_FIX));
}
__device__ __forceinline__ void rstd_table_fill(PG8_LAS float* rst, const unsigned long long* ss, float inv_n, const StaticOrder& S, int tid) {
    int tl = tid; asm volatile("" : "+v"(tl));
    const int half = __builtin_amdgcn_readfirstlane(tl >> 8), r = tl & (BM - 1);
    for (int i0 = 0; ; i0 += 8) {
        Unit u; unsigned long long raw[4]; bool ok[4];
#pragma unroll
        for (int k = 0; k < 4; ++k) { ok[k] = S.next(i0 + 2 * k + half, u); raw[k] = ok[k] ? ss[u.pm * BM + r] : 0ull; }
#pragma unroll
        for (int k = 0; k < 4; ++k) if (ok[k]) rst[(i0 + 2 * k + half) * BM + r] = 1.f / sqrtf((float)raw[k] * (SS_UNFIX * inv_n) + 1e-6f);
        if (!ok[3]) break;
    }
    asm volatile("s_waitcnt vmcnt(0) lgkmcnt(0)\n\ts_barrier" ::: "memory");
}
template <int SSMODE> struct EpiBf16S {
    static constexpr bool PERM = true, AFTER_DRAIN = false; static constexpr bool HAS_TABLE = true; static constexpr int NST = 16;
    bf16_t* O; int ldc; const PG8_LAS float* rst; unsigned long long* ss1; unsigned long long* ss2; bf16_t* O1; bf16_t* O2; const unsigned long long* ssin; float inv_n;
    __device__ __forceinline__ void operator()(const f32x4 (&acc)[2][2][4][2], const Unit& u, int wr, int wc, int fr, int fq, int ui) const {
        const int row0 = u.pm * BM + wr * 64 + fr; int col0 = u.pn * BM + wc * 32 + 8 * fq;
        bf16_t* Ob = O; int ld = ldc;
        if (SSMODE == 1) { if (u.pn < 4) { Ob = O1; ld = 1024; } else if (u.pn < 6) { Ob = O2; ld = 512; col0 -= 1024; } }
#pragma unroll
        for (int ai = 0; ai < 2; ++ai)
#pragma unroll
            for (int m = 0; m < 4; ++m) { const int row = row0 + ai * HALF + m * 16; const float rs = rst[ui * BM + (row - u.pm * BM)]; bf16_t* rowp = Ob + (size_t)row * ld + col0; float part = 0.f;
#pragma unroll
                for (int bj = 0; bj < 2; ++bj) { const f32x4 v0 = acc[ai][bj][m][0] * rs, v1 = acc[ai][bj][m][1] * rs;
                    if (SSMODE == 1) part += (v0[0] * v0[0] + v0[1] * v0[1]) + (v0[2] * v0[2] + v0[3] * v0[3]) + (v1[0] * v1[0] + v1[1] * v1[1]) + (v1[2] * v1[2] + v1[3] * v1[3]);
                    u32x4 w; w.x = cvt_pk_bf16(v0[0], v0[1]); w.y = cvt_pk_bf16(v0[2], v0[3]); w.z = cvt_pk_bf16(v1[0], v1[1]); w.w = cvt_pk_bf16(v1[2], v1[3]);
                    st16_wt(rowp + bj * HALF, w); }
                if (SSMODE == 1) { if (u.pn < 6) ss_add(u.pn < 4 ? ss1 : ss2, row, part, fq); } }
    }
};
struct EpiResHL {
    static constexpr bool PERM = true, AFTER_DRAIN = false; static constexpr bool HAS_TABLE = false; static constexpr int NST = 48;
    bf16_t* hi; bf16_t* lo; int ldc; float* outf; unsigned long long* ss;
    static __device__ __forceinline__ float blo_(unsigned w) { return __uint_as_float(w << 16); }
    static __device__ __forceinline__ float bhi_(unsigned w) { return __uint_as_float(w & 0xffff0000u); }
    __device__ __forceinline__ void operator()(f32x4 (&acc)[2][2][4][2], const Unit& u, int wr, int wc, int fr, int fq, int ui) const {
        const int row0 = u.pm * BM + wr * 64 + fr; const int col0 = u.pn * BM + wc * 32 + 8 * fq;
        u32x4 ph[2][2], pl[2][2];
#define ERX_LOAD(ai, mh) do { _Pragma("unroll") for (int m2 = 0; m2 < 2; ++m2) { const size_t off = (size_t)(row0 + (ai) * HALF + (2 * (mh) + m2) * 16) * ldc + col0; \
            _Pragma("unroll") for (int bj = 0; bj < 2; ++bj) { ph[m2][bj] = *(const u32x4*)(hi + off + bj * HALF); pl[m2][bj] = *(const u32x4*)(lo + off + bj * HALF); } } asm volatile("" ::: "memory"); } while (0)
#define ERX_SUM(ai, mh) do { _Pragma("unroll") for (int m2 = 0; m2 < 2; ++m2) _Pragma("unroll") for (int bj = 0; bj < 2; ++bj) { const u32x4 h_ = ph[m2][bj], l_ = pl[m2][bj]; \
            acc[ai][bj][2 * (mh) + m2][0] += (f32x4){blo_(h_.x) + blo_(l_.x), bhi_(h_.x) + bhi_(l_.x), blo_(h_.y) + blo_(l_.y), bhi_(h_.y) + bhi_(l_.y)}; \
            acc[ai][bj][2 * (mh) + m2][1] += (f32x4){blo_(h_.z) + blo_(l_.z), bhi_(h_.z) + bhi_(l_.z), blo_(h_.w) + blo_(l_.w), bhi_(h_.w) + bhi_(l_.w)}; \
            asm volatile("" : "+v"(acc[ai][bj][2 * (mh) + m2][0]), "+v"(acc[ai][bj][2 * (mh) + m2][1])); } } while (0)
#define ERX_STORE(ai, mh) do { _Pragma("unroll") for (int m2 = 0; m2 < 2; ++m2) { const int m = 2 * (mh) + m2; const int row = row0 + (ai) * HALF + m * 16; const size_t off = (size_t)row * ldc + col0; float part = 0.f; \
            _Pragma("unroll") for (int bj = 0; bj < 2; ++bj) { const f32x4 o0 = acc[ai][bj][m][0], o1 = acc[ai][bj][m][1]; \
                if (outf) { st16_wt(outf + off + bj * HALF, __builtin_bit_cast(u32x4, o0)); st16_wt(outf + off + bj * HALF + 4, __builtin_bit_cast(u32x4, o1)); } \
                else { part += (o0[0] * o0[0] + o0[1] * o0[1]) + (o0[2] * o0[2] + o0[3] * o0[3]) + (o1[0] * o1[0] + o1[1] * o1[1]) + (o1[2] * o1[2] + o1[3] * o1[3]); \
                    u32x4 w; w.x = cvt_pk_bf16(o0[0], o0[1]); w.y = cvt_pk_bf16(o0[2], o0[3]); w.z = cvt_pk_bf16(o1[0], o1[1]); w.w = cvt_pk_bf16(o1[2], o1[3]); \
                    u32x4 r; r.x = cvt_pk_bf16(o0[0] - blo_(w.x), o0[1] - bhi_(w.x)); r.y = cvt_pk_bf16(o0[2] - blo_(w.y), o0[3] - bhi_(w.y)); r.z = cvt_pk_bf16(o1[0] - blo_(w.z), o1[1] - bhi_(w.z)); r.w = cvt_pk_bf16(o1[2] - blo_(w.w), o1[3] - bhi_(w.w)); \
                    st16_wt(hi + off + bj * HALF, w); st16_wt(lo + off + bj * HALF, r); } } \
            if (!outf) ss_add(ss, row, part, fq); } asm volatile("" ::: "memory"); } while (0)
        ERX_LOAD(0, 0); ERX_SUM(0, 0); ERX_LOAD(0, 1); ERX_STORE(0, 0); ERX_SUM(0, 1); ERX_LOAD(1, 0); ERX_STORE(0, 1); ERX_SUM(1, 0); ERX_LOAD(1, 1); ERX_STORE(1, 0); ERX_SUM(1, 1); ERX_STORE(1, 1);
#undef ERX_LOAD
#undef ERX_SUM
#undef ERX_STORE
    }
};
struct EpiKV {
    static constexpr bool PERM = true, AFTER_DRAIN = false; static constexpr bool HAS_TABLE = true; static constexpr int NST = 16;
    bf16_t* O; int ldc; const PG8_LAS float* rst; float* sskp; const unsigned long long* ssin; float inv_n;
    __device__ __forceinline__ void operator()(const f32x4 (&acc)[2][2][4][2], const Unit& u, int wr, int wc, int fr, int fq, int ui) const {
        const int row0 = u.pm * BM + wr * 64 + fr; const int col0 = u.pn * BM + wc * 32 + 8 * fq;
#pragma unroll
        for (int ai = 0; ai < 2; ++ai)
#pragma unroll
            for (int m = 0; m < 4; ++m) { const int row = row0 + ai * HALF + m * 16; const float rs = rst[ui * BM + (row - u.pm * BM)]; bf16_t* rowp = O + (size_t)row * ldc + col0; float part = 0.f;
#pragma unroll
                for (int bj = 0; bj < 2; ++bj) { const f32x4 v0 = acc[ai][bj][m][0] * rs, v1 = acc[ai][bj][m][1] * rs;
                    if (bj == 0) part = (v0[0] * v0[0] + v0[1] * v0[1]) + (v0[2] * v0[2] + v0[3] * v0[3]) + (v1[0] * v1[0] + v1[1] * v1[1]) + (v1[2] * v1[2] + v1[3] * v1[3]);
                    u32x4 w; w.x = cvt_pk_bf16(v0[0], v0[1]); w.y = cvt_pk_bf16(v0[2], v0[3]); w.z = cvt_pk_bf16(v1[0], v1[1]); w.w = cvt_pk_bf16(v1[2], v1[3]);
                    st16_wt(rowp + bj * HALF, w); }
                part += __shfl_xor(part, 16); part += __shfl_xor(part, 32);
                if (fq == 0) sskp[((size_t)row * 32 + u.pn) * 4 + wc] = part; }
    }
};

template <class Epi, class Sched, bool ALIGN_EPI = false, bool SP2 = false>
__device__ __forceinline__ void gemm_phase(PG8_LAS unsigned char* lds, const Gemm g, const Sched& S, const Epi& E, unsigned* tp = nullptr) {
#if PROBE_GEMM
    const unsigned tg0 = (unsigned)__builtin_amdgcn_s_memtime(); unsigned tgk = 0;
#endif
    int tid_l = threadIdx.x; asm volatile("" : "+v"(tid_l));
    const int tid = tid_l, wid = __builtin_amdgcn_readfirstlane(tid >> 6), lane = tid & 63, wr = wid >> 2, wc = wid & 3, fr = lane & 15, fq = lane >> 4;
    const int K = g.K, nt = K / BK;
    unsigned voffA[2], voffB[2];
#pragma unroll
    for (int i = 0; i < 2; ++i) { int R, C; stage_rc(tid * 16 + i * 8192, R, C); const int Rb = Epi::PERM ? ((R & ~31) + perm32(R & 31)) : R;
        voffA[i] = (unsigned)(R * g.lda + C) * 2u; voffB[i] = (unsigned)(Rb * K + C) * 2u; }
    const size_t kstep = (size_t)(BK * 2);
    const size_t hstep = (size_t)HALF * K * 2;
    const size_t tstep = 2 * hstep;
    const size_t hstepA = (size_t)HALF * g.lda * 2, tstepA = 2 * hstepA;
    const unsigned ldsw = (unsigned)wid * 1024u;
    const int aoff = lds_byte(wr * 64 + fr, fq * 8), boff = lds_byte(wc * 32 + fr, fq * 8);
#define PG8_SA(b, h) (((b) * 2 + (h)) * HTB)
#define PG8_SB(b, h) ((4 + (b) * 2 + (h)) * HTB)
#define PG8_STAGE(bufoff, gbase, voff) do { _Pragma("unroll") for (int _i = 0; _i < 2; ++_i) \
        __builtin_amdgcn_global_load_lds((const unsigned*)((const char*)(gbase) + (voff)[_i]), (PG8_LAS unsigned*)(lds + (bufoff) + ldsw + _i * 8192), 16, 0, 0); } while (0)
#define PG8_LDA(dst, b, h) do { _Pragma("unroll") for (int m = 0; m < 4; ++m) _Pragma("unroll") for (int k = 0; k < 2; ++k) dst[m][k] = *(const PG8_LAS bf16x8*)(lds + PG8_SA(b, h) + aoff + m * 2048 + k * 1024); } while (0)
#define PG8_LDB(dst, b, h) do { _Pragma("unroll") for (int n = 0; n < 2; ++n) _Pragma("unroll") for (int k = 0; k < 2; ++k) dst[n][k] = *(const PG8_LAS bf16x8*)(lds + PG8_SB(b, h) + boff + n * 2048 + k * 1024); } while (0)
#define PG8_MMA(ai, bj, At, Bt) do { __builtin_amdgcn_s_setprio(1); _Pragma("unroll") for (int m = 0; m < 4; ++m) _Pragma("unroll") for (int n = 0; n < 2; ++n) _Pragma("unroll") for (int k = 0; k < 2; ++k) \
        acc[ai][bj][m][n] = __builtin_amdgcn_mfma_f32_16x16x32_bf16(Bt[n][k], At[m][k], acc[ai][bj][m][n], 0, 0, 0); __builtin_amdgcn_s_setprio(0); } while (0)
#define PG8_WAIT_V(n) asm volatile("s_waitcnt vmcnt(" #n ")" ::: "memory")
#define PG8_WAIT_L(n) asm volatile("s_waitcnt lgkmcnt(" #n ")" ::: "memory")
#define PG8_WAIT_VP(post_) asm volatile("s_waitcnt vmcnt(%1)\n\ts_cmp_lg_u32 %0, 0\n\ts_cbranch_scc1 .Lpg8post%=\n\ts_waitcnt vmcnt(8)\n.Lpg8post%=:" :: "s"(post_), "n"(8 + Epi::NST) : "memory", "scc")
#define PG8_BAR __builtin_amdgcn_s_barrier()
#define PG8_SCHED __builtin_amdgcn_sched_barrier(0)
    Unit cur, nxt; int ui = 0;
    if (!S.next(0, cur)) return;
    f32x4 acc[2][2][4][2];
#pragma unroll
    for (int a = 0; a < 2; ++a)
#pragma unroll
        for (int b = 0; b < 2; ++b)
#pragma unroll
            for (int m = 0; m < 4; ++m)
#pragma unroll
                for (int n = 0; n < 2; ++n) acc[a][b][m][n] = (f32x4){0.f, 0.f, 0.f, 0.f};
    bf16x8 At[4][2], B0[2][2], B1[2][2];
    const char* cA = (const char*)g.A + (size_t)cur.pm * tstepA; const char* cB = (const char*)g.Bt + (size_t)cur.pn * tstep;
    S.a_ready(cur);
    if constexpr (SP2) {
        PG8_STAGE(PG8_SB(0, 0), cB, voffB); PG8_STAGE(PG8_SB(0, 1), cB + hstep, voffB); PG8_STAGE(PG8_SA(0, 0), cA, voffA); PG8_STAGE(PG8_SA(0, 1), cA + hstepA, voffA);
        if (wr == 1) PG8_BAR;
        PG8_WAIT_V(2); PG8_BAR;
        PG8_STAGE(PG8_SB(1, 0), cB + kstep, voffB); PG8_STAGE(PG8_SA(1, 0), cA + kstep, voffA); PG8_STAGE(PG8_SB(1, 1), cB + hstep + kstep, voffB);
        PG8_WAIT_V(6); PG8_BAR;
        if (PG8_POSTEPI) PG8_STAGE(PG8_SA(1, 1), cA + kstep + hstepA, voffA);
    } else {
        PG8_STAGE(PG8_SB(0, 0), cB, voffB); PG8_STAGE(PG8_SA(0, 0), cA, voffA); PG8_STAGE(PG8_SB(0, 1), cB + hstep, voffB); PG8_STAGE(PG8_SA(0, 1), cA + hstepA, voffA);
        if (wr == 1) PG8_BAR;
        PG8_WAIT_V(4); PG8_BAR;
        PG8_STAGE(PG8_SB(1, 0), cB + kstep, voffB); PG8_STAGE(PG8_SA(1, 0), cA + kstep, voffA); PG8_STAGE(PG8_SB(1, 1), cB + hstep + kstep, voffB);
        PG8_WAIT_V(6); PG8_BAR;
    }
    for (;;) {
        const bool has_next = S.next(ui + 1, nxt);
        const char* nA = has_next ? (const char*)g.A + (size_t)nxt.pm * tstepA : cA; const char* nB = has_next ? (const char*)g.Bt + (size_t)nxt.pn * tstep : cB;
#if PROBE_GEMM
        const unsigned tk0 = (unsigned)__builtin_amdgcn_s_memtime();
#endif
        for (int t = 0; t < nt; t += 2) {
            const bool last = (t == nt - 2);
            const char* a1 = cA + (size_t)(t + 1) * kstep;
            const char* a2 = last ? nA : cA + (size_t)(t + 2) * kstep; const char* b2 = last ? nB : cB + (size_t)(t + 2) * kstep;
            const char* a3 = a2 + kstep; const char* b3 = b2 + kstep;
            if (last && has_next) S.a_ready(nxt);
            if constexpr (SP2) {
            const int post = __builtin_amdgcn_readfirstlane((PG8_POSTEPI && t == 0 && ui > 0) ? 1 : 0);
            PG8_LDB(B0, 0, 0); PG8_LDB(B1, 0, 1); PG8_SCHED; PG8_LDA(At, 0, 0); if (!PG8_POSTEPI) PG8_STAGE(PG8_SA(1, 1), a1 + hstepA, voffA);
            PG8_WAIT_VP(post); PG8_WAIT_L(0); PG8_BAR; PG8_MMA(0, 0, At, B0); PG8_MMA(0, 1, At, B1); PG8_BAR; PG8_SCHED;
            PG8_LDA(At, 0, 1); PG8_STAGE(PG8_SB(0, 0), b2, voffB); PG8_STAGE(PG8_SB(0, 1), b2 + hstep, voffB); PG8_STAGE(PG8_SA(0, 0), a2, voffA);
            PG8_WAIT_VP(post); PG8_WAIT_L(0); PG8_BAR; PG8_MMA(1, 0, At, B0); PG8_MMA(1, 1, At, B1); PG8_BAR; PG8_SCHED;
            PG8_LDB(B0, 1, 0); PG8_LDB(B1, 1, 1); PG8_SCHED; PG8_LDA(At, 1, 0); PG8_STAGE(PG8_SA(0, 1), a2 + hstepA, voffA);
            PG8_WAIT_VP(post); PG8_WAIT_L(0); PG8_BAR; PG8_MMA(0, 0, At, B0); PG8_MMA(0, 1, At, B1); PG8_BAR; PG8_SCHED;
            PG8_LDA(At, 1, 1); PG8_STAGE(PG8_SB(1, 0), b3, voffB); PG8_STAGE(PG8_SB(1, 1), b3 + hstep, voffB); PG8_STAGE(PG8_SA(1, 0), a3, voffA);
            PG8_WAIT_V(8); PG8_WAIT_L(0); PG8_BAR; PG8_MMA(1, 0, At, B0); PG8_MMA(1, 1, At, B1); PG8_BAR; PG8_SCHED;
            if (PG8_POSTEPI) PG8_STAGE(PG8_SA(1, 1), a3 + hstepA, voffA);
            } else {
            PG8_LDB(B0, 0, 0); PG8_SCHED; PG8_LDA(At, 0, 0); PG8_STAGE(PG8_SA(1, 1), a1 + hstepA, voffA);
            PG8_WAIT_L(8); PG8_BAR; PG8_WAIT_L(0); PG8_MMA(0, 0, At, B0); PG8_BAR; PG8_SCHED;
            PG8_LDB(B1, 0, 1); PG8_STAGE(PG8_SB(0, 0), b2, voffB);
            PG8_BAR; PG8_WAIT_L(0); PG8_MMA(0, 1, At, B1); PG8_BAR;
            PG8_LDA(At, 0, 1); PG8_STAGE(PG8_SA(0, 0), a2, voffA);
            PG8_BAR; PG8_WAIT_L(0); PG8_MMA(1, 0, At, B0); PG8_BAR; PG8_SCHED;
            PG8_STAGE(PG8_SB(0, 1), b2 + hstep, voffB);
            PG8_WAIT_V(6); PG8_BAR; PG8_MMA(1, 1, At, B1); PG8_BAR;
            PG8_LDB(B0, 1, 0); PG8_SCHED; PG8_LDA(At, 1, 0); PG8_STAGE(PG8_SA(0, 1), a2 + hstepA, voffA);
            PG8_WAIT_L(8); PG8_BAR; PG8_WAIT_L(0); PG8_MMA(0, 0, At, B0); PG8_BAR; PG8_SCHED;
            PG8_LDB(B1, 1, 1); PG8_STAGE(PG8_SB(1, 0), b3, voffB);
            PG8_BAR; PG8_WAIT_L(0); PG8_MMA(0, 1, At, B1); PG8_BAR;
            PG8_LDA(At, 1, 1); PG8_STAGE(PG8_SA(1, 0), a3, voffA);
            PG8_BAR; PG8_WAIT_L(0); PG8_MMA(1, 0, At, B0); PG8_BAR; PG8_SCHED;
            PG8_STAGE(PG8_SB(1, 1), b3 + hstep, voffB);
            PG8_WAIT_V(6); PG8_BAR; PG8_MMA(1, 1, At, B1); PG8_BAR;
            }
        }
#if PROBE_GEMM
        tgk += (unsigned)__builtin_amdgcn_s_memtime() - tk0;
#endif
        if constexpr (ALIGN_EPI) { if (wr == 0) PG8_BAR; }
        if constexpr (!Epi::AFTER_DRAIN) { E(acc, cur, wr, wc, fr, fq, ui); S.done(cur); }
        if (!has_next) break;
#pragma unroll
        for (int a = 0; a < 2; ++a)
#pragma unroll
            for (int b = 0; b < 2; ++b)
#pragma unroll
                for (int m = 0; m < 4; ++m)
#pragma unroll
                    for (int n = 0; n < 2; ++n) acc[a][b][m][n] = (f32x4){0.f, 0.f, 0.f, 0.f};
        cur = nxt; cA = nA; cB = nB; ++ui;
        if constexpr (ALIGN_EPI) { if (wr == 1) PG8_BAR; }
    }
    PG8_WAIT_V(0);
    if constexpr (!ALIGN_EPI) { if (wr == 0) PG8_BAR; }
    PG8_BAR;
    if constexpr (Epi::AFTER_DRAIN) { E.fused(acc, cur, wr, wc, fr, fq, lds, wid, lane); S.done(cur); }
#if PROBE_GEMM
    if (tp) *tp += (PROBE_GEMM == 1) ? tgk : ((unsigned)__builtin_amdgcn_s_memtime() - tg0);
#endif
#undef PG8_SA
#undef PG8_SB
#undef PG8_STAGE
#undef PG8_LDA
#undef PG8_LDB
#undef PG8_MMA
#undef PG8_WAIT_V
#undef PG8_WAIT_L
#undef PG8_WAIT_VP
#undef PG8_BAR
#undef PG8_SCHED
}
}
#ifndef PG8_SP2
#define PG8_SP2 true
#endif
#ifndef PG8_ALIGN
#define PG8_ALIGN true
#endif

constexpr int NWAVES = 8;
#ifndef MK_ONE_LAUNCH
#define MK_ONE_LAUNCH 1
#endif

#define PROBE_NREP 2
#define PROBE_SEG 0
#define PROBE_BAR 0
#define PROBE_BLOCK 0
#define PROBE_BAR2 0
#define PROBE_BARMASK 0x7fffu
#define PROBE_SITE 8
#define PROBE_MODE 0
#define PROBE_SHIFT 0
constexpr int M = 8192, DM = 4096, SEQ = 2048, NH = 32;
constexpr int MLA_IN = 5696, MLA_INP = 5888, QL = 1024, KVL = 512, QKD = 192, NQ = NH * QKD, NKV = NH * 256;
constexpr int C_KVLAT = 1024, C_KPE = 1536, C_GATE = 1600;
constexpr int SB_IN = 16384, C_SBK = 4096, C_SBV = 8192, C_SBG = 12288;
constexpr float EPS = 1e-6f;
constexpr float Q_SCALE_MLA = 0.07216878364870323f * 1.4426950408889634f;
constexpr float Q_SCALE_SB = 0.08838834764831845f * 1.4426950408889634f;
constexpr int N_PHASES = 15;
#ifndef OUTPROJ_STAGGER
#define OUTPROJ_STAGGER 0
#endif

constexpr size_t MiB = 1u << 20;
constexpr size_t WS_CTL = 0, CTL_ZERO_BYTES = 1 * MiB;
constexpr size_t WS_ROPE = 1 * MiB;
constexpr size_t WS_W = 2 * MiB, W_LAYER = 258 * MiB;
constexpr size_t W_IN_MLA = 0, W_QB = 46 * MiB, W_KVB = 58 * MiB, W_OUT_MLA = 66 * MiB, W_IN_SB = 98 * MiB, W_OUT_SB = 226 * MiB;
constexpr size_t WS_ACT = WS_W + 2 * W_LAYER;
constexpr size_t A_XN = WS_ACT, A_PROJ = WS_ACT + 64 * MiB, A_QN = WS_ACT + 320 * MiB, A_KVN = WS_ACT + 336 * MiB, A_QRAW = WS_ACT + 344 * MiB,
                 A_KVRAW = WS_ACT + 440 * MiB, A_KPER = WS_ACT + 568 * MiB  , A_SSPE = WS_ACT + 570 * MiB  , A_SSKP = WS_ACT + 572 * MiB  , A_XLO = WS_ACT + 600 * MiB  , A_OG = WS_ACT + 760 * MiB, WS_END = WS_ACT + 824 * MiB;
constexpr int CW_TMO = 0, CW_P0Q = 2048  , CW_BAR = 4096;
constexpr size_t WS_SS = 64 * 1024, SS_BYTES = 64 * 1024;

constexpr int RING_OFF = 0, RING_BYTES = 131072;
constexpr int LDSCTL_OFF = RING_BYTES, MISC_OFF = LDSCTL_OFF + 320;
constexpr int LDS_BYTES = 147456;

#define GAS __attribute__((address_space(1)))
#define LAS __attribute__((address_space(3)))
typedef unsigned short bf16;
typedef unsigned v4u __attribute__((ext_vector_type(4)));
typedef unsigned v2u __attribute__((ext_vector_type(2)));
typedef float f32x4 __attribute__((ext_vector_type(4)));
typedef GAS unsigned gu32;
#define RLX_AGENT __ATOMIC_RELAXED, __HIP_MEMORY_SCOPE_AGENT
#define LDS_WAIT() asm volatile("s_waitcnt lgkmcnt(0)" ::: "memory")
__device__ __forceinline__ float bf_lo(unsigned w) { return __uint_as_float(w << 16); }
__device__ __forceinline__ float bf_hi(unsigned w) { return __uint_as_float(w & 0xffff0000u); }
__device__ __forceinline__ unsigned pk2(float lo, float hi) { return pg8::cvt_pk_bf16(lo, hi); }
__device__ __forceinline__ void unpack8(v4u w, float (&f)[8]) { f[0] = bf_lo(w.x); f[1] = bf_hi(w.x); f[2] = bf_lo(w.y); f[3] = bf_hi(w.y); f[4] = bf_lo(w.z); f[5] = bf_hi(w.z); f[6] = bf_lo(w.w); f[7] = bf_hi(w.w); }
__device__ __forceinline__ v4u pack8(const float (&f)[8]) { v4u w; w.x = pk2(f[0], f[1]); w.y = pk2(f[2], f[3]); w.z = pk2(f[4], f[5]); w.w = pk2(f[6], f[7]); return w; }

#define XB_TMO      128
#define XB_XCNT(j)  (256  + 64 * (j))
#define XB_XSUB(j)  (1280 + 64 * (j))
#define XB_XGEN(j)  (2304 + 64 * (j))
#define XB_TOP      3328
#define XB_TOPGEN   3392
#define XCD_BAR_WORDS 3456
#define XB_SPIN_CAP (1u << 18)

__device__ __forceinline__ unsigned xb_ld(unsigned* p)              { return __hip_atomic_load(p, __ATOMIC_RELAXED, __HIP_MEMORY_SCOPE_AGENT); }
__device__ __forceinline__ unsigned xb_add(unsigned* p, unsigned v) { return __hip_atomic_fetch_add(p, v, __ATOMIC_RELAXED, __HIP_MEMORY_SCOPE_AGENT); }
__device__ __forceinline__ unsigned xb_xcc_id() { return (unsigned)__builtin_amdgcn_s_getreg((3 << 11) | 20) & 0xFu; }
#define XB_SPIN(cond, bar) do { unsigned _sp = 0; while (cond) { __builtin_amdgcn_s_sleep(1); \
    if ((++_sp & 255u) == 0u) { if (xb_ld(&(bar)[XB_TMO])) break; if (_sp > XB_SPIN_CAP) { atomicAdd(&(bar)[XB_TMO], 1u); break; } } } } while (0)

struct XcdBarrier {
    unsigned* bar; unsigned x;
    volatile LAS unsigned* st;
};

__device__ __forceinline__ XcdBarrier xcd_barrier_post(unsigned* bar, volatile LAS unsigned* st) {
    XcdBarrier b; b.bar = bar; b.x = xb_xcc_id(); b.st = st;
    if (threadIdx.x == 0) (void)xb_add(&bar[XB_XCNT(b.x)], 1u);
    return b;
}
__device__ __forceinline__ void xcd_barrier_complete(unsigned* bar, unsigned x, unsigned& nloc, unsigned& nx) {
    const unsigned G = gridDim.x * gridDim.y * gridDim.z;
    unsigned sum, cnt, mine, sp = 0u;
    for (;;) {
        sum = 0u; cnt = 0u; mine = 0u;
#pragma unroll
        for (unsigned j = 0; j < 16; ++j) { const unsigned c = xb_ld(&bar[XB_XCNT(j)]); sum += c; cnt += (c > 0u) ? 1u : 0u; mine = (j == x) ? c : mine; }
        if (sum == G) break;
        __builtin_amdgcn_s_sleep(1);
        if ((++sp & 255u) == 0u) { if (xb_ld(&bar[XB_TMO])) break; if (sp > XB_SPIN_CAP) { atomicAdd(&bar[XB_TMO], 1u); break; } }
    }
    nloc = mine > 0u ? mine : 1u; nx = cnt > 0u ? cnt : 1u;
}

__device__ __forceinline__ void xcd_barrier(const XcdBarrier& b) {
    asm volatile("s_waitcnt vmcnt(0)" ::: "memory");
    __syncthreads();
    if (threadIdx.x == 0) {
        unsigned* bar = b.bar;
        __builtin_amdgcn_s_waitcnt(0);
        unsigned nloc = b.st[0], nx = b.st[1];
        if (nloc == 0u) { xcd_barrier_complete(bar, b.x, nloc, nx); b.st[0] = nloc; b.st[1] = nx; }
        const unsigned old = xb_add(&bar[XB_XSUB(b.x)], 1u);
        const unsigned gen = old / nloc;
        if (old + 1u == (gen + 1u) * nloc) {
            __builtin_amdgcn_fence(__ATOMIC_RELEASE, "agent");
            asm volatile("s_waitcnt vmcnt(0)" ::: "memory");
            const unsigned og = xb_add(&bar[XB_TOP], 1u);
            const unsigned tg = og / nx;
            if (og + 1u == (tg + 1u) * nx) xb_add(&bar[XB_TOPGEN], 1u);
            else XB_SPIN(xb_ld(&bar[XB_TOPGEN]) == tg, bar);
            __builtin_amdgcn_fence(__ATOMIC_ACQUIRE, "agent");
            xb_add(&bar[XB_XGEN(b.x)], 1u);
            asm volatile("s_waitcnt vmcnt(0)" ::: "memory");
        } else {
            XB_SPIN(xb_ld(&bar[XB_XGEN(b.x)]) == gen, bar);
            __builtin_amdgcn_fence(__ATOMIC_ACQUIRE, "agent");
            asm volatile("s_waitcnt vmcnt(0)" ::: "memory");
        }
    }
    __syncthreads();
}

#define LAUNDER_V(x) asm volatile("" : "+v"(x))
__device__ __forceinline__ float wave_sum(float v) {
#pragma unroll
    for (int o = 1; o < 64; o <<= 1) v += __shfl_xor(v, o);
    return v;
}
__device__ __forceinline__ void p0_item_load(const float* W, int N, int item, int lane, f32x4 (&v)[16]) {
    const int nblk = N / 64, kb = item / nblk, nb = item % nblk, k0 = 64 * kb, n0 = 64 * nb, rr = lane >> 4, c4 = (lane & 15) * 4;
#pragma unroll
    for (int i = 0; i < 16; ++i) v[i] = *(const GAS f32x4*)(W + (size_t)(k0 + 4 * i + rr) * N + n0 + c4);
}
__device__ __forceinline__ void p0_item_store(const f32x4 (&v)[16], int K, int N, bf16* WT, LAS float* scr, int item, int lane, int nscale, float scale, const float* kg) {
    const int nblk = N / 64, kb = item / nblk, nb = item % nblk, k0 = 64 * kb, n0 = 64 * nb;
    const int rr = lane >> 4, c4 = (lane & 15) * 4;
#pragma unroll
    for (int i = 0; i < 16; ++i) { const int k = 4 * i + rr; *(LAS f32x4*)(scr + k * 64 + (c4 ^ ((k >> 3) * 4))) = v[i]; }
    LDS_WAIT(); asm volatile("" ::: "memory");
    const int c = lane & 7, nl = lane >> 3;
    f32x4 ga = (f32x4){1.f, 1.f, 1.f, 1.f}, gb = ga;
    if (kg) { ga = *(const GAS f32x4*)(kg + k0 + 8 * c); gb = *(const GAS f32x4*)(kg + k0 + 8 * c + 4); }
#pragma unroll
    for (int j = 0; j < 8; ++j) { const int n = nl + 8 * j; const LAS float* s = scr + (8 * c) * 64 + (n ^ (4 * c));
        const float sc = (n0 + n) < nscale ? scale : 1.f;
        v4u o; o.x = pk2(s[0 * 64] * (sc * ga.x), s[1 * 64] * (sc * ga.y)); o.y = pk2(s[2 * 64] * (sc * ga.z), s[3 * 64] * (sc * ga.w)); o.z = pk2(s[4 * 64] * (sc * gb.x), s[5 * 64] * (sc * gb.y)); o.w = pk2(s[6 * 64] * (sc * gb.z), s[7 * 64] * (sc * gb.w));
        *(GAS v4u*)(WT + (size_t)(n0 + n) * K + k0 + 8 * c) = o; }
    LDS_WAIT(); asm volatile("" ::: "memory");
}
__device__ __forceinline__ void p0_transpose(const float* W, int K, int N, bf16* WT, LAS float* scr, int gw, int NGW, int lane, const float* kg = nullptr, int nscale = 0, float scale = 1.f) {
    LAUNDER_V(lane);
    const int items = (K / 64) * (N / 64);
    f32x4 va[16], vb[16];
    int it = gw;
    if (it < items) p0_item_load(W, N, it, lane, va);
    for (; it < items; it += 2 * NGW) {
        const int it1 = it + NGW, it2 = it + 2 * NGW;
        if (it1 < items) p0_item_load(W, N, it1, lane, vb);
        p0_item_store(va, K, N, WT, scr, it, lane, nscale, scale, kg);
        if (it1 < items) { if (it2 < items) p0_item_load(W, N, it2, lane, va); p0_item_store(vb, K, N, WT, scr, it1, lane, nscale, scale, kg); }
    }
}
__device__ __forceinline__ void x_to_bf16_rows(const float* x, bf16* xb, bf16* xlo, unsigned long long* ss, int gw, int NGW, int lane) {
    LAUNDER_V(lane);
    for (int m = 2 * gw; m < M; m += 2 * NGW) {
        const GAS f32x4* xr = (const GAS f32x4*)(x + (size_t)m * DM) + lane;
        f32x4 v[16], w[16]; float s = 0.f, t = 0.f;
#pragma unroll
        for (int j = 0; j < 16; ++j) { v[j] = xr[64 * j]; w[j] = xr[DM / 4 + 64 * j]; }
#pragma unroll
        for (int j = 0; j < 16; ++j) { s += (v[j].x * v[j].x + v[j].y * v[j].y) + (v[j].z * v[j].z + v[j].w * v[j].w); t += (w[j].x * w[j].x + w[j].y * w[j].y) + (w[j].z * w[j].z + w[j].w * w[j].w); }
#pragma unroll
        for (int o = 1; o < 64; o <<= 1) { s += __shfl_xor(s, o); t += __shfl_xor(t, o); }
        if (lane == 0) { ss[m] = (unsigned long long)(s * pg8::SS_FIX); ss[m + 1] = (unsigned long long)(t * pg8::SS_FIX); }
        GAS v2u* o8 = (GAS v2u*)(xb + (size_t)m * DM) + lane; GAS v2u* l8 = (GAS v2u*)(xlo + (size_t)m * DM) + lane;
#pragma unroll
        for (int j = 0; j < 16; ++j) { v2u o, q, ol, ql; o.x = pk2(v[j].x, v[j].y); o.y = pk2(v[j].z, v[j].w); o8[64 * j] = o; q.x = pk2(w[j].x, w[j].y); q.y = pk2(w[j].z, w[j].w); o8[DM / 4 + 64 * j] = q;
            ol.x = pk2(v[j].x - bf_lo(o.x), v[j].y - bf_hi(o.x)); ol.y = pk2(v[j].z - bf_lo(o.y), v[j].w - bf_hi(o.y)); l8[64 * j] = ol;
            ql.x = pk2(w[j].x - bf_lo(q.x), w[j].y - bf_hi(q.x)); ql.y = pk2(w[j].z - bf_lo(q.y), w[j].w - bf_hi(q.y)); l8[DM / 4 + 64 * j] = ql; }
    }
}
constexpr int P0_T0 = (DM / 64) * (MLA_IN / 64), P0_T1 = (QL / 64) * (NQ / 64), P0_T2 = (KVL / 64) * (NKV / 64), P0_T3 = (DM / 64) * (DM / 64), P0_T4 = (DM / 64) * (SB_IN / 64), P0_T5 = P0_T3;
constexpr int P1_CHUNK = 8;
constexpr int FQ_KV0 = P0_T1 + P0_T2, FQ_OM0 = FQ_KV0 + P0_T3, FQ_IS0 = FQ_OM0 + P0_T4, FQ_OS0 = FQ_IS0 + P0_T5, FQ_IM1 = FQ_OS0 + P0_T0, FQ_KV1 = FQ_IM1 + P0_T1 + P0_T2, FQ_OM1 = FQ_KV1 + P0_T3,
              FQ_IS1 = FQ_OM1 + P0_T4, FQ_OS1 = FQ_IS1 + P0_T5, FQ_ITEMS = FQ_OS1;
struct P1Fill {
    const float* const* in; unsigned char* ws; gu32* q; LAS float* scr; int cbase, cpos;
    __device__ __forceinline__ bool item(int lane, int limit = FQ_ITEMS) {
        if (cpos >= P1_CHUNK) { unsigned v = 0; if (lane == 0) v = __hip_atomic_fetch_add(q, (unsigned)P1_CHUNK, __ATOMIC_RELAXED, __HIP_MEMORY_SCOPE_AGENT); cbase = __builtin_amdgcn_readfirstlane((int)v); cpos = 0; }
        int r = cbase + cpos;
        if (r >= limit) return false;
        ++cpos;
        LAUNDER_V(lane);
        int z_; asm volatile("s_mov_b32 %0, 0" : "=s"(z_));
        const float* const* in = this->in + z_; unsigned char* ws = this->ws + z_;
        const int j = r >= FQ_OS0 ? 1 : 0; if (j) r -= FQ_OS0; else r += P0_T0;
        unsigned char* wl = ws + WS_W + (size_t)j * W_LAYER;
        const float* W; bf16* WT; const float* kg = nullptr; int K, N, nscale = 0; float scale = 1.f;
        if (r < P0_T0) { W = in[2] + (size_t)j * DM * MLA_IN; K = DM; N = MLA_IN; WT = (bf16*)(wl + W_IN_MLA); kg = in[1] + (size_t)j * DM; }
        else if ((r -= P0_T0) < P0_T1) { W = in[4] + (size_t)j * QL * NQ; K = QL; N = NQ; WT = (bf16*)(wl + W_QB); kg = in[3] + (size_t)j * QL; }
        else if ((r -= P0_T1) < P0_T2) { W = in[6] + (size_t)j * KVL * NKV; K = KVL; N = NKV; WT = (bf16*)(wl + W_KVB); kg = in[5] + (size_t)j * KVL; }
        else if ((r -= P0_T2) < P0_T3) { W = in[9] + (size_t)j * DM * DM; K = DM; N = DM; WT = (bf16*)(wl + W_OUT_MLA); }
        else if ((r -= P0_T3) < P0_T4) { W = in[11] + (size_t)j * DM * SB_IN; K = DM; N = SB_IN; WT = (bf16*)(wl + W_IN_SB); kg = in[10] + (size_t)j * DM; nscale = DM; scale = Q_SCALE_SB; }
        else { r -= P0_T4; W = in[12] + (size_t)j * DM * DM; K = DM; N = DM; WT = (bf16*)(wl + W_OUT_SB); }
        f32x4 v[16]; p0_item_load(W, N, r, lane, v); p0_item_store(v, K, N, WT, scr, r, lane, nscale, scale, kg);
        return true;
    }
};
__device__ __forceinline__ void xcd_barrier_fill(const XcdBarrier& b, P1Fill& F, int wave, int lane) {
    asm volatile("s_waitcnt vmcnt(0)" ::: "memory");
    if (threadIdx.x == 0) b.st[2] = 0u;
    __syncthreads();
    if (wave == 0) {
        if (threadIdx.x == 0) {
            unsigned* bar = b.bar;
            __builtin_amdgcn_s_waitcnt(0);
            unsigned nloc = b.st[0], nx = b.st[1];
            if (nloc == 0u) { xcd_barrier_complete(bar, b.x, nloc, nx); b.st[0] = nloc; b.st[1] = nx; }
            const unsigned old = xb_add(&bar[XB_XSUB(b.x)], 1u);
            const unsigned gen = old / nloc;
            if (old + 1u == (gen + 1u) * nloc) {
                __builtin_amdgcn_fence(__ATOMIC_RELEASE, "agent");
                asm volatile("s_waitcnt vmcnt(0)" ::: "memory");
                const unsigned og = xb_add(&bar[XB_TOP], 1u);
                const unsigned tg = og / nx;
                if (og + 1u == (tg + 1u) * nx) xb_add(&bar[XB_TOPGEN], 1u);
                else { b.st[2] = 1u; XB_SPIN(xb_ld(&bar[XB_TOPGEN]) == tg, bar); }
                __builtin_amdgcn_fence(__ATOMIC_ACQUIRE, "agent");
                xb_add(&bar[XB_XGEN(b.x)], 1u);
                asm volatile("s_waitcnt vmcnt(0)" ::: "memory");
            } else {
                b.st[2] = 1u;
                XB_SPIN(xb_ld(&bar[XB_XGEN(b.x)]) == gen, bar);
                __builtin_amdgcn_fence(__ATOMIC_ACQUIRE, "agent");
                asm volatile("s_waitcnt vmcnt(0)" ::: "memory");
            }
            b.st[2] = 2u;
        }
    } else {
        while (b.st[2] == 0u) __builtin_amdgcn_s_sleep(1);
        while (b.st[2] == 1u) { if (!F.item(lane)) { while (b.st[2] == 1u) __builtin_amdgcn_s_sleep(2); break; } }
    }
    __syncthreads();
}

__device__ __forceinline__ void kpe_rows(const bf16* proj, const float* gk, const float* ropec, const float* ropes, bf16* kper, float* sspe, int gw, int NGW, int lane) {
    LAUNDER_V(lane);
    const int tk = lane >> 3, c = lane & 7;
    float g[8];
#pragma unroll
    for (int e = 0; e < 8; ++e) g[e] = gk[128 + 8 * c + e];
    for (int m0 = 8 * gw; m0 < M; m0 += 8 * NGW) { const int m = m0 + tk, pos = m & (SEQ - 1);
        float f[8], x[8], pr[8], o[8]; unpack8(*(const GAS v4u*)(proj + (size_t)m * MLA_INP + C_KPE + 8 * c), f);
        float ss = 0.f;
#pragma unroll
        for (int e = 0; e < 8; ++e) { ss += f[e] * f[e]; x[e] = f[e] * g[e]; }
        ss += __shfl_xor(ss, 1); ss += __shfl_xor(ss, 2); ss += __shfl_xor(ss, 4);
        if (c == 0) sspe[m] = ss;
#pragma unroll
        for (int e = 0; e < 8; ++e) pr[e] = __shfl_xor(x[e], 4);
        const float* cs = ropec + pos * 32 + (c & 3) * 8; const float* sn = ropes + pos * 32 + (c & 3) * 8;
#pragma unroll
        for (int e = 0; e < 8; ++e) o[e] = (c < 4) ? (x[e] * cs[e] - pr[e] * sn[e]) : (pr[e] * sn[e] + x[e] * cs[e]);
        *(GAS v4u*)(kper + (size_t)m * 64 + 8 * c) = pack8(o); }
}


namespace fa {
typedef short bf16x8 __attribute__((ext_vector_type(8)));
typedef short s16x4 __attribute__((ext_vector_type(4)));
typedef float f32x16 __attribute__((ext_vector_type(16)));
typedef float f32x2 __attribute__((ext_vector_type(2)));
#define FA_SBAR() __builtin_amdgcn_sched_barrier(0)
#ifndef FA_RING3
#define FA_RING3 0
#endif
#ifndef FA_NDR
#define FA_NDR 12
#endif
#ifndef FA_PV_DEFER
#define FA_PV_DEFER 0
#endif
#ifndef FA_PP2_LAG
#define FA_PP2_LAG 0
#endif
#ifndef FA_PP2
#define FA_PP2 0
#endif
#ifndef FA_PP
#define FA_PP 0
#endif
constexpr int SHM_V = 16384;
__device__ __forceinline__ int v_st(int k, int c) { const int kk = (k & ~0xC) | ((k & 4) << 1) | ((k & 8) >> 1); return ((kk >> 3) * 4 + (c >> 5)) * 512 + ((kk & 7) * 32 + (c & 31)) * 2; }
__device__ __forceinline__ int v_rd_base(int lane) { return ((lane & 3) << 3) | (((lane >> 2) & 3) << 6) | (((lane >> 4) & 1) << 5) | (((lane >> 5) & 1) << 8); }
__device__ __forceinline__ unsigned cvtpk(float lo, float hi) { unsigned r; asm volatile("v_cvt_pk_bf16_f32 %0, %1, %2" : "=v"(r) : "v"(lo), "v"(hi)); return r; }
__device__ __forceinline__ bf16x8 pack8p(const f32x16& p, int b) { v4u w = {cvtpk(p[b + 0], p[b + 1]), cvtpk(p[b + 2], p[b + 3]), cvtpk(p[b + 4], p[b + 5]), cvtpk(p[b + 6], p[b + 7])}; return __builtin_bit_cast(bf16x8, w); }
__device__ __forceinline__ float ex2(float x) { return __builtin_amdgcn_exp2f(x); }
__device__ __forceinline__ float lg2(float x) { return __builtin_amdgcn_logf(x); }

struct AttnP { const bf16* Q; int qpitch, qhs; const bf16* K; int kpitch, khs; const bf16* V; int vpitch, vhs; const bf16* Gt; int gpitch; bf16* O;
               const bf16* KR; const float* sskp; const float* sspe; const float* gq; const float* gk; const float* rc; const float* rs; };
template <int MODE>
__device__ __forceinline__ void attn_phase(LAS unsigned char* lds, const AttnP& P, int G, int vcu, LAS unsigned* ecnt, unsigned& tacc) {
#if PROBE_SEG
    unsigned t_prev = 0;
#define FA_STAMP_ON(k) (PROBE_SEG == 9 || (k) == 0 || (k) == PROBE_SEG || ((k) == PROBE_SEG - 1 && PROBE_SEG >= 2 && PROBE_SEG <= 4))
#define FA_STAMP(k) do { if (PROBE_MODE == MODE && FA_STAMP_ON(k)) { asm volatile("" ::: "memory"); const unsigned t_now = (unsigned)__builtin_amdgcn_s_memtime(); asm volatile("s_waitcnt lgkmcnt(0)" ::: "memory"); if (PROBE_SEG == (k) || (PROBE_SEG == 9 && (k) != 0)) tacc += t_now - t_prev; t_prev = t_now; } } while (0)
#else
#define FA_STAMP(k) do { } while (0)
#endif
    const bf16* Qp = P.Q; const int qpitch = P.qpitch, qhs = P.qhs; const bf16* Kp = P.K; const int kpitch = P.kpitch, khs = P.khs; const bf16* Vp = P.V; const int vpitch = P.vpitch, vhs = P.vhs;
    const bf16* Gp = P.Gt; const int gpitch = P.gpitch; bf16* Op = P.O;
    constexpr int DQK = MODE == 0 ? 192 : 128, ND = DQK / 16, KPITCH = DQK * 2, SHM_K = 64 * KPITCH, KP = SHM_K / 8192, NKB = (MODE == 0 && FA_RING3) ? 3 : 2, VOFF = NKB * SHM_K, NVB = (MODE == 0 && (FA_PP2 || FA_PV_DEFER || FA_RING3)) ? 3 : 2, RKOFF = VOFF + NVB * SHM_V, QROFF = RKOFF + 8192, NDR = (PROBE_SEG && MODE == 0) ? 7 : (MODE == 0 ? FA_NDR : 8), GTOFF = 131072 + 1024  ;
    int tid_l = threadIdx.x; asm volatile("" : "+v"(tid_l));
    const int tid = tid_l, wid = __builtin_amdgcn_readfirstlane(tid >> 6), lane = tid & 63;
#define FA_QRBASE ((MODE == 0 && (FA_PP2 || FA_PV_DEFER) && wid >= 6) ? 133120 + (wid - 6) * 4096 : QROFF + wid * (NDR < 8 ? 5120 : 4096))
#define FA_LANE_ADDRS(ln) const int r32 = (ln) & 31, hi = (ln) >> 5; const int kswz = MODE == 0 ? (((r32 >> 1) & 7) << 4) : ((r32 & 15) << 4); const int krow = r32 * KPITCH; \
        const int vb0 = (int)(uintptr_t)lds + VOFF + v_rd_base(ln); LAS unsigned char* qrl = lds + FA_QRBASE + (ln) * 16;
    const float NEG_INF = -__builtin_inff();
    constexpr float SB_CUT = -160.f;
    int un = 0;
    if (MODE == 1) { if (tid < 64) ecnt[tid] = 0u; asm volatile("s_waitcnt lgkmcnt(0)\n\ts_barrier" ::: "memory"); }

#define FA_DMA_OFFS(koff, krope, voff) unsigned koff[KP], voff[2]; bool krope[KP]; { int ln_ = lane; asm volatile("" : "+v"(ln_)); \
            _Pragma("unroll") for (int i_ = 0; i_ < KP; ++i_) { const int L = (wid * KP + i_) * 1024 + ln_ * 16, v = L / KPITCH, sb = L % KPITCH; \
                const int swz = MODE == 0 ? (((v >> 1) & 7) << 4) : ((v & 15) << 4), cb = sb ^ swz, vi = v & 31, dim = cb >> 1; \
                const int key = (v & 32) + (vi & 3) + 4 * (vi >> 3) + 16 * ((vi >> 2) & 1);                     \
                krope[i_] = MODE == 0 && dim >= 128; koff[i_] = krope[i_] ? (unsigned)(key * 64 + dim - 128) : (unsigned)(key * kpitch + dim); } \
            _Pragma("unroll") for (int i_ = 0; i_ < 2; ++i_) { const int L = (wid * 2 + i_) * 1024 + ln_ * 16, sub = L >> 9, within = L & 511, kk = (sub >> 2) * 8 + (within >> 6); \
                const int u_ = (kk & ~0xC) | ((kk & 4) << 1) | ((kk & 8) >> 1);                                    \
                const int key = (u_ & ~0x18) | ((u_ & 8) << 1) | ((u_ & 16) >> 1);                                  \
                voff[i_] = (unsigned)(key * vpitch + (sub & 3) * 32 + ((within & 63) >> 4) * 8); } }
#define FA_DMA_GO(koff, krope, voff, Kh_, Vh_, KRh_, j, KB) do { const bf16* kb_ = (Kh_) + (size_t)(j) * 64 * kpitch; const bf16* vb_ = (Vh_) + (size_t)(j) * 64 * vpitch; const bf16* kr_ = MODE == 0 ? (KRh_) + (size_t)(j) * 64 * 64 : nullptr; \
            _Pragma("unroll") for (int i_ = 0; i_ < KP; ++i_) __builtin_amdgcn_global_load_lds((const unsigned*)(((MODE == 0 && krope[i_]) ? kr_ : kb_) + koff[i_]), (LAS unsigned*)(lds + (KB) * SHM_K + (wid * KP + i_) * 1024), 16, 0, 0); \
            _Pragma("unroll") for (int i_ = 0; i_ < 2; ++i_) __builtin_amdgcn_global_load_lds((const unsigned*)(vb_ + voff[i_]), (LAS unsigned*)(lds + VOFF + (KB) * SHM_V + (wid * 2 + i_) * 1024), 16, 0, 0); } while (0)
#define FA_WAITBAR() asm volatile("s_waitcnt vmcnt(0) lgkmcnt(0)\n\ts_barrier" ::: "memory")
#define FA_TRRD(dst, off) asm volatile("ds_read_b64_tr_b16 %0, %1 offset:%2" : "=&v"(dst) : "v"(vb0), "i"(off) : "memory")
#define FA_PV_D0(d0, VB) do { s16x4 l0, l1, l2, l3, h0, h1, h2, h3; constexpr int b_ = (VB) * SHM_V + (d0) * 512; \
            FA_TRRD(l0, b_); FA_TRRD(h0, b_ + 2048); FA_TRRD(l1, b_ + 4096); FA_TRRD(h1, b_ + 6144); FA_TRRD(l2, b_ + 8192); FA_TRRD(h2, b_ + 10240); FA_TRRD(l3, b_ + 12288); FA_TRRD(h3, b_ + 14336); \
            asm volatile("s_waitcnt lgkmcnt(0)" ::: "memory"); FA_SBAR(); \
            o[d0] = __builtin_amdgcn_mfma_f32_32x32x16_bf16((bf16x8){l0[0], l0[1], l0[2], l0[3], h0[0], h0[1], h0[2], h0[3]}, pa0, o[d0], 0, 0, 0); \
            o[d0] = __builtin_amdgcn_mfma_f32_32x32x16_bf16((bf16x8){l1[0], l1[1], l1[2], l1[3], h1[0], h1[1], h1[2], h1[3]}, pa1, o[d0], 0, 0, 0); \
            o[d0] = __builtin_amdgcn_mfma_f32_32x32x16_bf16((bf16x8){l2[0], l2[1], l2[2], l2[3], h2[0], h2[1], h2[2], h2[3]}, pa2, o[d0], 0, 0, 0); \
            o[d0] = __builtin_amdgcn_mfma_f32_32x32x16_bf16((bf16x8){l3[0], l3[1], l3[2], l3[3], h3[0], h3[1], h3[2], h3[3]}, pa3, o[d0], 0, 0, 0); } while (0)
#ifndef FA_HOIST
#define FA_HOIST 1
#endif
#if FA_HOIST
#define FA_STEP_ADDRS
#else
#define FA_STEP_ADDRS int ln_s = lane; asm volatile("" : "+v"(ln_s)); FA_LANE_ADDRS(ln_s)
#endif
#define FA_STEP(t, KB) do { const int j = MODE == 0 ? (t) : NT - 1 - (t); FA_STEP_ADDRS \
            FA_STAMP(0); \
            if ((t) + 1 < NT) { const int jn = MODE == 0 ? (t) + 1 : NT - 2 - (t); FA_DMA_GO(sko, skr, svo, Kh, Vh, KRh, jn, (KB) ^ 1); } \
            if (j <= jmax && !(MODE == 1 && wdone)) { \
                f32x16 p0 = f32x16{}, p1 = f32x16{}; \
                _Pragma("unroll") for (int d0 = 0; d0 < ND; ++d0) { const int cb = d0 * 32 + hi * 16; const LAS unsigned char* a = lds + (KB) * SHM_K + krow + (cb ^ kswz); \
                    const bf16x8 k0 = *(const LAS bf16x8*)a, k1 = *(const LAS bf16x8*)(a + 32 * KPITCH); \
                    const bf16x8 qf = d0 < NDR ? qr[d0 < NDR ? d0 : 0] : *(const LAS bf16x8*)(qrl + (d0 == 7 ? 4 : d0 - 8) * 1024); \
                    p0 = __builtin_amdgcn_mfma_f32_32x32x16_bf16(k0, qf, p0, 0, 0, 0); p1 = __builtin_amdgcn_mfma_f32_32x32x16_bf16(k1, qf, p1, 0, 0, 0); } \
                const int kb = j * 64, dq = qlo + r32 - kb - 16 * hi; \
                if (PROBE_SEG) { asm volatile("" : "+v"(p0), "+v"(p1)); FA_STAMP(1); }     \
                if (MODE == 0) { \
                    { const LAS float* rkw = (const LAS float*)(lds + RKOFF) + kb; \
                      _Pragma("unroll") for (int g_ = 0; g_ < 4; ++g_) { const f32x4 ra = *(const LAS f32x4*)(rkw + 16 * hi + 4 * g_), rb = *(const LAS f32x4*)(rkw + 32 + 16 * hi + 4 * g_); \
                          p0[4 * g_] *= ra.x; p0[4 * g_ + 1] *= ra.y; p0[4 * g_ + 2] *= ra.z; p0[4 * g_ + 3] *= ra.w; p1[4 * g_] *= rb.x; p1[4 * g_ + 1] *= rb.y; p1[4 * g_ + 2] *= rb.z; p1[4 * g_ + 3] *= rb.w; } } \
                    if (kb + 63 > qlo) { _Pragma("unroll") for (int r = 0; r < 16; ++r) { if (r > dq) p0[r] = NEG_INF; if (r + 32 > dq) p1[r] = NEG_INF; } } \
                    float pmax = p0[0]; _Pragma("unroll") for (int r = 1; r < 16; ++r) pmax = fmaxf(pmax, p0[r]); _Pragma("unroll") for (int r = 0; r < 16; ++r) pmax = fmaxf(pmax, p1[r]); \
                    { auto rr = __builtin_amdgcn_permlane32_swap(__float_as_uint(pmax), __float_as_uint(pmax), false, false); pmax = fmaxf(__uint_as_float(rr[0]), __uint_as_float(rr[1])); } \
                    if (!__all(pmax - m_reg <= 11.5f)) { const float mn = fmaxf(m_reg, pmax), alpha = ex2(m_reg - mn); m_reg = mn; l_reg *= alpha; \
                        _Pragma("unroll") for (int d0 = 0; d0 < 4; ++d0) _Pragma("unroll") for (int r = 0; r < 16; ++r) o[d0][r] *= alpha; } \
                    float ps = 0.f; \
                    _Pragma("unroll") for (int r = 0; r < 16; r += 2) { const f32x2 a0 = (f32x2){p0[r], p0[r + 1]} - (f32x2){m_reg, m_reg}, a1 = (f32x2){p1[r], p1[r + 1]} - (f32x2){m_reg, m_reg}; \
                        p0[r] = ex2(a0.x); p0[r + 1] = ex2(a0.y); p1[r] = ex2(a1.x); p1[r + 1] = ex2(a1.y); ps += (p0[r] + p1[r]) + (p0[r + 1] + p1[r + 1]); } \
                    l_reg += ps; \
                } else { \
                    f32x16 e0, e1;     \
                    _Pragma("unroll") for (int r = 0; r < 16; r += 2) { const f32x2 t0 = {p0[r], p0[r + 1]}, t1 = {p1[r], p1[r + 1]}; \
                        const f32x2 x0 = (f32x2){ex2(-fabsf(t0.x)), ex2(-fabsf(t0.y))} + (f32x2){1.f, 1.f}, x1 = (f32x2){ex2(-fabsf(t1.x)), ex2(-fabsf(t1.y))} + (f32x2){1.f, 1.f}; \
                        const f32x2 b0 = (f32x2){fminf(t0.x, 0.f), fminf(t0.y, 0.f)} - (f32x2){lg2(x0.x), lg2(x0.y)}, b1 = (f32x2){fminf(t1.x, 0.f), fminf(t1.y, 0.f)} - (f32x2){lg2(x1.x), lg2(x1.y)}; \
                        const f32x2 d0 = b0 - t0, d1 = b1 - t1; \
                        p0[r] = b0.x; p0[r + 1] = b0.y; e0[r] = d0.x; e0[r + 1] = d0.y; p1[r] = b1.x; p1[r + 1] = b1.y; e1[r] = d1.x; e1[r + 1] = d1.y; } \
                    if (kb + 63 >= qlo) { _Pragma("unroll") for (int r = 0; r < 16; ++r) { if (r >= dq) { p0[r] = NEG_INF; e0[r] = 0.f; } if (r + 32 >= dq) { p1[r] = NEG_INF; e1[r] = 0.f; } } } \
                    float s0 = 0.f, s1 = 0.f; \
                    _Pragma("unroll") for (int r = 15; r >= 0; --r) { const float x0 = e0[r], x1 = e1[r]; e0[r] = s0; e1[r] = s1; s0 += x0; s1 += x1; } \
                    const auto r1 = __builtin_amdgcn_permlane32_swap(__float_as_uint(s0), __float_as_uint(s1), false, false); \
                    const auto r2 = __builtin_amdgcn_permlane32_swap(__float_as_uint(s1), __float_as_uint(s0), false, false); \
                    const float ps0 = __uint_as_float(hi ? r2[0] : r1[1]), ps1 = __uint_as_float(hi ? r1[0] : r2[1]); \
                    const float off1 = carry + (hi ? 0.f : ps1), off0 = carry + s1 + ps1 + (hi ? 0.f : ps0); \
                    carry += (s0 + s1) + (ps0 + ps1); \
                    _Pragma("unroll") for (int r = 0; r < 16; r += 2) { const f32x2 a0 = (f32x2){p0[r], p0[r + 1]} + ((f32x2){e0[r], e0[r + 1]} + (f32x2){off0, off0}), a1 = (f32x2){p1[r], p1[r + 1]} + ((f32x2){e1[r], e1[r + 1]} + (f32x2){off1, off1}); \
                        p0[r] = ex2(a0.x); p0[r + 1] = ex2(a0.y); p1[r] = ex2(a1.x); p1[r + 1] = ex2(a1.y); } \
                } \
                const bf16x8 pa0 = pack8p(p0, 0), pa1 = pack8p(p0, 8), pa2 = pack8p(p1, 0), pa3 = pack8p(p1, 8); \
                FA_STAMP(2); \
                FA_PV_D0(0, KB); FA_PV_D0(1, KB); FA_PV_D0(2, KB); FA_PV_D0(3, KB); \
                FA_STAMP(3); \
                if (MODE == 1) { if (__all(carry < SB_CUT)) wdone = true; } \
            } \
            if (MODE == 1 && wdone && lane == 0) __hip_atomic_fetch_add(ebank + (t), 1u, __ATOMIC_RELAXED, __HIP_MEMORY_SCOPE_WORKGROUP); \
            FA_WAITBAR(); FA_STAMP(4); \
            if (MODE == 1) stop = *(volatile LAS unsigned*)(ebank + (t)) == 8u; } while (0)


#define FA_DMA_K(koff, krope, Kh_, KRh_, j, KB) do { const bf16* kb_ = (Kh_) + (size_t)(j) * 64 * kpitch; const bf16* kr_ = MODE == 0 ? (KRh_) + (size_t)(j) * 64 * 64 : nullptr; \
            _Pragma("unroll") for (int i_ = 0; i_ < KP; ++i_) __builtin_amdgcn_global_load_lds((const unsigned*)(((MODE == 0 && krope[i_]) ? kr_ : kb_) + koff[i_]), (LAS unsigned*)(lds + (KB) * SHM_K + (wid * KP + i_) * 1024), 16, 0, 0); } while (0)
#define FA_DMA_V(voff, Vh_, j, KB) do { const bf16* vb_ = (Vh_) + (size_t)(j) * 64 * vpitch; \
            _Pragma("unroll") for (int i_ = 0; i_ < 2; ++i_) __builtin_amdgcn_global_load_lds((const unsigned*)(vb_ + voff[i_]), (LAS unsigned*)(lds + VOFF + (KB) * SHM_V + (wid * 2 + i_) * 1024), 16, 0, 0); } while (0)
#define FA_SLOT_END(more_, na, nb) do { FA_SBAR(); if (more_) { if (!grpB) asm volatile("s_waitcnt vmcnt(" #na ") lgkmcnt(0)\n\ts_barrier" ::: "memory"); else asm volatile("s_waitcnt vmcnt(" #nb ") lgkmcnt(0)\n\ts_barrier" ::: "memory"); } \
            else asm volatile("s_waitcnt vmcnt(0) lgkmcnt(0)\n\ts_barrier" ::: "memory"); FA_SBAR(); } while (0)
#define FA_S1(t, KB) do { const int j = (t); int ln_s = lane; asm volatile("" : "+v"(ln_s)); FA_LANE_ADDRS(ln_s) \
            const bool more_ = (t) + 1 < NT; \
            if (more_) { if (!grpB) FA_DMA_K(sko, skr, Kh, KRh, (t) + 1, (KB) ^ 1); else FA_DMA_V(svo, Vh, (t) + 1, (KB) ^ 1); } \
            if (j <= jmax) { \
                p0 = f32x16{}; p1 = f32x16{}; \
                _Pragma("unroll") for (int d0 = 0; d0 < ND; ++d0) { const int cb = d0 * 32 + hi * 16; const LAS unsigned char* a = lds + (KB) * SHM_K + krow + (cb ^ kswz); \
                    const bf16x8 k0 = *(const LAS bf16x8*)a, k1 = *(const LAS bf16x8*)(a + 32 * KPITCH); \
                    const bf16x8 qf = d0 < NDR ? qr[d0 < NDR ? d0 : 0] : *(const LAS bf16x8*)(qrl + (d0 == 7 ? 4 : d0 - 8) * 1024); \
                    p0 = __builtin_amdgcn_mfma_f32_32x32x16_bf16(k0, qf, p0, 0, 0, 0); p1 = __builtin_amdgcn_mfma_f32_32x32x16_bf16(k1, qf, p1, 0, 0, 0); } \
                const int kb = j * 64, dq = qlo + r32 - kb - 16 * hi; \
                { const LAS float* rkw = (const LAS float*)(lds + RKOFF) + kb; \
                  _Pragma("unroll") for (int g_ = 0; g_ < 4; ++g_) { const f32x4 ra = *(const LAS f32x4*)(rkw + 16 * hi + 4 * g_), rb = *(const LAS f32x4*)(rkw + 32 + 16 * hi + 4 * g_); \
                      p0[4 * g_] *= ra.x; p0[4 * g_ + 1] *= ra.y; p0[4 * g_ + 2] *= ra.z; p0[4 * g_ + 3] *= ra.w; p1[4 * g_] *= rb.x; p1[4 * g_ + 1] *= rb.y; p1[4 * g_ + 2] *= rb.z; p1[4 * g_ + 3] *= rb.w; } } \
                if (kb + 63 > qlo) { _Pragma("unroll") for (int r = 0; r < 16; ++r) { if (r > dq) p0[r] = NEG_INF; if (r + 32 > dq) p1[r] = NEG_INF; } } \
                float pmax = p0[0]; _Pragma("unroll") for (int r = 1; r < 16; ++r) pmax = fmaxf(pmax, p0[r]); _Pragma("unroll") for (int r = 0; r < 16; ++r) pmax = fmaxf(pmax, p1[r]); \
                { auto rr = __builtin_amdgcn_permlane32_swap(__float_as_uint(pmax), __float_as_uint(pmax), false, false); pmax = fmaxf(__uint_as_float(rr[0]), __uint_as_float(rr[1])); } \
                if (!__all(pmax - m_reg <= 11.5f)) { const float mn = fmaxf(m_reg, pmax), alpha = ex2(m_reg - mn); m_reg = mn; l_reg *= alpha; \
                    _Pragma("unroll") for (int d0 = 0; d0 < 4; ++d0) _Pragma("unroll") for (int r = 0; r < 16; ++r) o[d0][r] *= alpha; } \
                (void)vb0; \
            } \
            FA_SLOT_END(more_, 3, 2); } while (0)
#define FA_S2(t, KB) do { const int j = (t); int ln_s = lane; asm volatile("" : "+v"(ln_s)); FA_LANE_ADDRS(ln_s) \
            const bool more_ = grpB ? (t) + 2 < NT : (t) + 1 < NT; \
            if (more_) { if (!grpB) FA_DMA_V(svo, Vh, (t) + 1, (KB) ^ 1); else FA_DMA_K(sko, skr, Kh, KRh, (t) + 2, (KB)); } \
            if (j <= jmax) { \
                float ps = 0.f; \
                _Pragma("unroll") for (int r = 0; r < 16; ++r) { p0[r] = ex2(p0[r] - m_reg); p1[r] = ex2(p1[r] - m_reg); ps += p0[r] + p1[r]; } \
                l_reg += ps; \
                const bf16x8 pa0 = pack8p(p0, 0), pa1 = pack8p(p0, 8), pa2 = pack8p(p1, 0), pa3 = pack8p(p1, 8); \
                FA_PV_D0(0, KB); FA_PV_D0(1, KB); FA_PV_D0(2, KB); FA_PV_D0(3, KB); \
                (void)krow; (void)kswz; (void)qrl; \
            } \
            FA_SLOT_END(more_, 2, 3); } while (0)

#define FA_QK2(t) do { const int j = (t); int ln_s = lane; asm volatile("" : "+v"(ln_s)); FA_LANE_ADDRS(ln_s) (void)vb0; \
            if (j <= jmax) { const LAS unsigned char* kt_ = lds + ((t) & 1) * SHM_K + krow; p0 = f32x16{}; p1 = f32x16{}; \
                _Pragma("unroll") for (int d0 = 0; d0 < ND; ++d0) { const int cb = d0 * 32 + hi * 16; const LAS unsigned char* a = kt_ + (cb ^ kswz); \
                    const bf16x8 k0 = *(const LAS bf16x8*)a, k1 = *(const LAS bf16x8*)(a + 32 * KPITCH); \
                    const bf16x8 qf = d0 < NDR ? qr[d0 < NDR ? d0 : 0] : *(const LAS bf16x8*)(qrl + (d0 == 7 ? 4 : d0 - 8) * 1024); \
                    p0 = __builtin_amdgcn_mfma_f32_32x32x16_bf16(k0, qf, p0, 0, 0, 0); p1 = __builtin_amdgcn_mfma_f32_32x32x16_bf16(k1, qf, p1, 0, 0, 0); } } } while (0)
#define FA_SMPV2(t, vs_) do { const int j = (t); int ln_s = lane; asm volatile("" : "+v"(ln_s)); \
            if (j <= jmax) { const int r32 = ln_s & 31, hi = ln_s >> 5; const int vb0 = (int)(uintptr_t)lds + VOFF + (vs_) * SHM_V + v_rd_base(ln_s); \
                const int kb = j * 64, dq = qlo + r32 - kb - 16 * hi; \
                { const LAS float* rkw = (const LAS float*)(lds + RKOFF) + kb; \
                  _Pragma("unroll") for (int g_ = 0; g_ < 4; ++g_) { const f32x4 ra = *(const LAS f32x4*)(rkw + 16 * hi + 4 * g_), rb = *(const LAS f32x4*)(rkw + 32 + 16 * hi + 4 * g_); \
                      p0[4 * g_] *= ra.x; p0[4 * g_ + 1] *= ra.y; p0[4 * g_ + 2] *= ra.z; p0[4 * g_ + 3] *= ra.w; p1[4 * g_] *= rb.x; p1[4 * g_ + 1] *= rb.y; p1[4 * g_ + 2] *= rb.z; p1[4 * g_ + 3] *= rb.w; } } \
                if (kb + 63 > qlo) { _Pragma("unroll") for (int r = 0; r < 16; ++r) { if (r > dq) p0[r] = NEG_INF; if (r + 32 > dq) p1[r] = NEG_INF; } } \
                float pmax = p0[0]; _Pragma("unroll") for (int r = 1; r < 16; ++r) pmax = fmaxf(pmax, p0[r]); _Pragma("unroll") for (int r = 0; r < 16; ++r) pmax = fmaxf(pmax, p1[r]); \
                { auto rr = __builtin_amdgcn_permlane32_swap(__float_as_uint(pmax), __float_as_uint(pmax), false, false); pmax = fmaxf(__uint_as_float(rr[0]), __uint_as_float(rr[1])); } \
                if (!__all(pmax - m_reg <= 11.5f)) { const float mn = fmaxf(m_reg, pmax), alpha = ex2(m_reg - mn); m_reg = mn; l_reg *= alpha; \
                    _Pragma("unroll") for (int d0 = 0; d0 < 4; ++d0) _Pragma("unroll") for (int r = 0; r < 16; ++r) o[d0][r] *= alpha; } \
                float ps = 0.f; \
                _Pragma("unroll") for (int r = 0; r < 16; r += 2) { const f32x2 a0 = (f32x2){p0[r], p0[r + 1]} - (f32x2){m_reg, m_reg}, a1 = (f32x2){p1[r], p1[r + 1]} - (f32x2){m_reg, m_reg}; \
                    p0[r] = ex2(a0.x); p0[r + 1] = ex2(a0.y); p1[r] = ex2(a1.x); p1[r + 1] = ex2(a1.y); ps += (p0[r] + p1[r]) + (p0[r + 1] + p1[r + 1]); } \
                l_reg += ps; \
                const bf16x8 pa0 = pack8p(p0, 0), pa1 = pack8p(p0, 8), pa2 = pack8p(p1, 0), pa3 = pack8p(p1, 8); \
                FA_PV_D0(0, 0); FA_PV_D0(1, 0); FA_PV_D0(2, 0); FA_PV_D0(3, 0); } } while (0)
#define FA_STEP2(t) do { \
            if ((t) + 1 < NT) { FA_DMA_K(sko, skr, Kh, KRh, (t) + 1, ((t) + 1) & 1); FA_DMA_V(svo, Vh, (t) + 1, vs1); } \
            if (grpB && (t) > 0) FA_SMPV2((t) - 1, vsp); \
            FA_QK2(t); \
            if (!grpB || (t) + 1 == NT) FA_SMPV2(t, vs0); \
            FA_WAITBAR(); vsp = vs0; vs0 = vs1; vs1 = vs1 == 2 ? 0 : vs1 + 1; } while (0)

#define FA_EXPSLOT(P, r) do { const f32x2 a_ = (f32x2){P[r], P[(r) + 1]} - (f32x2){m_reg, m_reg}; P[r] = ex2(a_.x); P[(r) + 1] = ex2(a_.y); ps += P[r] + P[(r) + 1]; } while (0)
#define FA_MF(d0, L, H, PA) o[d0] = __builtin_amdgcn_mfma_f32_32x32x16_bf16((bf16x8){L[0], L[1], L[2], L[3], H[0], H[1], H[2], H[3]}, PA, o[d0], 0, 0, 0)
#define FA_PV_D0I(d0, r0) do { s16x4 l0, l1, l2, l3, h0, h1, h2, h3; constexpr int b_ = (d0) * 512; \
            FA_TRRD(l0, b_); FA_TRRD(h0, b_ + 2048); FA_TRRD(l1, b_ + 4096); FA_TRRD(h1, b_ + 6144); FA_TRRD(l2, b_ + 8192); FA_TRRD(h2, b_ + 10240); FA_TRRD(l3, b_ + 12288); FA_TRRD(h3, b_ + 14336); \
            FA_EXPSLOT(p0, r0); asm volatile("s_waitcnt lgkmcnt(0)" ::: "memory"); FA_SBAR(); \
            FA_MF(d0, l0, h0, pa0); FA_SBAR(); FA_EXPSLOT(p1, r0); FA_SBAR(); \
            FA_MF(d0, l1, h1, pa1); FA_SBAR(); FA_EXPSLOT(p0, (r0) + 2); FA_SBAR(); \
            FA_MF(d0, l2, h2, pa2); FA_SBAR(); FA_EXPSLOT(p1, (r0) + 2); FA_SBAR(); \
            FA_MF(d0, l3, h3, pa3); FA_SBAR(); } while (0)
#define FA_SM3(t, dopv_, vs_) do { const int j = (t); int ln_s = lane; asm volatile("" : "+v"(ln_s)); const bool pv_ = (dopv_) && (t) - 1 <= jmax; \
            if (j <= jmax) { const int r32 = ln_s & 31, hi = ln_s >> 5; const int vb0 = (int)(uintptr_t)lds + VOFF + (vs_) * SHM_V + v_rd_base(ln_s); \
                const int kb = j * 64, dq = qlo + r32 - kb - 16 * hi; \
                { const LAS float* rkw = (const LAS float*)(lds + RKOFF) + kb; \
                  _Pragma("unroll") for (int g_ = 0; g_ < 4; ++g_) { const f32x4 ra = *(const LAS f32x4*)(rkw + 16 * hi + 4 * g_), rb = *(const LAS f32x4*)(rkw + 32 + 16 * hi + 4 * g_); \
                      p0[4 * g_] *= ra.x; p0[4 * g_ + 1] *= ra.y; p0[4 * g_ + 2] *= ra.z; p0[4 * g_ + 3] *= ra.w; p1[4 * g_] *= rb.x; p1[4 * g_ + 1] *= rb.y; p1[4 * g_ + 2] *= rb.z; p1[4 * g_ + 3] *= rb.w; } } \
                if (kb + 63 > qlo) { _Pragma("unroll") for (int r = 0; r < 16; ++r) { if (r > dq) p0[r] = NEG_INF; if (r + 32 > dq) p1[r] = NEG_INF; } } \
                float pmax = p0[0]; _Pragma("unroll") for (int r = 1; r < 16; ++r) pmax = fmaxf(pmax, p0[r]); _Pragma("unroll") for (int r = 0; r < 16; ++r) pmax = fmaxf(pmax, p1[r]); \
                { auto rr = __builtin_amdgcn_permlane32_swap(__float_as_uint(pmax), __float_as_uint(pmax), false, false); pmax = fmaxf(__uint_as_float(rr[0]), __uint_as_float(rr[1])); } \
                const bool resc_ = !__all(pmax - m_reg <= 11.5f); float alpha_ = 1.f; \
                if (resc_) { const float mn = fmaxf(m_reg, pmax); alpha_ = ex2(m_reg - mn); m_reg = mn; l_reg *= alpha_; } \
                float ps = 0.f; \
                if (pv_) { FA_PV_D0I(0, 0); FA_PV_D0I(1, 4); FA_PV_D0I(2, 8); FA_PV_D0I(3, 12); }     \
                else { _Pragma("unroll") for (int r = 0; r < 16; r += 2) { FA_EXPSLOT(p0, r); FA_EXPSLOT(p1, r); } } \
                if (resc_) { _Pragma("unroll") for (int d0 = 0; d0 < 4; ++d0) _Pragma("unroll") for (int r = 0; r < 16; ++r) o[d0][r] *= alpha_; } \
                l_reg += ps; \
                pa0 = pack8p(p0, 0); pa1 = pack8p(p0, 8); pa2 = pack8p(p1, 0); pa3 = pack8p(p1, 8); \
            } } while (0)
#define FA_PV3(t, vs_) do { int ln_s = lane; asm volatile("" : "+v"(ln_s)); \
            if ((t) <= jmax) { const int vb0 = (int)(uintptr_t)lds + VOFF + (vs_) * SHM_V + v_rd_base(ln_s); FA_PV_D0(0, 0); FA_PV_D0(1, 0); FA_PV_D0(2, 0); FA_PV_D0(3, 0); } } while (0)
#define FA_STEP3(t) do { \
            if ((t) + 1 < NT) { FA_DMA_K(sko, skr, Kh, KRh, (t) + 1, ((t) + 1) & 1); FA_DMA_V(svo, Vh, (t) + 1, vs1); } \
            FA_QK2(t); \
            FA_SM3(t, (t) > 0, vsp); \
            if ((t) == jmax + 1 || ((t) + 1 == NT && jmax + 1 == NT)) { const int vf_ = (t) > jmax ? vsp : vs0; FA_PV3(jmax, vf_); }     \
            FA_WAITBAR(); vsp = vs0; vs0 = vs1; vs1 = vs1 == 2 ? 0 : vs1 + 1; } while (0)

#define FA_QK4(t, ks_) do { const int j = (t); int ln_s = lane; asm volatile("" : "+v"(ln_s)); FA_LANE_ADDRS(ln_s) (void)vb0; (void)qrl; \
            if (j <= jmax) { const LAS unsigned char* kt_ = lds + (ks_) * SHM_K + krow; p0 = f32x16{}; p1 = f32x16{}; \
                _Pragma("unroll") for (int d0 = 0; d0 < ND; ++d0) { const int cb = d0 * 32 + hi * 16; const LAS unsigned char* a = kt_ + (cb ^ kswz); \
                    const bf16x8 k0 = *(const LAS bf16x8*)a, k1 = *(const LAS bf16x8*)(a + 32 * KPITCH); \
                    p0 = __builtin_amdgcn_mfma_f32_32x32x16_bf16(k0, qr[d0], p0, 0, 0, 0); p1 = __builtin_amdgcn_mfma_f32_32x32x16_bf16(k1, qr[d0], p1, 0, 0, 0); } } } while (0)
#define FA_STEP4(t) do { \
            if ((t) == 0 && NT > 1) { FA_DMA_K(sko, skr, Kh, KRh, 1, 1); FA_DMA_V(svo, Vh, 1, 1); } \
            const bool more_ = (t) + 2 < NT; \
            if (more_) { FA_DMA_K(sko, skr, Kh, KRh, (t) + 2, s2); FA_DMA_V(svo, Vh, (t) + 2, s2); } \
            FA_QK4(t, s0); \
            FA_SMPV2(t, s0); \
            if (more_) asm volatile("s_waitcnt vmcnt(5) lgkmcnt(0)\n\ts_barrier" ::: "memory"); else asm volatile("s_waitcnt vmcnt(0) lgkmcnt(0)\n\ts_barrier" ::: "memory"); \
            s0 = s1; s1 = s2; s2 = s2 == 2 ? 0 : s2 + 1; } while (0)

    const int nunits = vcu < 512 ? 2 * ((512 - vcu + G - 1) / G) : 0;
#define FA_UNIT(u_, b_, h_, qb_) do { const int it_ = vcu + G * ((u_) >> 1), bh_ = it_ >> 2, pp_ = it_ & 3; b_ = bh_ >> 5; h_ = bh_ & 31; qb_ = ((u_) & 1) ? pp_ : 7 - pp_; } while (0)
    LAS float* gtl = (LAS float*)(lds + GTOFF);
    if (MODE == 0) { if (tid < QKD) gtl[tid] = tid < 128 ? P.gq[tid] * P.gk[tid] : P.gq[tid]; }
    bf16x8 qr[ND]; f32x16 o[4];
    float m_reg = -1e30f, l_reg = 0.f, carry = 0.f; bool wdone = false; LAS unsigned* ebank = ecnt;
    int b = 0, h = 0, qlo = 0, NT = 0, jmax = 0; const bf16* Kh = nullptr; const bf16* Vh = nullptr; const bf16* KRh = nullptr;
    for (int u = -1; u < nunits; ++u) {
        if (u >= 0) {
            bool stop = false;
            FA_DMA_OFFS(sko, skr, svo)
#if FA_HOIST
            int ln_u = lane; asm volatile("" : "+v"(ln_u)); FA_LANE_ADDRS(ln_u) (void)qrl;
#endif
            if (MODE == 0 && FA_RING3) {
                static_assert(!FA_RING3 || FA_NDR >= 12, "FA_RING3 uses the LDS space of the Q image");
                f32x16 p0 = f32x16{}, p1 = f32x16{}; int s0 = 0, s1 = 1, s2 = 2;
                for (int t = 0; t < NT; ++t) FA_STEP4(t);
            } else if (MODE == 0 && FA_PV_DEFER) {
                f32x16 p0 = f32x16{}, p1 = f32x16{}; bf16x8 pa0 = bf16x8{}, pa1 = bf16x8{}, pa2 = bf16x8{}, pa3 = bf16x8{}; int vsp = 0, vs0 = 0, vs1 = 1;
                for (int t = 0; t < NT; ++t) FA_STEP3(t);
            } else if (MODE == 0 && FA_PP2) {
                const bool grpB = FA_PP2_LAG && wid >= 4; f32x16 p0 = f32x16{}, p1 = f32x16{}; int vsp = 0, vs0 = 0, vs1 = 1;
                for (int t = 0; t < NT; ++t) FA_STEP2(t);
            } else if (MODE == 0 && FA_PP) {
                const bool grpB = wid >= 4; f32x16 p0 = f32x16{}, p1 = f32x16{};
                if (grpB) { FA_DMA_K(sko, skr, Kh, KRh, 1, 1); asm volatile("s_barrier" ::: "memory"); }
                for (int t = 0; t < NT; t += 2) { FA_S1(t, 0); FA_S2(t, 0); FA_S1(t + 1, 1); FA_S2(t + 1, 1); }
                if (!grpB) asm volatile("s_barrier" ::: "memory");
            } else
            for (int t = 0; t < NT; t += 2) { FA_STEP(t, 0); if (MODE == 1 && stop) break; FA_STEP(t + 1, 1); if (MODE == 1 && stop) break; }
        }
        FA_STAMP(0);
        const bool has_next = u + 1 < nunits;
        int b2 = 0, h2 = 0, q2 = 0; if (has_next) FA_UNIT(u + 1, b2, h2, q2);
        const int qlo2 = q2 * 256 + wid * 32, NT2 = 4 * (q2 + 1);
        const bf16* Kh2 = Kp + (size_t)b2 * SEQ * kpitch + h2 * khs; const bf16* Vh2 = Vp + (size_t)b2 * SEQ * vpitch + h2 * vhs; const bf16* KRh2 = MODE == 0 ? P.KR + (size_t)b2 * SEQ * 64 : nullptr;
        int lane_e = lane; asm volatile("" : "+v"(lane_e));
        const int er = lane_e >> 3, ec = lane_e & 7;
        v2u gv[16];
        const bf16* grow = Gp + ((size_t)b * SEQ + qlo + er) * gpitch + h * 128 + 4 * ec;
#define FA_LOAD_G(half) do { if (MODE == 0 || (half) == 0) { _Pragma("unroll") for (int ps = 0; ps < (MODE == 1 ? 4 : 2); ++ps) _Pragma("unroll") for (int i = 0; i < 4; ++i) gv[(2 * (half) + ps) * 4 + i] = *(const GAS v2u*)(grow + (size_t)(8 * i) * gpitch + 32 * (2 * (half) + ps)); } asm volatile("" ::: "memory"); } while (0)
        FA_LOAD_G(0); FA_LOAD_G(1);
        f32x4 csv[8]; f32x4 skv[4]; float spv[4];
        { const size_t mr_ = (size_t)b2 * SEQ + qlo2 + (lane_e & 31);
#pragma unroll
            for (int d0 = 0; d0 < ND; ++d0) qr[d0] = *(const bf16x8*)(Qp + mr_ * qpitch + h2 * qhs + d0 * 16 + (lane_e >> 5) * 8);
        }
        asm volatile("" ::: "memory");
        if (has_next) { FA_DMA_OFFS(tko, tkr, tvo) FA_DMA_GO(tko, tkr, tvo, Kh2, Vh2, KRh2, MODE == 0 ? 0 : NT2 - 1, 0); }
        asm volatile("" ::: "memory");
#define FA_LOAD_CS() do { if (MODE == 0) { const int pos = qlo2 + (lane_e & 31); \
            _Pragma("unroll") for (int dd = 0; dd < 2; ++dd) { const int ri = dd * 16 + (lane_e >> 5) * 8; \
                csv[dd * 4 + 0] = *(const GAS f32x4*)(P.rc + pos * 32 + ri); csv[dd * 4 + 1] = *(const GAS f32x4*)(P.rc + pos * 32 + ri + 4); \
                csv[dd * 4 + 2] = *(const GAS f32x4*)(P.rs + pos * 32 + ri); csv[dd * 4 + 3] = *(const GAS f32x4*)(P.rs + pos * 32 + ri + 4); } } asm volatile("" ::: "memory"); } while (0)
#define FA_LOAD_SK() do { if (MODE == 0) { \
            _Pragma("unroll") for (int i = 0; i < 4; ++i) { const size_t kt_ = (size_t)b2 * SEQ + tid + 512 * i; skv[i] = *(const GAS f32x4*)(P.sskp + (kt_ * NH + h2) * 4); spv[i] = P.sspe[kt_]; } } asm volatile("" ::: "memory"); } while (0)
        if (u >= 0) {
            float inv = 1.f;
            if (MODE == 0) { auto rr = __builtin_amdgcn_permlane32_swap(__float_as_uint(l_reg), __float_as_uint(l_reg), false, false); inv = 1.f / (__uint_as_float(rr[0]) + __uint_as_float(rr[1])); }
            LAS unsigned char* stg = lds + (MODE == 0 ? (wid < 5 ? SHM_K + wid * 4608 : VOFF + SHM_V + (wid - 5) * 4608) : 65536 + wid * 4608);
            LAS unsigned char* stw = stg + (lane_e & 31) * 144 + (lane_e >> 5) * 16;
            const LAS unsigned char* strd = stg + er * 144 + ec * 16;
            bf16* orow = Op + ((size_t)b * SEQ + qlo + er) * DM + h * 128 + 4 * ec;
#define FA_EPI_PASS(ps) do { \
                _Pragma("unroll") for (int g4 = 0; g4 < 4; ++g4) *(LAS f32x4*)(stw + g4 * 32) = (f32x4){o[ps][g4 * 4 + 0] * inv, o[ps][g4 * 4 + 1] * inv, o[ps][g4 * 4 + 2] * inv, o[ps][g4 * 4 + 3] * inv}; \
                _Pragma("unroll") for (int i = 0; i < 4; ++i) { const f32x4 ov = *(const LAS f32x4*)(strd + (8 * i) * 144); const v2u gq_ = gv[(ps) * 4 + i]; \
                    const float g0 = bf_lo(gq_.x), g1 = bf_hi(gq_.x), g2 = bf_lo(gq_.y), g3 = bf_hi(gq_.y); \
                    const float y0 = ov.x * g0 * __builtin_amdgcn_rcpf(1.f + ex2(-1.4426950408889634f * g0)), y1 = ov.y * g1 * __builtin_amdgcn_rcpf(1.f + ex2(-1.4426950408889634f * g1)); \
                    const float y2 = ov.z * g2 * __builtin_amdgcn_rcpf(1.f + ex2(-1.4426950408889634f * g2)), y3 = ov.w * g3 * __builtin_amdgcn_rcpf(1.f + ex2(-1.4426950408889634f * g3)); \
                    v2u w; w.x = cvtpk(y0, y1); w.y = cvtpk(y2, y3); *(GAS v2u*)(orow + (size_t)(8 * i) * DM + 32 * (ps)) = w; } \
                asm volatile("" ::: "memory"); } while (0)
            FA_EPI_PASS(0); FA_LOAD_SK(); FA_LOAD_CS(); FA_EPI_PASS(1); FA_EPI_PASS(2); FA_EPI_PASS(3);
        } else { FA_LOAD_SK(); FA_LOAD_CS(); }
        asm volatile("" ::: "memory");
        if (has_next) {
            if (MODE == 0 && ((u + 1) & 1) == 0) {
                LAS float* rkl = (LAS float*)(lds + RKOFF);
#pragma unroll
                for (int i = 0; i < 4; ++i) rkl[tid + 512 * i] = 1.f / sqrtf((((skv[i].x + skv[i].y) + (skv[i].z + skv[i].w)) + spv[i]) * (1.f / QKD) + EPS); }
            asm volatile("" ::: "memory");
            if (MODE == 0) {
                if (u < 0) asm volatile("s_waitcnt lgkmcnt(0)\n\ts_barrier" ::: "memory");
                float ss = 0.f;
#pragma unroll
                for (int d0 = 0; d0 < ND; ++d0) { float f[8]; unpack8(__builtin_bit_cast(v4u, qr[d0]), f);
#pragma unroll
                    for (int e = 0; e < 8; ++e) ss += f[e] * f[e]; }
                { auto rr = __builtin_amdgcn_permlane32_swap(__float_as_uint(ss), __float_as_uint(ss), false, false); ss = __uint_as_float(rr[0]) + __uint_as_float(rr[1]); }
                const float rq = Q_SCALE_MLA / sqrtf(ss * (1.f / QKD) + EPS);
                const int hi_e = lane_e >> 5; LAS unsigned char* qrl = lds + FA_QRBASE + lane_e * 16;
#pragma unroll
                for (int d0 = 0; d0 < 8; ++d0) { float f[8]; unpack8(__builtin_bit_cast(v4u, qr[d0]), f); const int dd = d0 * 16 + hi_e * 8;
                    const f32x4 a0 = *(const LAS f32x4*)(gtl + dd), a1 = *(const LAS f32x4*)(gtl + dd + 4);
                    f[0] *= rq * a0.x; f[1] *= rq * a0.y; f[2] *= rq * a0.z; f[3] *= rq * a0.w; f[4] *= rq * a1.x; f[5] *= rq * a1.y; f[6] *= rq * a1.z; f[7] *= rq * a1.w;
                    qr[d0] = __builtin_bit_cast(bf16x8, pack8(f)); }
                if (NDR < 8) *(LAS bf16x8*)(qrl + 4 * 1024) = qr[7];
#pragma unroll
                for (int dd = 0; dd < 2; ++dd) { float x1[8], x2[8], o1[8], o2[8]; unpack8(__builtin_bit_cast(v4u, qr[8 + dd]), x1); unpack8(__builtin_bit_cast(v4u, qr[10 + dd]), x2);
                    const int ri = dd * 16 + hi_e * 8;
                    const f32x4 ga0 = *(const LAS f32x4*)(gtl + 128 + ri), ga1 = *(const LAS f32x4*)(gtl + 128 + ri + 4), gb0 = *(const LAS f32x4*)(gtl + 160 + ri), gb1 = *(const LAS f32x4*)(gtl + 160 + ri + 4);
                    const f32x4 c0 = csv[dd * 4 + 0], c1 = csv[dd * 4 + 1], s0 = csv[dd * 4 + 2], s1 = csv[dd * 4 + 3];
                    const float gA[8] = {ga0.x, ga0.y, ga0.z, ga0.w, ga1.x, ga1.y, ga1.z, ga1.w}, gB[8] = {gb0.x, gb0.y, gb0.z, gb0.w, gb1.x, gb1.y, gb1.z, gb1.w};
                    const float cs[8] = {c0.x, c0.y, c0.z, c0.w, c1.x, c1.y, c1.z, c1.w}, sn[8] = {s0.x, s0.y, s0.z, s0.w, s1.x, s1.y, s1.z, s1.w};
#pragma unroll
                    for (int e = 0; e < 8; ++e) { const float a = x1[e] * gA[e], bq = x2[e] * gB[e]; o1[e] = (a * cs[e] - bq * sn[e]) * rq; o2[e] = (a * sn[e] + bq * cs[e]) * rq; }
                    if (NDR >= 12) { qr[8 + dd] = __builtin_bit_cast(bf16x8, pack8(o1)); qr[10 + dd] = __builtin_bit_cast(bf16x8, pack8(o2)); } else { *(LAS bf16x8*)(qrl + dd * 1024) = __builtin_bit_cast(bf16x8, pack8(o1)); *(LAS bf16x8*)(qrl + (2 + dd) * 1024) = __builtin_bit_cast(bf16x8, pack8(o2)); } }
            }
            b = b2; h = h2; qlo = qlo2; NT = NT2; jmax = (qlo2 + 31) >> 6; Kh = Kh2; Vh = Vh2; KRh = KRh2;
#pragma unroll
            for (int d0 = 0; d0 < 4; ++d0) o[d0] = f32x16{};
            m_reg = -1e30f; l_reg = 0.f; carry = 0.f; wdone = false; ebank = ecnt + (un & 1) * 32;
            FA_STAMP(6);
            if (u >= 0) asm volatile("s_waitcnt vmcnt(12) lgkmcnt(0)\n\ts_barrier" ::: "memory");
            else FA_WAITBAR();
            FA_STAMP(5);
            if (MODE == 1) { if (tid < 32) ecnt[((un + 1) & 1) * 32 + tid] = 0u; ++un; }
        }
    }
#undef FA_UNIT
#undef FA_LOAD_CS
#undef FA_LOAD_G
#undef FA_LOAD_SK
#undef FA_EPI_PASS
#undef FA_DMA_OFFS
#undef FA_DMA_GO
#undef FA_WAITBAR
#undef FA_TRRD
#undef FA_PV_D0
#undef FA_STEP
#undef FA_STEP_ADDRS
#undef FA_STEP2
#undef FA_STEP3
#undef FA_STEP4
#undef FA_QK4
#undef FA_EXPSLOT
#undef FA_MF
#undef FA_PV_D0I
#undef FA_SM3
#undef FA_PV3
#undef FA_QK2
#undef FA_SMPV2
#undef FA_QRBASE
#undef FA_S1
#undef FA_S2
#undef FA_SLOT_END
#undef FA_DMA_K
#undef FA_DMA_V
#undef FA_STAMP
}
}
struct Args { const float* in[13]; float* out; unsigned char* ws; int ph_lo, ph_hi; };
__global__ void __launch_bounds__(NWAVES * 64, 2) hybrid_fwd(Args args) {
    extern __shared__ __attribute__((aligned(16))) unsigned char lds_raw[];
    LAS unsigned char* lds = (LAS unsigned char*)lds_raw;
    volatile LAS unsigned* MISC = (volatile LAS unsigned*)(lds + MISC_OFF);
    const int tid = threadIdx.x, lane = tid & 63, wave = __builtin_amdgcn_readfirstlane(tid >> 6);
    const int G = gridDim.x, bx = blockIdx.x;
    const int vcu = (G % 8 == 0) ? (bx % 8) * (G / 8) + bx / 8 : bx;
    const int gw = vcu * NWAVES + wave, NGW = G * NWAVES;
    unsigned char* ws = args.ws;
    gu32* ctl = (gu32*)(ws + WS_CTL);
    for (int u = tid; u < (LDS_BYTES - LDSCTL_OFF) / 4; u += NWAVES * 64) ((LAS unsigned*)(lds + LDSCTL_OFF))[u] = 0u;
    __syncthreads();
#if MK_ONE_LAUNCH
    XcdBarrier bar = xcd_barrier_post((unsigned*)(ctl + CW_BAR), MISC + 8);
#if PROBE_BAR
#define GRID_BAR(kk) do { const unsigned tb0_ = (unsigned)__builtin_amdgcn_s_memtime(); xcd_barrier(bar); if ((PROBE_BARMASK >> (kk)) & 1u) tacc += (unsigned)__builtin_amdgcn_s_memtime() - tb0_; } while (0)
#else
#define GRID_BAR(kk) xcd_barrier(bar)
#endif
#else
    (void)MISC; (void)ctl;
#define GRID_BAR(kk) do { } while (0)
#endif
    const int lo = args.ph_lo, hi = args.ph_hi;
    P1Fill fill{args.in, ws, ctl + CW_P0Q, (LAS float*)(lds + RING_OFF + wave * 16384), 0, P1_CHUNK};
    unsigned tacc = 0;
#define IN(k) (lo <= (k) && (k) < hi)
#define SEAM(k) do { if (IN(k) && IN((k) + 1)) GRID_BAR(k); } while (0)
#if MK_ONE_LAUNCH
#if PROBE_BAR
#define SEAM_FILL(k) do { if (IN(k) && IN((k) + 1)) { const unsigned tb0_ = (unsigned)__builtin_amdgcn_s_memtime(); xcd_barrier_fill(bar, fill, wave, lane); if (PROBE_BAR == 1 && ((PROBE_BARMASK >> (k)) & 1u)) tacc += (unsigned)__builtin_amdgcn_s_memtime() - tb0_; } } while (0)
#else
#define SEAM_FILL(k) do { if (IN(k) && IN((k) + 1)) { xcd_barrier_fill(bar, fill, wave, lane); if (PROBE_BAR2) { xcd_barrier(bar); } } } while (0)
#endif
#else
#define SEAM_FILL(k) SEAM(k)
#endif
#define DRAIN(k, limit) do { if (IN(k)) { const unsigned td0_ = PROBE_BAR == 2 ? (unsigned)__builtin_amdgcn_s_memtime() : 0u; __syncthreads(); while (fill.item(lane, (limit))) { } if (PROBE_BAR == 2 && ((PROBE_BARMASK >> (k)) & 1u)) tacc += (unsigned)__builtin_amdgcn_s_memtime() - td0_; } } while (0)
    const float* x_in = args.in[0]; float* out = args.out;
    float* ropec = (float*)(ws + WS_ROPE); float* ropes = ropec + SEQ * 32;
    bf16* XB = (bf16*)(ws + A_XN); bf16* XLO = (bf16*)(ws + A_XLO); bf16* PROJ = (bf16*)(ws + A_PROJ);
    bf16* QLAT = (bf16*)(ws + A_QN); bf16* KVLAT = (bf16*)(ws + A_KVN); bf16* QRAW = (bf16*)(ws + A_QRAW); bf16* KVRAW = (bf16*)(ws + A_KVRAW); bf16* OG = (bf16*)(ws + A_OG);
    bf16* KPER = (bf16*)(ws + A_KPER); float* SSPE = (float*)(ws + A_SSPE); float* SSKP = (float*)(ws + A_SSKP);
    unsigned long long* SSX = (unsigned long long*)(ws + WS_SS);
    unsigned long long* SSQ = SSX + 4 * M; unsigned long long* SSKV = SSX + 6 * M;

    if (IN(0)) {
        LAS float* scr = (LAS float*)(lds + RING_OFF + wave * 16384);
        x_to_bf16_rows(x_in, XB, XLO, SSX, gw, NGW, lane);
        p0_transpose(args.in[2], DM, MLA_IN, (bf16*)(ws + WS_W + W_IN_MLA), scr, gw, NGW, lane, args.in[1]);
        { GAS v4u* pad = (GAS v4u*)(ws + WS_W + W_IN_MLA + (size_t)MLA_IN * DM * 2);
          for (int i = vcu * 512 + tid; i < (MLA_INP - MLA_IN) * DM * 2 / 16; i += G * 512) pad[i] = (v4u){0u, 0u, 0u, 0u}; }
        { GAS v4u* pad1 = (GAS v4u*)(ws + WS_W + W_LAYER + W_IN_MLA + (size_t)MLA_IN * DM * 2);
          for (int i = vcu * 512 + tid; i < (MLA_INP - MLA_IN) * DM * 2 / 16; i += G * 512) pad1[i] = (v4u){0u, 0u, 0u, 0u}; }
        for (int i = vcu * 512 + tid; i < SEQ * 32; i += G * 512) { const int pos = i >> 5, p = i & 31;
            const float inv = 1.0f / powf(10000.0f, (float)(2 * p) / 64.0f), ang = (float)pos * inv; ropec[i] = cosf(ang); ropes[i] = sinf(ang); }
    }
    SEAM_FILL(0);

    for (int L = 0; L < 2; ++L) {
        const int pb = 1 + 7 * L;
        unsigned char* wl = ws + WS_W + (size_t)L * W_LAYER;
        if (IN(pb + 0)) { pg8::Gemm g{XB, (const bf16*)(wl + W_IN_MLA), M, MLA_INP, DM, DM}; pg8::StaticOrder S; S.init(M, MLA_INP, G, bx);
            PG8_LAS float* rst = (PG8_LAS float*)(lds + LDSCTL_OFF + 2048);
            pg8::rstd_table_fill(rst, SSX + (size_t)(2 * L) * M, 1.f / DM, S, tid); pg8::EpiBf16S<1> E{PROJ, MLA_INP, rst, SSQ + (size_t)L * M, SSKV + (size_t)L * M, QLAT, KVLAT, nullptr, 0.f};
            pg8::gemm_phase<pg8::EpiBf16S<1>, pg8::StaticOrder, PG8_ALIGN, PG8_SP2>(lds + RING_OFF, g, S, E); }
        DRAIN(pb + 0, L == 0 ? FQ_KV0 : FQ_KV1);
        SEAM_FILL(pb + 0);
        if (IN(pb + 1)) {
            kpe_rows(PROJ, args.in[8] + (size_t)L * QKD, ropec, ropes, KPER, SSPE, gw, NGW, lane);
            { pg8::Gemm g{QLAT, (const bf16*)(wl + W_QB), M, NQ, QL, QL}; pg8::StaticOrder S; S.init(M, NQ, G, bx);
              PG8_LAS float* rst = (PG8_LAS float*)(lds + LDSCTL_OFF + 2048);
              pg8::rstd_table_fill(rst, SSQ + (size_t)L * M, 1.f / QL, S, tid); pg8::EpiBf16S<0> E{QRAW, NQ, rst, nullptr, nullptr, nullptr, nullptr, nullptr, 0.f}; pg8::gemm_phase<pg8::EpiBf16S<0>, pg8::StaticOrder, PG8_ALIGN, PG8_SP2>(lds + RING_OFF, g, S, E, PROBE_SITE == 2 ? &tacc : nullptr); }
            { pg8::Gemm g{KVLAT, (const bf16*)(wl + W_KVB), M, NKV, KVL, KVL}; pg8::StaticOrder S; S.init(M, NKV, G, bx);
              PG8_LAS float* rst = (PG8_LAS float*)(lds + LDSCTL_OFF + 2048);
              pg8::rstd_table_fill(rst, SSKV + (size_t)L * M, 1.f / KVL, S, tid); pg8::EpiKV E{KVRAW, NKV, rst, SSKP, nullptr, 0.f}; pg8::gemm_phase<pg8::EpiKV, pg8::StaticOrder, PG8_ALIGN, PG8_SP2>(lds + RING_OFF, g, S, E, PROBE_SITE == 3 ? &tacc : nullptr); }
        }
        SEAM_FILL(pb + 1);
        if (IN(pb + 2)) { const fa::AttnP P{QRAW, NQ, QKD, KVRAW, NKV, 256, KVRAW + 128, NKV, 256, PROJ + C_GATE, MLA_INP, OG, KPER, SSKP, SSPE, args.in[7] + (size_t)L * QKD, args.in[8] + (size_t)L * QKD, ropec, ropes};
            fa::attn_phase<0>(lds, P, G, vcu, (LAS unsigned*)(lds + LDSCTL_OFF), tacc); }
        DRAIN(pb + 2, L == 0 ? FQ_OM0 : FQ_OM1);
        SEAM_FILL(pb + 2);
        if (IN(pb + 3)) { if (OUTPROJ_STAGGER && (bx & 4)) { const unsigned long long t0_ = __builtin_amdgcn_s_memtime(); while (__builtin_amdgcn_s_memtime() - t0_ < (unsigned long long)OUTPROJ_STAGGER) { if (!fill.item(lane)) break; } __syncthreads(); }     pg8::Gemm g{OG, (const bf16*)(wl + W_OUT_MLA), M, DM, DM, DM}; pg8::StaticOrder S; S.init(M, DM, G, bx);
            pg8::EpiResHL E{XB, XLO, DM, nullptr, SSX + (size_t)(2 * L + 1) * M}; pg8::gemm_phase<pg8::EpiResHL, pg8::StaticOrder, PG8_ALIGN, PG8_SP2>(lds + RING_OFF, g, S, E, PROBE_SITE == 4 ? &tacc : nullptr); }
        DRAIN(pb + 3, L == 0 ? FQ_IS0 : FQ_IS1);
        SEAM_FILL(pb + 3);
        if (IN(pb + 4)) { pg8::Gemm g{XB, (const bf16*)(wl + W_IN_SB), M, SB_IN, DM, DM}; pg8::StaticOrder S; S.init(M, SB_IN, G, bx);
            PG8_LAS float* rst = (PG8_LAS float*)(lds + LDSCTL_OFF + 2048);
            pg8::rstd_table_fill(rst, SSX + (size_t)(2 * L + 1) * M, 1.f / DM, S, tid); pg8::EpiBf16S<0> E{PROJ, SB_IN, rst, nullptr, nullptr, nullptr, nullptr, nullptr, 0.f}; pg8::gemm_phase<pg8::EpiBf16S<0>, pg8::StaticOrder, PG8_ALIGN, PG8_SP2>(lds + RING_OFF, g, S, E, PROBE_SITE == 8 ? &tacc : nullptr); }
        SEAM_FILL(pb + 4);
        if (IN(pb + 5)) { const fa::AttnP P{PROJ, SB_IN, 128, PROJ + C_SBK, SB_IN, 128, PROJ + C_SBV, SB_IN, 128, PROJ + C_SBG, SB_IN, OG, nullptr, nullptr, nullptr, nullptr, nullptr, nullptr, nullptr};
            fa::attn_phase<1>(lds, P, G, vcu, (LAS unsigned*)(lds + LDSCTL_OFF), tacc); }
        DRAIN(pb + 5, L == 0 ? FQ_OS0 : FQ_OS1);
        SEAM_FILL(pb + 5);
        if (IN(pb + 6)) { if (OUTPROJ_STAGGER && (bx & 4)) { const unsigned long long t0_ = __builtin_amdgcn_s_memtime(); while (__builtin_amdgcn_s_memtime() - t0_ < (unsigned long long)OUTPROJ_STAGGER) { if (!fill.item(lane)) break; } __syncthreads(); }     pg8::Gemm g{OG, (const bf16*)(wl + W_OUT_SB), M, DM, DM, DM}; pg8::StaticOrder S; S.init(M, DM, G, bx);
            pg8::EpiResHL E{XB, XLO, DM, (L == 0) ? (float*)nullptr : out, SSX + (size_t)2 * M}; pg8::gemm_phase<pg8::EpiResHL, pg8::StaticOrder, PG8_ALIGN, PG8_SP2>(lds + RING_OFF, g, S, E); }
        DRAIN(pb + 6, L == 0 ? FQ_IM1 : FQ_ITEMS);
        SEAM_FILL(pb + 6);
    }
#if PROBE_SEG || PROBE_GEMM || PROBE_BAR
    if (bx == PROBE_BLOCK && wave == 0) { const unsigned long long t0 = __builtin_amdgcn_s_memrealtime(), want = (unsigned long long)(tacc >> PROBE_SHIFT); while (__builtin_amdgcn_s_memrealtime() - t0 < want) __builtin_amdgcn_s_sleep(8); }
#endif
#undef IN
#undef SEAM
}

extern "C" void kernel_launch(void* const* d_in, const int* in_sizes, int n_in, void* d_out, int out_size, void* d_ws, size_t ws_size, hipStream_t stream) {
    static int grid = 0;
    if (grid == 0) {
        if (n_in != 13 || in_sizes[0] != M * DM || out_size != M * DM || ws_size < WS_END) { fprintf(stderr, "kernel_launch: unexpected shapes (n_in %d, in0 %d, out %d, ws %zu; need ws >= %zu); nothing launched\n", n_in, n_in > 0 ? in_sizes[0] : -1, out_size, ws_size, (size_t)WS_END); grid = -1; return; }
        int dev = 0, cus = 0, per_cu = 0;
        if (hipGetDevice(&dev) != hipSuccess || hipDeviceGetAttribute(&cus, hipDeviceAttributeMultiprocessorCount, dev) != hipSuccess) { fprintf(stderr, "kernel_launch: device query failed\n"); grid = -1; return; }
        if (hipFuncSetAttribute((const void*)hybrid_fwd, hipFuncAttributeMaxDynamicSharedMemorySize, LDS_BYTES) != hipSuccess) { fprintf(stderr, "kernel_launch: hipFuncSetAttribute failed\n"); grid = -1; return; }
        if (hipOccupancyMaxActiveBlocksPerMultiprocessor(&per_cu, (const void*)hybrid_fwd, NWAVES * 64, LDS_BYTES) != hipSuccess || per_cu < 1)
            fprintf(stderr, "kernel_launch: note: occupancy query reports %d workgroups per CU\n", per_cu);
        (void)hipGetLastError();
        grid = cus;
    }
    if (grid < 0) return;
    if (hipMemsetAsync((char*)d_ws + WS_CTL, 0, CTL_ZERO_BYTES, stream) != hipSuccess) { fprintf(stderr, "kernel_launch: memset failed\n"); return; }
    Args a{};
    for (int i = 0; i < 13; ++i) a.in[i] = (const float*)d_in[i];
    a.out = (float*)d_out; a.ws = (unsigned char*)d_ws;
#if MK_ONE_LAUNCH
    a.ph_lo = 0; a.ph_hi = N_PHASES;
    hipLaunchKernelGGL(hybrid_fwd, dim3(grid), dim3(NWAVES * 64), LDS_BYTES, stream, a);
#ifdef PROBE_PHASES
    { static const int probe_ph[] = {PROBE_PHASES};
      for (int r = 0; r < PROBE_NREP; ++r) for (int ph : probe_ph) { a.ph_lo = ph; a.ph_hi = ph + 1; hipLaunchKernelGGL(hybrid_fwd, dim3(grid), dim3(NWAVES * 64), LDS_BYTES, stream, a); } }
#endif
#else
    for (int ph = 0; ph < N_PHASES; ++ph) { a.ph_lo = ph; a.ph_hi = ph + 1; hipLaunchKernelGGL(hybrid_fwd, dim3(grid), dim3(NWAVES * 64), LDS_BYTES, stream, a); }
#endif
    const hipError_t le = hipPeekAtLastError();
    if (le != hipSuccess) fprintf(stderr, "kernel_launch: launch failed: %s\n", hipGetErrorName(le));
}
```
